# Optimizing an MI355X kernel written in HIP

```python
import math
import jax, jax.numpy as jnp
from jax import lax
import numpy as np

D_MODEL = 1024
BATCH = 2
SEQ = 8192
DEPTH = 1

CHUNK = 64
Q_BLOCK = 128
D_PLE = 256
D_MIX = D_MODEL
RET_WIDTH = D_MIX // 2
RET_HEADS = 4
RET_HEAD_DIM = RET_WIDTH // RET_HEADS
MLA_HEADS = 4
MLA_NOPE_DIM = 128
MLA_ROPE_DIM = 64
MLA_V_DIM = (D_MIX - RET_WIDTH) // MLA_HEADS
MLA_QK_DIM = MLA_NOPE_DIM + MLA_ROPE_DIM
Q_LORA = 256
KV_LORA = 128
D_FF = -(-8 * D_MODEL // (3 * 256)) * 256
ROPE_BASE = 10000.0
RMS_EPS = 1e-6
GN_EPS = 1e-5

IN_SIZES = (RET_WIDTH, RET_WIDTH, RET_WIDTH, RET_WIDTH, Q_LORA, KV_LORA, MLA_ROPE_DIM)
IN_COLS = sum(IN_SIZES)
IN_SPLITS = tuple(int(v) for v in np.cumsum(IN_SIZES)[:-1])

kernel_name = "hybrid_retention_mla_block"


def rmsnorm(x, g):
    xf = x.astype(jnp.float32)
    y = xf * lax.rsqrt(jnp.mean(xf * xf, axis=-1, keepdims=True) + RMS_EPS)
    return (y * g.astype(jnp.float32)).astype(x.dtype)


def rope(x, pos):
    half = x.shape[-1] // 2
    inv = jnp.exp(-math.log(ROPE_BASE) * jnp.arange(half, dtype=jnp.float32) / half)
    ang = pos.astype(jnp.float32)[..., None] * inv
    cos = jnp.cos(ang)[:, :, None, :]
    sin = jnp.sin(ang)[:, :, None, :]
    xf = x.astype(jnp.float32)
    x1, x2 = xf[..., :half], xf[..., half:]
    return jnp.concatenate([x1 * cos - x2 * sin, x2 * cos + x1 * sin], axis=-1).astype(x.dtype)


def retention(q, k, v, gate, pos):
    B, S, H, d = q.shape
    n = S // CHUNK
    dt = q.dtype
    q = rope(q, pos)
    k = rope(k, pos) * (d ** -0.5)
    q = q.reshape(B, n, CHUNK, H, d)
    k = k.reshape(B, n, CHUNK, H, d)
    v = v.reshape(B, n, CHUNK, H, d)
    log_g = jnp.log1p(-jnp.exp2(-5.0 - jnp.arange(H, dtype=jnp.float32)))
    idx = jnp.arange(CHUNK, dtype=jnp.float32)
    intra_dec = jnp.exp(log_g[:, None, None] * jnp.abs(idx[:, None] - idx[None, :]))
    q_dec = jnp.exp(log_g[:, None] * (idx + 1.0))
    k_dec = jnp.exp(log_g[:, None] * (CHUNK - 1.0 - idx))
    c_dec = jnp.exp(log_g * CHUNK)[None, :, None, None]
    s = jnp.einsum('bnihd,bnjhd->bnhij', q, k) * intra_dec.astype(dt)
    o_intra = jnp.einsum('bnhij,bnjhe->bnihe', s, v)
    kv = jnp.einsum('bnjhd,hj,bnjhe->nbhde', k, k_dec.astype(dt), v)

    def step(state, kv_c):
        return c_dec * state + kv_c.astype(jnp.float32), state

    _, prev = lax.scan(step, jnp.zeros((B, H, d, d), jnp.float32), kv)
    o_cross = jnp.einsum('bnihd,nbhde,hi->bnihe', q, prev.astype(dt), q_dec.astype(dt))
    o = (o_intra + o_cross).reshape(B, S, H, d).astype(jnp.float32)
    mu = jnp.mean(o, axis=-1, keepdims=True)
    var = jnp.mean(jnp.square(o - mu), axis=-1, keepdims=True)
    o = ((o - mu) * lax.rsqrt(var + GN_EPS)).reshape(B, S, H * d).astype(dt)
    return o * jax.nn.silu(gate)


def mla(c_q, c_kv, k_pe, pos, q_norm_g, w_uq, kv_norm_g, w_ukv):
    B, S, _ = c_q.shape
    H = MLA_HEADS
    q = (rmsnorm(c_q, q_norm_g) @ w_uq).reshape(B, S, H, MLA_QK_DIM)
    q = jnp.concatenate([q[..., :MLA_NOPE_DIM], rope(q[..., MLA_NOPE_DIM:], pos)], axis=-1)
    kv = (rmsnorm(c_kv, kv_norm_g) @ w_ukv).reshape(B, S, H, MLA_NOPE_DIM + MLA_V_DIM)
    k_nope, v = kv[..., :MLA_NOPE_DIM], kv[..., MLA_NOPE_DIM:]
    k_rot = rope(k_pe[:, :, None, :], pos)
    k = jnp.concatenate([k_nope, jnp.broadcast_to(k_rot, (B, S, H, MLA_ROPE_DIM))], axis=-1)
    nb = S // Q_BLOCK
    qb = q.reshape(B, nb, Q_BLOCK, H, MLA_QK_DIM).transpose(1, 0, 2, 3, 4)
    key_chunk = jnp.arange(S) // CHUNK
    scale = MLA_QK_DIM ** -0.5
    neg = jnp.finfo(jnp.float32).min

    def attend(args):
        q_blk, b = args
        q_chunk = (b * Q_BLOCK + jnp.arange(Q_BLOCK)) // CHUNK
        mask = key_chunk[None, :] <= q_chunk[:, None]
        s = jnp.einsum('bqhd,bkhd->bhqk', q_blk, k).astype(jnp.float32) * scale
        s = jnp.where(mask[None, None], s, neg)
        prob = jax.nn.softmax(s, axis=-1).astype(v.dtype)
        return jnp.einsum('bhqk,bkhe->bqhe', prob, v)

    out = lax.map(attend, (qb, jnp.arange(nb)))
    return out.transpose(1, 0, 2, 3, 4).reshape(B, S, H * MLA_V_DIM)


def setup_inputs(seed: int = 0) -> dict:
    key = jax.random.key(seed)
    ks = jax.random.split(key, 20)
    f32 = jnp.float32

    def w(k, shape, fan_in):
        return jax.random.normal(k, shape, f32) * (fan_in ** -0.5)

    def gain(k, shape):
        return 1.0 + 0.02 * jax.random.normal(k, shape, f32)

    start = jax.random.randint(ks[2], (BATCH, 1), 0, 4096, dtype=jnp.int32)
    positions = (start + jnp.arange(SEQ, dtype=jnp.int32)[None, :]).astype(jnp.int32)
    return {
        "x": jax.random.normal(ks[0], (BATCH, SEQ, D_MODEL), f32),
        "p": jax.random.normal(ks[1], (DEPTH, BATCH, SEQ, D_PLE), f32),
        "positions": positions,
        "mix_norm_g": gain(ks[3], (DEPTH, D_MODEL)),
        "w_in": w(ks[4], (DEPTH, D_MODEL, IN_COLS), D_MODEL),
        "q_norm_g": gain(ks[5], (DEPTH, Q_LORA)),
        "w_uq": w(ks[6], (DEPTH, Q_LORA, MLA_HEADS * MLA_QK_DIM), Q_LORA),
        "kv_norm_g": gain(ks[7], (DEPTH, KV_LORA)),
        "w_ukv": w(ks[8], (DEPTH, KV_LORA, MLA_HEADS * (MLA_NOPE_DIM + MLA_V_DIM)), KV_LORA),
        "w_o": w(ks[9], (DEPTH, D_MIX, D_MODEL), D_MIX),
        "ffn_norm_g": gain(ks[10], (DEPTH, D_MODEL)),
        "w_ffn_gate": w(ks[11], (DEPTH, D_MODEL, D_FF), D_MODEL),
        "w_ffn_up": w(ks[12], (DEPTH, D_MODEL, D_FF), D_MODEL),
        "w_ffn_down": w(ks[13], (DEPTH, D_FF, D_MODEL), D_FF),
        "ple_norm_g": gain(ks[14], (DEPTH, D_MODEL)),
        "w_ple_gate": w(ks[15], (DEPTH, D_MODEL, D_MODEL), D_MODEL),
        "w_ple_proj": w(ks[16], (DEPTH, D_PLE, D_MODEL), D_PLE),
        "final_norm_g": gain(ks[17], (D_MODEL,)),
    }


def reference(x, p, positions, mix_norm_g, w_in, q_norm_g, w_uq, kv_norm_g, w_ukv, w_o,
              ffn_norm_g, w_ffn_gate, w_ffn_up, w_ffn_down, ple_norm_g, w_ple_gate,
              w_ple_proj, final_norm_g):
    B, S, _ = x.shape
    for i in range(DEPTH):
        h = rmsnorm(x, mix_norm_g[i])
        z = h @ w_in[i]
        rq, rk, rv, rg, c_q, c_kv, k_pe = jnp.split(z, IN_SPLITS, axis=-1)
        shp = (B, S, RET_HEADS, RET_HEAD_DIM)
        ret = retention(rq.reshape(shp), rk.reshape(shp), rv.reshape(shp), rg, positions)
        att = mla(c_q, c_kv, k_pe, positions, q_norm_g[i], w_uq[i], kv_norm_g[i], w_ukv[i])
        x = x + jnp.concatenate([ret, att], axis=-1) @ w_o[i]
        h = rmsnorm(x, ffn_norm_g[i])
        x = x + (jax.nn.silu(h @ w_ffn_gate[i]) * (h @ w_ffn_up[i])) @ w_ffn_down[i]
        gate = jax.nn.sigmoid(rmsnorm(x, ple_norm_g[i]) @ w_ple_gate[i])
        x = x + gate * (p[i] @ w_ple_proj[i])
    return rmsnorm(x, final_norm_g)
```

```cpp
#include <hip/hip_runtime.h>
#include <math.h>
#include <stdio.h>

constexpr int D_MODEL = 1024, BATCH = 2, SEQ = 8192, T = BATCH * SEQ, CHUNK = 64, NCH = SEQ / CHUNK;
constexpr int D_PLE = 256, RH = 4, RD = 128, MH = 4, NOPE = 128, ROPE = 64, VD = 128, QKD = 192, QLORA = 256, KVLORA = 128, DFF = 2816, INC = 2496;
constexpr float RMS_EPS = 1e-6f, GN_EPS = 1e-5f;

__device__ __forceinline__ float wave_sum(float v) {
#pragma unroll
    for (int o = 1; o < 64; o <<= 1) v += __shfl_xor(v, o);
    return v;
}

__global__ __launch_bounds__(256) void rmsnorm_rows(const float* in, int ldi, float* out, int ldo, const float* g, int rows, int D) {
    const int wave = (blockIdx.x * 256 + threadIdx.x) >> 6, lane = threadIdx.x & 63;
    if (wave >= rows) return;
    const float* x = in + (size_t)wave * ldi; float* o = out + (size_t)wave * ldo;
    float s = 0.f;
    for (int c = lane; c < D; c += 64) { float v = x[c]; s += v * v; }
    s = wave_sum(s);
    const float rs = 1.0f / sqrtf(s / (float)D + RMS_EPS);
    for (int c = lane; c < D; c += 64) o[c] = x[c] * rs * g[c];
}

enum { EPI_STORE = 0, EPI_RES = 1, EPI_SWIGLU = 2, EPI_PLE = 3 };
template <int EPI>
__global__ __launch_bounds__(256) void gemm_f32(const float* __restrict__ A, int lda, const float* __restrict__ B, int ldb, const float* __restrict__ B2,
                                                float* C, int ldc, const float* R, int ldr, const float* P2, int ldp, int K) {
    __shared__ float As[16][132];
    __shared__ float Bs[16][68];
    __shared__ float Bs2[16][68];
    const int tid = threadIdx.x, ty = tid >> 4, tx = tid & 15;
    const int m0 = blockIdx.y * 128, n0 = blockIdx.x * 64;
    float acc[8][4], acc2[8][4];
#pragma unroll
    for (int i = 0; i < 8; ++i)
#pragma unroll
        for (int j = 0; j < 4; ++j) { acc[i][j] = 0.f; acc2[i][j] = 0.f; }
    for (int k0 = 0; k0 < K; k0 += 16) {
#pragma unroll
        for (int i = 0; i < 2; ++i) {
            const int row = (tid >> 2) + 64 * i, k4 = (tid & 3) * 4;
            const float4 v = *(const float4*)(A + (size_t)(m0 + row) * lda + k0 + k4);
            As[k4 + 0][row] = v.x; As[k4 + 1][row] = v.y; As[k4 + 2][row] = v.z; As[k4 + 3][row] = v.w;
        }
        {
            const int k = tid >> 4, n4 = (tid & 15) * 4;
            *(float4*)&Bs[k][n4] = *(const float4*)(B + (size_t)(k0 + k) * ldb + n0 + n4);
            if (EPI == EPI_SWIGLU) *(float4*)&Bs2[k][n4] = *(const float4*)(B2 + (size_t)(k0 + k) * ldb + n0 + n4);
        }
        __syncthreads();
#pragma unroll
        for (int k = 0; k < 16; ++k) {
            const float4 a0 = *(const float4*)&As[k][ty * 8], a1 = *(const float4*)&As[k][ty * 8 + 4];
            const float4 b = *(const float4*)&Bs[k][tx * 4];
            const float a[8] = {a0.x, a0.y, a0.z, a0.w, a1.x, a1.y, a1.z, a1.w};
            const float bb[4] = {b.x, b.y, b.z, b.w};
#pragma unroll
            for (int i = 0; i < 8; ++i)
#pragma unroll
                for (int j = 0; j < 4; ++j) acc[i][j] += a[i] * bb[j];
            if (EPI == EPI_SWIGLU) {
                const float4 b2 = *(const float4*)&Bs2[k][tx * 4];
                const float b2b[4] = {b2.x, b2.y, b2.z, b2.w};
#pragma unroll
                for (int i = 0; i < 8; ++i)
#pragma unroll
                    for (int j = 0; j < 4; ++j) acc2[i][j] += a[i] * b2b[j];
            }
        }
        __syncthreads();
    }
#pragma unroll
    for (int i = 0; i < 8; ++i) {
        const int m = m0 + ty * 8 + i;
#pragma unroll
        for (int j = 0; j < 4; ++j) {
            const int n = n0 + tx * 4 + j;
            float v = acc[i][j];
            if (EPI == EPI_RES) v = R[(size_t)m * ldr + n] + v;
            if (EPI == EPI_SWIGLU) v = (v / (1.0f + expf(-v))) * acc2[i][j];
            if (EPI == EPI_PLE) v = R[(size_t)m * ldr + n] + (1.0f / (1.0f + expf(-v))) * P2[(size_t)m * ldp + n];
            C[(size_t)m * ldc + n] = v;
        }
    }
}

__global__ __launch_bounds__(256) void rope_inplace(float* Z, int ld, int col0, int nh, int hw, int half, const int* pos, float scale) {
    const size_t gid = (size_t)blockIdx.x * 256 + threadIdx.x;
    const size_t total = (size_t)T * nh * half;
    if (gid >= total) return;
    const int i = (int)(gid % half); const int h = (int)((gid / half) % nh); const int t = (int)(gid / ((size_t)half * nh));
    const float inv = expf(-logf(10000.0f) * (float)i / (float)half);
    const float ang = (float)pos[t] * inv;
    const float c = cosf(ang), s = sinf(ang);
    float* p = Z + (size_t)t * ld + col0 + h * hw;
    const float x1 = p[i], x2 = p[i + half];
    p[i] = (x1 * c - x2 * s) * scale; p[i + half] = (x2 * c + x1 * s) * scale;
}

__device__ __forceinline__ float ret_logg(int h) { return log1pf(-exp2f(-5.0f - (float)h)); }

__global__ __launch_bounds__(256) void ret_kv(const float* Z, float* KVS) {
    __shared__ float ks[64][128];
    __shared__ float vs[64][128];
    const int blk = blockIdx.x, h = blk % RH, n = (blk / RH) % NCH, b = blk / (RH * NCH);
    const int tid = threadIdx.x;
    const float lg = ret_logg(h);
    const size_t t0 = (size_t)b * SEQ + (size_t)n * CHUNK;
    for (int idx = tid; idx < 64 * 128; idx += 256) {
        const int j = idx >> 7, d = idx & 127;
        const float* row = Z + (t0 + j) * INC;
        ks[j][d] = row[512 + h * 128 + d] * expf(lg * (float)(CHUNK - 1 - j));
        vs[j][d] = row[1024 + h * 128 + d];
    }
    __syncthreads();
    const int d = tid >> 1, e0 = (tid & 1) * 64;
    float acc[64];
#pragma unroll
    for (int e = 0; e < 64; ++e) acc[e] = 0.f;
    for (int j = 0; j < 64; ++j) {
        const float kd = ks[j][d];
#pragma unroll
        for (int e = 0; e < 64; ++e) acc[e] += kd * vs[j][e0 + e];
    }
    float* o = KVS + (size_t)blk * 16384 + d * 128 + e0;
#pragma unroll
    for (int e = 0; e < 64; ++e) o[e] = acc[e];
}

__global__ __launch_bounds__(256) void ret_scan(float* KVS) {
    const int gid = blockIdx.x * 256 + threadIdx.x;
    const int de = gid & 16383, h = (gid >> 14) % RH, b = gid >> 16;
    const float c = expf(ret_logg(h) * (float)CHUNK);
    float S = 0.f;
    for (int n = 0; n < NCH; ++n) {
        float* p = KVS + ((size_t)((b * NCH + n) * RH + h)) * 16384 + de;
        const float kv = *p; *p = S; S = c * S + kv;
    }
}

__global__ __launch_bounds__(256) void ret_out(const float* Z, const float* PREV, float* CAT) {
    extern __shared__ float sm[];
    float* qs = sm;
    float* ks = qs + 64 * 129;
    float* vs = ks + 64 * 129;
    float* ss = vs + 64 * 128;
    const int blk = blockIdx.x, h = blk % RH, n = (blk / RH) % NCH, b = blk / (RH * NCH);
    const int tid = threadIdx.x;
    const float lg = ret_logg(h);
    const size_t t0 = (size_t)b * SEQ + (size_t)n * CHUNK;
    for (int idx = tid; idx < 64 * 128; idx += 256) {
        const int j = idx >> 7, d = idx & 127;
        const float* row = Z + (t0 + j) * INC;
        qs[j * 129 + d] = row[h * 128 + d];
        ks[j * 129 + d] = row[512 + h * 128 + d];
        vs[j * 128 + d] = row[1024 + h * 128 + d];
    }
    __syncthreads();
    {
        const int i = tid >> 2, jq = tid & 3;
        for (int jj = 0; jj < 16; ++jj) {
            const int j = jq * 16 + jj;
            float dot = 0.f;
            for (int d = 0; d < 128; ++d) dot += qs[i * 129 + d] * ks[j * 129 + d];
            const int dij = i > j ? i - j : j - i;
            ss[i * 65 + j] = dot * expf(lg * (float)dij);
        }
    }
    __syncthreads();
    const int e = tid & 127, ih = tid >> 7;
    float acc[32], acc2[32];
#pragma unroll
    for (int ii = 0; ii < 32; ++ii) { acc[ii] = 0.f; acc2[ii] = 0.f; }
    for (int j = 0; j < 64; ++j) {
        const float vv = vs[j * 128 + e];
#pragma unroll
        for (int ii = 0; ii < 32; ++ii) acc[ii] += ss[(ih * 32 + ii) * 65 + j] * vv;
    }
    const float* pv = PREV + (size_t)blk * 16384;
    for (int d = 0; d < 128; ++d) {
        const float p = pv[d * 128 + e];
#pragma unroll
        for (int ii = 0; ii < 32; ++ii) acc2[ii] += qs[(ih * 32 + ii) * 129 + d] * p;
    }
    __syncthreads();
    float* os = qs;
#pragma unroll
    for (int ii = 0; ii < 32; ++ii) { const int i = ih * 32 + ii; os[i * 128 + e] = acc[ii] + expf(lg * (float)(i + 1)) * acc2[ii]; }
    __syncthreads();
    const int wave = tid >> 6, lane = tid & 63;
    for (int r = 0; r < 16; ++r) {
        const int i = wave * 16 + r;
        const float a = os[i * 128 + lane], c = os[i * 128 + lane + 64];
        const float mu = wave_sum(a + c) * (1.0f / 128.0f);
        const float da = a - mu, dc = c - mu;
        const float var = wave_sum(da * da + dc * dc) * (1.0f / 128.0f);
        const float rs = 1.0f / sqrtf(var + GN_EPS);
        const float* zrow = Z + (t0 + i) * INC + 1536 + h * 128;
        const float g0 = zrow[lane], g1 = zrow[lane + 64];
        float* orow = CAT + (t0 + i) * D_MODEL + h * 128;
        orow[lane] = da * rs * (g0 / (1.0f + expf(-g0)));
        orow[lane + 64] = dc * rs * (g1 / (1.0f + expf(-g1)));
    }
}

__global__ __launch_bounds__(256) void mla_attn(const float* Z  , const float* KV  , float* CAT) {
    extern __shared__ float sm[];
    float* Qs = sm;
    float* Ks = Qs + 64 * 193;
    float* Vs = Ks + 64 * 193;
    float* Ss = Vs + 64 * 128;
    const int blk = blockIdx.x, c = (NCH - 1) - (blk % NCH), h = (blk / NCH) % MH, b = blk / (NCH * MH);
    const int tid = threadIdx.x;
    const size_t tq0 = (size_t)b * SEQ + (size_t)c * CHUNK;
    for (int idx = tid; idx < 64 * 192; idx += 256) { const int i = idx / 192, d = idx % 192; Qs[i * 193 + d] = Z[(tq0 + i) * INC + h * 192 + d]; }
    const int qi = tid >> 2, part = tid & 3;
    float m = -INFINITY, l = 0.f;
    float acc[32];
#pragma unroll
    for (int e = 0; e < 32; ++e) acc[e] = 0.f;
    const float scale = 1.0f / sqrtf((float)QKD);
    for (int kt = 0; kt <= c; ++kt) {
        __syncthreads();
        const size_t tk0 = (size_t)b * SEQ + (size_t)kt * CHUNK;
        for (int idx = tid; idx < 64 * 192; idx += 256) {
            const int j = idx / 192, d = idx % 192;
            Ks[j * 193 + d] = d < 128 ? KV[(tk0 + j) * 1024 + h * 256 + d] : Z[(tk0 + j) * INC + 2432 + (d - 128)];
        }
        for (int idx = tid; idx < 64 * 128; idx += 256) { const int j = idx >> 7, e = idx & 127; Vs[j * 128 + e] = KV[(tk0 + j) * 1024 + h * 256 + 128 + e]; }
        __syncthreads();
        for (int jj = 0; jj < 16; ++jj) {
            const int j = part * 16 + jj;
            float dot = 0.f;
            for (int d = 0; d < 192; ++d) dot += Qs[qi * 193 + d] * Ks[j * 193 + d];
            Ss[qi * 65 + j] = dot * scale;
        }
        __syncthreads();
        float mx = m;
        for (int j = 0; j < 64; ++j) mx = fmaxf(mx, Ss[qi * 65 + j]);
        const float alpha = expf(m - mx);
        l *= alpha;
#pragma unroll
        for (int e = 0; e < 32; ++e) acc[e] *= alpha;
        for (int j = 0; j < 64; ++j) {
            const float p = expf(Ss[qi * 65 + j] - mx);
            l += p;
            const float* vr = Vs + j * 128 + part * 32;
#pragma unroll
            for (int e = 0; e < 32; ++e) acc[e] += p * vr[e];
        }
        m = mx;
    }
    const float il = 1.0f / l;
    float* o = CAT + (tq0 + qi) * D_MODEL + 512 + h * 128 + part * 32;
#pragma unroll
    for (int e = 0; e < 32; ++e) o[e] = acc[e] * il;
}

extern "C" void kernel_launch(void* const* d_in, const int* in_sizes, int n_in, void* d_out, int out_size, void* d_ws, size_t ws_size, hipStream_t stream) {
    const float* x = (const float*)d_in[0]; const float* p = (const float*)d_in[1]; const int* pos = (const int*)d_in[2];
    const float* mix_g = (const float*)d_in[3]; const float* w_in = (const float*)d_in[4]; const float* qn_g = (const float*)d_in[5];
    const float* w_uq = (const float*)d_in[6]; const float* kvn_g = (const float*)d_in[7]; const float* w_ukv = (const float*)d_in[8];
    const float* w_o = (const float*)d_in[9]; const float* ffn_g = (const float*)d_in[10]; const float* w_g = (const float*)d_in[11];
    const float* w_u = (const float*)d_in[12]; const float* w_d = (const float*)d_in[13]; const float* ple_g = (const float*)d_in[14];
    const float* w_pg = (const float*)d_in[15]; const float* w_pp = (const float*)d_in[16]; const float* fin_g = (const float*)d_in[17];
    float* out = (float*)d_out;
    const size_t A_BYTES = (size_t)T * D_MODEL * 4;
    if (ws_size < A_BYTES + (size_t)T * DFF * 4) { fprintf(stderr, "ws too small: %zu\n", ws_size); return; }
    float* RA = (float*)d_ws;
    float* RB = (float*)((char*)d_ws + A_BYTES);
    float* Z = RB;
    const int ROPE_SMEM = (64 * 129 * 2 + 64 * 128 + 64 * 65) * 4, ATT_SMEM = (64 * 193 * 2 + 64 * 128 + 64 * 65) * 4;
    static bool attr_done = false;
    if (!attr_done) {
        hipFuncSetAttribute((const void*)ret_out, hipFuncAttributeMaxDynamicSharedMemorySize, ROPE_SMEM);
        hipFuncSetAttribute((const void*)mla_attn, hipFuncAttributeMaxDynamicSharedMemorySize, ATT_SMEM);
        attr_done = true;
    }
    const dim3 blk(256);
    rmsnorm_rows<<<T / 4, blk, 0, stream>>>(x, D_MODEL, RA, D_MODEL, mix_g, T, D_MODEL);
    gemm_f32<EPI_STORE><<<dim3(INC / 64, T / 128), blk, 0, stream>>>(RA, D_MODEL, w_in, INC, nullptr, Z, INC, nullptr, 0, nullptr, 0, D_MODEL);
    rope_inplace<<<(T * RH * 64 + 255) / 256, blk, 0, stream>>>(Z, INC, 0, RH, RD, 64, pos, 1.0f);
    rope_inplace<<<(T * RH * 64 + 255) / 256, blk, 0, stream>>>(Z, INC, 512, RH, RD, 64, pos, 1.0f / sqrtf((float)RD));
    rope_inplace<<<(T * 1 * 32 + 255) / 256, blk, 0, stream>>>(Z, INC, 2432, 1, ROPE, 32, pos, 1.0f);
    ret_kv<<<BATCH * NCH * RH, blk, 0, stream>>>(Z, RA);
    ret_scan<<<BATCH * RH * 16384 / 256, blk, 0, stream>>>(RA);
    ret_out<<<BATCH * NCH * RH, blk, ROPE_SMEM, stream>>>(Z, RA, out);
    rmsnorm_rows<<<T / 4, blk, 0, stream>>>(Z + 2048, INC, Z + 2048, INC, qn_g, T, QLORA);
    rmsnorm_rows<<<T / 4, blk, 0, stream>>>(Z + 2304, INC, Z + 2304, INC, kvn_g, T, KVLORA);
    gemm_f32<EPI_STORE><<<dim3(MH * QKD / 64, T / 128), blk, 0, stream>>>(Z + 2048, INC, w_uq, MH * QKD, nullptr, Z, INC, nullptr, 0, nullptr, 0, QLORA);
    rope_inplace<<<(T * MH * 32 + 255) / 256, blk, 0, stream>>>(Z, INC, NOPE, MH, QKD, 32, pos, 1.0f);
    gemm_f32<EPI_STORE><<<dim3(MH * 256 / 64, T / 128), blk, 0, stream>>>(Z + 2304, INC, w_ukv, MH * 256, nullptr, RA, 1024, nullptr, 0, nullptr, 0, KVLORA);
    mla_attn<<<BATCH * MH * NCH, blk, ATT_SMEM, stream>>>(Z, RA, out);
    gemm_f32<EPI_RES><<<dim3(D_MODEL / 64, T / 128), blk, 0, stream>>>(out, D_MODEL, w_o, D_MODEL, nullptr, RA, D_MODEL, x, D_MODEL, nullptr, 0, D_MODEL);
    rmsnorm_rows<<<T / 4, blk, 0, stream>>>(RA, D_MODEL, out, D_MODEL, ffn_g, T, D_MODEL);
    gemm_f32<EPI_SWIGLU><<<dim3(DFF / 64, T / 128), blk, 0, stream>>>(out, D_MODEL, w_g, DFF, w_u, RB, DFF, nullptr, 0, nullptr, 0, D_MODEL);
    gemm_f32<EPI_RES><<<dim3(D_MODEL / 64, T / 128), blk, 0, stream>>>(RB, DFF, w_d, D_MODEL, nullptr, out, D_MODEL, RA, D_MODEL, nullptr, 0, DFF);
    float* H3 = RB; float* PROJ = RB + (size_t)T * D_MODEL;
    rmsnorm_rows<<<T / 4, blk, 0, stream>>>(out, D_MODEL, H3, D_MODEL, ple_g, T, D_MODEL);
    gemm_f32<EPI_STORE><<<dim3(D_MODEL / 64, T / 128), blk, 0, stream>>>(p, D_PLE, w_pp, D_MODEL, nullptr, PROJ, D_MODEL, nullptr, 0, nullptr, 0, D_PLE);
    gemm_f32<EPI_PLE><<<dim3(D_MODEL / 64, T / 128), blk, 0, stream>>>(H3, D_MODEL, w_pg, D_MODEL, nullptr, RA, D_MODEL, out, D_MODEL, PROJ, D_MODEL, D_MODEL);
    rmsnorm_rows<<<T / 4, blk, 0, stream>>>(RA, D_MODEL, out, D_MODEL, fin_g, T, D_MODEL);
}
```

```cpp
#include <hip/hip_runtime.h>
#include <cstdio>
#include <cstdint>
#include <cmath>
#define MK_N_LAUNCHES 1
namespace pg8 {
#define PG8_LAS __attribute__((address_space(3)))
typedef unsigned short bf16_t;
typedef short bf16x8 __attribute__((ext_vector_type(8)));
typedef float f32x4 __attribute__((ext_vector_type(4)));
typedef unsigned u32x4 __attribute__((ext_vector_type(4)));
constexpr int BM = 256, BK = 64, HALF = 128, HTB = HALF * BK * 2  , STAGE_BYTES = 8 * HTB, NXCD = 8, WGM = 8;

__host__ __device__ __forceinline__ int lds_byte(int r, int c) { const int st = (r >> 4) * 2 + (c >> 5), rr = r & 15, cc = c & 31, ob = rr * 64 + cc * 2; return st * 1024 + (ob ^ (((ob >> 9) & 1) << 5)); }
__host__ __device__ __forceinline__ void stage_rc(int b, int& R, int& C) { const int st = b / 1024, sb = b % 1024, swz = sb ^ (((sb >> 9) & 1) << 5); R = (st >> 1) * 16 + swz / 64; C = (st & 1) * 32 + (swz % 64) / 2; }
__host__ __device__ __forceinline__ int perm32(int rho) { const int n = rho >> 4, i = rho & 15; return 8 * (i >> 2) + 4 * n + (i & 3); }

struct Unit { int pm, pn; };
struct Gemm { const bf16_t* A; const bf16_t* Bt; int M, N, K; };

struct StaticOrder {
    int nM, nN, nwg, G, c;
    __host__ __device__ void init(int M, int N, int G_, int c_) { nM = M / BM; nN = N / BM; nwg = nM * nN; G = G_; c = c_; }
    __host__ __device__ bool next(int i, Unit& u) const {
        const long L = (long)i * G + c; if (L >= nwg) return false;
        int wgid = (int)L; { const int q = nwg / NXCD, r = nwg % NXCD, xcd = wgid % NXCD, off = wgid / NXCD; wgid = (xcd < r ? xcd * (q + 1) : r * (q + 1) + (xcd - r) * q) + off; }
        const int nig = WGM * nN, gid = wgid / nig, fm = gid * WGM, gsz = (nM - fm) < WGM ? (nM - fm) : WGM;
        u.pm = fm + ((wgid % nig) % gsz); u.pn = (wgid % nig) / gsz; return true;
    }
    __device__ __forceinline__ void a_ready(const Unit&) const {}
    __device__ __forceinline__ void done(const Unit&) const {}
};

__device__ __forceinline__ unsigned cvt_pk_bf16(float lo, float hi) { unsigned r; asm volatile("v_cvt_pk_bf16_f32 %0, %1, %2" : "=v"(r) : "v"(lo), "v"(hi)); return r; }
__device__ __forceinline__ u32x4 pack8(const f32x4 v0, const f32x4 v1) { u32x4 w; w.x = cvt_pk_bf16(v0[0], v0[1]); w.y = cvt_pk_bf16(v0[2], v0[3]); w.z = cvt_pk_bf16(v1[0], v1[1]); w.w = cvt_pk_bf16(v1[2], v1[3]); return w; }
__device__ __forceinline__ float sq8(const f32x4 a, const f32x4 b) { return (a[0] * a[0] + a[1] * a[1]) + (a[2] * a[2] + a[3] * a[3]) + (b[0] * b[0] + b[1] * b[1]) + (b[2] * b[2] + b[3] * b[3]); }
__device__ __forceinline__ float fast_sigmoid(float v) { return __builtin_amdgcn_rcpf(1.0f + __builtin_amdgcn_exp2f(-1.4426950408889634f * v)); }
__device__ __forceinline__ void rope8(f32x4& v0, f32x4& v1, const f32x4 c, const f32x4 s) {
    const float a0 = v0[0] * c[0] - v0[1] * s[0], b0 = v0[1] * c[0] + v0[0] * s[0];
    const float a1 = v0[2] * c[1] - v0[3] * s[1], b1 = v0[3] * c[1] + v0[2] * s[1];
    const float a2 = v1[0] * c[2] - v1[1] * s[2], b2 = v1[1] * c[2] + v1[0] * s[2];
    const float a3 = v1[2] * c[3] - v1[3] * s[3], b3 = v1[3] * c[3] + v1[2] * s[3];
    v0 = (f32x4){a0, b0, a1, b1}; v1 = (f32x4){a2, b2, a3, b3};
}
__device__ __forceinline__ void ssq_add(float* ssq, int row, float s, int fq) { s += __shfl_xor(s, 16); s += __shfl_xor(s, 32); if (fq == 0) atomicAdd(ssq + row, s); }

#define EPI_ROWS_BEGIN _Pragma("unroll") for (int ai = 0; ai < 2; ++ai) _Pragma("unroll") for (int m = 0; m < 4; ++m) { const int row = row0 + ai * HALF + m * 16;
#define EPI_ROWS_END }

struct EpiZ {
    static constexpr bool PERM = true, AFTER_DRAIN = false;
    bf16_t *RQ, *RK, *RV, *RG, *CQ, *CKV, *KPE; const float *RC, *RS, *MC, *MS; float *ssq_cq, *ssq_ckv;
    __device__ __forceinline__ void operator()(const f32x4 (&acc)[2][2][4][2], const Unit& u, int wr, int wc, int fr, int fq) const {
        const int pn = u.pn, row0 = u.pm * BM + wr * 64 + fr, cw = wc * 32 + 8 * fq;
        if (pn < 4) {
            bf16_t* dst = (pn < 2 ? RQ : RK) + (pn & 1) * 256 + cw; const int i0 = 16 * wc + 4 * fq;
            EPI_ROWS_BEGIN
                const f32x4 c = *(const f32x4*)(RC + (size_t)row * 64 + i0), s = *(const f32x4*)(RS + (size_t)row * 64 + i0);
#pragma unroll
                for (int bj = 0; bj < 2; ++bj) { f32x4 v0 = acc[ai][bj][m][0], v1 = acc[ai][bj][m][1]; rope8(v0, v1, c, s); *(u32x4*)(dst + (size_t)row * 512 + bj * HALF) = pack8(v0, v1); }
            EPI_ROWS_END
        } else if (pn < 8) {
            bf16_t* dst = (pn < 6 ? RV : RG) + (pn & 1) * 256 + cw;
            EPI_ROWS_BEGIN
#pragma unroll
                for (int bj = 0; bj < 2; ++bj) *(u32x4*)(dst + (size_t)row * 512 + bj * HALF) = pack8(acc[ai][bj][m][0], acc[ai][bj][m][1]);
            EPI_ROWS_END
        } else if (pn == 8) {
            EPI_ROWS_BEGIN
                float s = 0.f;
#pragma unroll
                for (int bj = 0; bj < 2; ++bj) { *(u32x4*)(CQ + (size_t)row * 256 + bj * HALF + cw) = pack8(acc[ai][bj][m][0], acc[ai][bj][m][1]); s += sq8(acc[ai][bj][m][0], acc[ai][bj][m][1]); }
                ssq_add(ssq_cq, row, s, fq);
            EPI_ROWS_END
        } else {
            const int i0 = 16 * wc + 4 * fq;
            EPI_ROWS_BEGIN
                *(u32x4*)(CKV + (size_t)row * 128 + cw) = pack8(acc[ai][0][m][0], acc[ai][0][m][1]);
                ssq_add(ssq_ckv, row, sq8(acc[ai][0][m][0], acc[ai][0][m][1]), fq);
                if (wc < 2) { const f32x4 c = *(const f32x4*)(MC + (size_t)row * 32 + i0), s = *(const f32x4*)(MS + (size_t)row * 32 + i0);
                    f32x4 v0 = acc[ai][1][m][0], v1 = acc[ai][1][m][1]; rope8(v0, v1, c, s); *(u32x4*)(KPE + (size_t)row * 64 + cw) = pack8(v0, v1); }
            EPI_ROWS_END
        }
    }
};
struct EpiQM {
    static constexpr bool PERM = true, AFTER_DRAIN = false;
    bf16_t* QM; const float *MC, *MS; const float* ssq; float qscale;
    __device__ __forceinline__ void operator()(const f32x4 (&acc)[2][2][4][2], const Unit& u, int wr, int wc, int fr, int fq) const {
        const int pn = u.pn, row0 = u.pm * BM + wr * 64 + fr, cw = wc * 32 + 8 * fq; const int i0 = 16 * (wc & 1) + 4 * fq;
        EPI_ROWS_BEGIN
            const float rs = qscale / sqrtf(ssq[row] * (1.0f / 256.0f) + 1e-6f);
            f32x4 c, s; if (pn == 2) { c = *(const f32x4*)(MC + (size_t)row * 32 + i0); s = *(const f32x4*)(MS + (size_t)row * 32 + i0); }
#pragma unroll
            for (int bj = 0; bj < 2; ++bj) { f32x4 v0 = acc[ai][bj][m][0] * rs, v1 = acc[ai][bj][m][1] * rs; if (pn == 2) rope8(v0, v1, c, s);
                *(u32x4*)(QM + (size_t)row * 768 + pn * 256 + bj * HALF + cw) = pack8(v0, v1); }
        EPI_ROWS_END
    }
};
struct EpiScaleBf16 {
    static constexpr bool PERM = true, AFTER_DRAIN = false;
    bf16_t* O; int ldc; const float* ssq; float inv_n;
    __device__ __forceinline__ void operator()(const f32x4 (&acc)[2][2][4][2], const Unit& u, int wr, int wc, int fr, int fq) const {
        const int row0 = u.pm * BM + wr * 64 + fr, col0 = u.pn * BM + wc * 32 + 8 * fq;
        EPI_ROWS_BEGIN
            const float rs = ssq ? 1.0f / sqrtf(ssq[row] * inv_n + 1e-6f) : 1.0f;
#pragma unroll
            for (int bj = 0; bj < 2; ++bj) *(u32x4*)(O + (size_t)row * ldc + col0 + bj * HALF) = pack8(acc[ai][bj][m][0] * rs, acc[ai][bj][m][1] * rs);
        EPI_ROWS_END
    }
};
struct EpiRes {
    static constexpr bool PERM = true, AFTER_DRAIN = false;
    const float* base; float* X; bf16_t* XB; float* ssq;
    __device__ __forceinline__ void operator()(const f32x4 (&acc)[2][2][4][2], const Unit& u, int wr, int wc, int fr, int fq) const {
        const int row0 = u.pm * BM + wr * 64 + fr, col0 = u.pn * BM + wc * 32 + 8 * fq;
        EPI_ROWS_BEGIN
            float s = 0.f;
#pragma unroll
            for (int bj = 0; bj < 2; ++bj) { const size_t off = (size_t)row * 1024 + col0 + bj * HALF;
                const f32x4 v0 = acc[ai][bj][m][0] + *(const f32x4*)(base + off), v1 = acc[ai][bj][m][1] + *(const f32x4*)(base + off + 4);
                *(f32x4*)(X + off) = v0; *(f32x4*)(X + off + 4) = v1; *(u32x4*)(XB + off) = pack8(v0, v1); s += sq8(v0, v1); }
            ssq_add(ssq, row, s, fq);
        EPI_ROWS_END
    }
};
struct EpiGU {
    static constexpr bool PERM = true, AFTER_DRAIN = false;
    bf16_t* ACT; int ldc; const float* ssq;
    __device__ __forceinline__ void operator()(const f32x4 (&acc)[2][2][4][2], const Unit& u, int wr, int wc, int fr, int fq) const {
        const int row0 = u.pm * BM + wr * 64 + fr, col0 = u.pn * HALF + wc * 32 + 8 * fq;
        EPI_ROWS_BEGIN
            const float rs = 1.0f / sqrtf(ssq[row] * (1.0f / 1024.0f) + 1e-6f);
            f32x4 o[2];
#pragma unroll
            for (int n = 0; n < 2; ++n) { const f32x4 g = acc[ai][0][m][n] * rs, up = acc[ai][1][m][n] * rs;
#pragma unroll
                for (int q = 0; q < 4; ++q) o[n][q] = g[q] * fast_sigmoid(g[q]) * up[q]; }
            *(u32x4*)(ACT + (size_t)row * ldc + col0) = pack8(o[0], o[1]);
        EPI_ROWS_END
    }
};
struct EpiPle {
    static constexpr bool PERM = true, AFTER_DRAIN = false;
    float* X; const bf16_t* PROJ; const float* ssq_in; float* ssq_out;
    __device__ __forceinline__ void operator()(const f32x4 (&acc)[2][2][4][2], const Unit& u, int wr, int wc, int fr, int fq) const {
        const int row0 = u.pm * BM + wr * 64 + fr, col0 = u.pn * BM + wc * 32 + 8 * fq;
        EPI_ROWS_BEGIN
            const float rs = 1.0f / sqrtf(ssq_in[row] * (1.0f / 1024.0f) + 1e-6f);
            float s = 0.f;
#pragma unroll
            for (int bj = 0; bj < 2; ++bj) { const size_t off = (size_t)row * 1024 + col0 + bj * HALF;
                const u32x4 pw = *(const u32x4*)(PROJ + off); const f32x4 x0 = *(const f32x4*)(X + off), x1 = *(const f32x4*)(X + off + 4);
                const f32x4 p0 = {__uint_as_float(pw.x << 16), __uint_as_float(pw.x & 0xffff0000u), __uint_as_float(pw.y << 16), __uint_as_float(pw.y & 0xffff0000u)};
                const f32x4 p1 = {__uint_as_float(pw.z << 16), __uint_as_float(pw.z & 0xffff0000u), __uint_as_float(pw.w << 16), __uint_as_float(pw.w & 0xffff0000u)};
                f32x4 v0, v1;
#pragma unroll
                for (int q = 0; q < 4; ++q) { v0[q] = x0[q] + fast_sigmoid(acc[ai][bj][m][0][q] * rs) * p0[q]; v1[q] = x1[q] + fast_sigmoid(acc[ai][bj][m][1][q] * rs) * p1[q]; }
                *(f32x4*)(X + off) = v0; *(f32x4*)(X + off + 4) = v1; s += sq8(v0, v1); }
            ssq_add(ssq_out, row, s, fq);
        EPI_ROWS_END
    }
};
template <class Epi, class Sched, bool ALIGN_EPI = false, bool SP2 = false>
__device__ __forceinline__ void gemm_phase(PG8_LAS unsigned char* lds, const Gemm g, const Sched& S, const Epi& E) {
    const int tid = threadIdx.x, wid = __builtin_amdgcn_readfirstlane(tid >> 6), lane = tid & 63, wr = wid >> 2, wc = wid & 3, fr = lane & 15, fq = lane >> 4;
    int Kop = g.K; asm volatile("" : "+s"(Kop));
    const int K = Kop, nt = K / BK;
    unsigned voffA[2], voffB[2];
#pragma unroll
    for (int i = 0; i < 2; ++i) { int R, C; stage_rc(tid * 16 + i * 8192, R, C); const int Rb = Epi::PERM ? ((R & ~31) + perm32(R & 31)) : R;
        voffA[i] = (unsigned)(R * K + C) * 2u; voffB[i] = (unsigned)(Rb * K + C) * 2u; }
    const size_t kstep = (size_t)(BK * 2);
    const size_t hstep = (size_t)HALF * K * 2;
    const size_t tstep = 2 * hstep;
    const unsigned ldsw = (unsigned)wid * 1024u;
    const int aoff = lds_byte(wr * 64 + fr, fq * 8), boff = lds_byte(wc * 32 + fr, fq * 8);
#define PG8_SA(b, h) (((b) * 2 + (h)) * HTB)
#define PG8_SB(b, h) ((4 + (b) * 2 + (h)) * HTB)
#define PG8_STAGE(bufoff, gbase, voff) do { _Pragma("unroll") for (int _i = 0; _i < 2; ++_i) \
        __builtin_amdgcn_global_load_lds((const unsigned*)((const char*)(gbase) + (voff)[_i]), (PG8_LAS unsigned*)(lds + (bufoff) + ldsw + _i * 8192), 16, 0, 0); } while (0)
#define PG8_LDA(dst, b, h) do { _Pragma("unroll") for (int m = 0; m < 4; ++m) _Pragma("unroll") for (int k = 0; k < 2; ++k) dst[m][k] = *(const PG8_LAS bf16x8*)(lds + PG8_SA(b, h) + aoff + m * 2048 + k * 1024); } while (0)
#define PG8_LDB(dst, b, h) do { _Pragma("unroll") for (int n = 0; n < 2; ++n) _Pragma("unroll") for (int k = 0; k < 2; ++k) dst[n][k] = *(const PG8_LAS bf16x8*)(lds + PG8_SB(b, h) + boff + n * 2048 + k * 1024); } while (0)
#define PG8_MMA(ai, bj, At, Bt) do { __builtin_amdgcn_s_setprio(1); _Pragma("unroll") for (int m = 0; m < 4; ++m) _Pragma("unroll") for (int n = 0; n < 2; ++n) _Pragma("unroll") for (int k = 0; k < 2; ++k) \
        acc[ai][bj][m][n] = __builtin_amdgcn_mfma_f32_16x16x32_bf16(Bt[n][k], At[m][k], acc[ai][bj][m][n], 0, 0, 0); __builtin_amdgcn_s_setprio(0); } while (0)
#define PG8_WAIT_V(n) asm volatile("s_waitcnt vmcnt(" #n ")" ::: "memory")
#define PG8_WAIT_L(n) asm volatile("s_waitcnt lgkmcnt(" #n ")" ::: "memory")
#define PG8_BAR __builtin_amdgcn_s_barrier()
#define PG8_SCHED __builtin_amdgcn_sched_barrier(0)
    Unit cur, nxt; int ui = 0;
    if (!S.next(0, cur)) return;
    f32x4 acc[2][2][4][2];
#pragma unroll
    for (int a = 0; a < 2; ++a)
#pragma unroll
        for (int b = 0; b < 2; ++b)
#pragma unroll
            for (int m = 0; m < 4; ++m)
#pragma unroll
                for (int n = 0; n < 2; ++n) acc[a][b][m][n] = (f32x4){0.f, 0.f, 0.f, 0.f};
    bf16x8 At[4][2], B0[2][2], B1[2][2];
    const char* cA = (const char*)g.A + (size_t)cur.pm * tstep; const char* cB = (const char*)g.Bt + (size_t)cur.pn * tstep;
    S.a_ready(cur);
    if constexpr (SP2) {
        PG8_STAGE(PG8_SB(0, 0), cB, voffB); PG8_STAGE(PG8_SB(0, 1), cB + hstep, voffB); PG8_STAGE(PG8_SA(0, 0), cA, voffA); PG8_STAGE(PG8_SA(0, 1), cA + hstep, voffA);
        if (wr == 1) PG8_BAR;
        PG8_WAIT_V(2); PG8_BAR;
        PG8_STAGE(PG8_SB(1, 0), cB + kstep, voffB); PG8_STAGE(PG8_SA(1, 0), cA + kstep, voffA); PG8_STAGE(PG8_SB(1, 1), cB + hstep + kstep, voffB);
        PG8_WAIT_V(6); PG8_BAR;
    } else {
        PG8_STAGE(PG8_SB(0, 0), cB, voffB); PG8_STAGE(PG8_SA(0, 0), cA, voffA); PG8_STAGE(PG8_SB(0, 1), cB + hstep, voffB); PG8_STAGE(PG8_SA(0, 1), cA + hstep, voffA);
        if (wr == 1) PG8_BAR;
        PG8_WAIT_V(4); PG8_BAR;
        PG8_STAGE(PG8_SB(1, 0), cB + kstep, voffB); PG8_STAGE(PG8_SA(1, 0), cA + kstep, voffA); PG8_STAGE(PG8_SB(1, 1), cB + hstep + kstep, voffB);
        PG8_WAIT_V(6); PG8_BAR;
    }
    for (;;) {
        const bool has_next = S.next(ui + 1, nxt);
        const char* nA = has_next ? (const char*)g.A + (size_t)nxt.pm * tstep : cA; const char* nB = has_next ? (const char*)g.Bt + (size_t)nxt.pn * tstep : cB;
        for (int t = 0; t < nt; t += 2) {
            const bool last = (t == nt - 2);
            const char* a1 = cA + (size_t)(t + 1) * kstep;
            const char* a2 = last ? nA : cA + (size_t)(t + 2) * kstep; const char* b2 = last ? nB : cB + (size_t)(t + 2) * kstep;
            const char* a3 = a2 + kstep; const char* b3 = b2 + kstep;
            if (last && has_next) S.a_ready(nxt);
            if constexpr (SP2) {
            PG8_LDB(B0, 0, 0); PG8_LDB(B1, 0, 1); PG8_SCHED; PG8_LDA(At, 0, 0); PG8_STAGE(PG8_SA(1, 1), a1 + hstep, voffA);
            PG8_WAIT_V(8); PG8_WAIT_L(0); PG8_BAR; PG8_MMA(0, 0, At, B0); PG8_MMA(0, 1, At, B1); PG8_BAR; PG8_SCHED;
            PG8_LDA(At, 0, 1); PG8_STAGE(PG8_SB(0, 0), b2, voffB); PG8_STAGE(PG8_SB(0, 1), b2 + hstep, voffB); PG8_STAGE(PG8_SA(0, 0), a2, voffA);
            PG8_WAIT_V(8); PG8_WAIT_L(0); PG8_BAR; PG8_MMA(1, 0, At, B0); PG8_MMA(1, 1, At, B1); PG8_BAR; PG8_SCHED;
            PG8_LDB(B0, 1, 0); PG8_LDB(B1, 1, 1); PG8_SCHED; PG8_LDA(At, 1, 0); PG8_STAGE(PG8_SA(0, 1), a2 + hstep, voffA);
            PG8_WAIT_V(8); PG8_WAIT_L(0); PG8_BAR; PG8_MMA(0, 0, At, B0); PG8_MMA(0, 1, At, B1); PG8_BAR; PG8_SCHED;
            PG8_LDA(At, 1, 1); PG8_STAGE(PG8_SB(1, 0), b3, voffB); PG8_STAGE(PG8_SB(1, 1), b3 + hstep, voffB); PG8_STAGE(PG8_SA(1, 0), a3, voffA);
            PG8_WAIT_V(8); PG8_WAIT_L(0); PG8_BAR; PG8_MMA(1, 0, At, B0); PG8_MMA(1, 1, At, B1); PG8_BAR; PG8_SCHED;
            } else {
            PG8_LDB(B0, 0, 0); PG8_SCHED; PG8_LDA(At, 0, 0); PG8_STAGE(PG8_SA(1, 1), a1 + hstep, voffA);
            PG8_WAIT_L(8); PG8_BAR; PG8_WAIT_L(0); PG8_MMA(0, 0, At, B0); PG8_BAR; PG8_SCHED;
            PG8_LDB(B1, 0, 1); PG8_STAGE(PG8_SB(0, 0), b2, voffB);
            PG8_BAR; PG8_WAIT_L(0); PG8_MMA(0, 1, At, B1); PG8_BAR;
            PG8_LDA(At, 0, 1); PG8_STAGE(PG8_SA(0, 0), a2, voffA);
            PG8_BAR; PG8_WAIT_L(0); PG8_MMA(1, 0, At, B0); PG8_BAR; PG8_SCHED;
            PG8_STAGE(PG8_SB(0, 1), b2 + hstep, voffB);
            PG8_WAIT_V(6); PG8_BAR; PG8_MMA(1, 1, At, B1); PG8_BAR;
            PG8_LDB(B0, 1, 0); PG8_SCHED; PG8_LDA(At, 1, 0); PG8_STAGE(PG8_SA(0, 1), a2 + hstep, voffA);
            PG8_WAIT_L(8); PG8_BAR; PG8_WAIT_L(0); PG8_MMA(0, 0, At, B0); PG8_BAR; PG8_SCHED;
            PG8_LDB(B1, 1, 1); PG8_STAGE(PG8_SB(1, 0), b3, voffB);
            PG8_BAR; PG8_WAIT_L(0); PG8_MMA(0, 1, At, B1); PG8_BAR;
            PG8_LDA(At, 1, 1); PG8_STAGE(PG8_SA(1, 0), a3, voffA);
            PG8_BAR; PG8_WAIT_L(0); PG8_MMA(1, 0, At, B0); PG8_BAR; PG8_SCHED;
            PG8_STAGE(PG8_SB(1, 1), b3 + hstep, voffB);
            PG8_WAIT_V(6); PG8_BAR; PG8_MMA(1, 1, At, B1); PG8_BAR;
            }
        }
        if constexpr (ALIGN_EPI) { if (wr == 0) PG8_BAR; }
        if constexpr (!Epi::AFTER_DRAIN) { E(acc, cur, wr, wc, fr, fq); S.done(cur); }
        if (!has_next) break;
#pragma unroll
        for (int a = 0; a < 2; ++a)
#pragma unroll
            for (int b = 0; b < 2; ++b)
#pragma unroll
                for (int m = 0; m < 4; ++m)
#pragma unroll
                    for (int n = 0; n < 2; ++n) acc[a][b][m][n] = (f32x4){0.f, 0.f, 0.f, 0.f};
        cur = nxt; cA = nA; cB = nB; ++ui;
        if constexpr (ALIGN_EPI) { if (wr == 1) PG8_BAR; }
    }
    PG8_WAIT_V(0);
    if constexpr (!ALIGN_EPI) { if (wr == 0) PG8_BAR; }
    PG8_BAR;
    if constexpr (Epi::AFTER_DRAIN) { E.fused(acc, cur, wr, wc, fr, fq, lds, wid, lane); S.done(cur); }
#undef PG8_SA
#undef PG8_SB
#undef PG8_STAGE
#undef PG8_LDA
#undef PG8_LDB
#undef PG8_MMA
#undef PG8_WAIT_V
#undef PG8_WAIT_L
#undef PG8_BAR
#undef PG8_SCHED
}
}

constexpr int NWAVES = 8, NTHR = 512;
constexpr int BATCH = 2, SEQ = 8192, T = BATCH * SEQ, D = 1024, CHUNK = 64, NCH = SEQ / CHUNK;
constexpr int RH = 4, MH = 4, DFF = 2816, INC = 2496, NZ = 2560, NQM = 768, NKV = 1024, NGU = 2 * DFF, DPLE = 256;
constexpr float QSCALE = 0.07216878364870322f * 1.4426950408889634f;
#ifndef MK_N_LAUNCHES
#define MK_N_LAUNCHES 1
#endif
constexpr int PER_PHASE = 10;
constexpr int N_LAUNCHES = MK_N_LAUNCHES;

constexpr size_t MiB = 1u << 20;
constexpr size_t WS_CTL = 0, CTL_ZERO_BYTES = 1 * MiB;
constexpr size_t WS_SSQ = 256 * 1024;
constexpr size_t WS_WIN = 1 * MiB, WS_WUQ = 6 * MiB, WS_WUKV = 6 * MiB + 512 * 1024, WS_WO = 7 * MiB, WS_WGU = 9 * MiB, WS_WD = 20 * MiB, WS_WPG = 26 * MiB, WS_WPP = 28 * MiB;
constexpr size_t WS_RC = 29 * MiB, WS_RS = 33 * MiB, WS_MC = 37 * MiB, WS_MS = 39 * MiB;
constexpr size_t WS_XN = 42 * MiB;
constexpr size_t WS_RQ = 74 * MiB, WS_RK = 90 * MiB, WS_RV = 106 * MiB, WS_RG = 122 * MiB, WS_QM = 138 * MiB;
constexpr size_t WS_ACT = 74 * MiB;
constexpr size_t WS_CQ = 162 * MiB, WS_CKV = 170 * MiB, WS_KPE = 174 * MiB;
constexpr size_t WS_KVB = 176 * MiB;
constexpr size_t WS_CAT = 208 * MiB;
constexpr size_t WS_PB = 240 * MiB;
constexpr size_t WS_END = 248 * MiB;
constexpr int CW_TMO = 0, CW_CODE = 1, CW_BAR = 4096;

constexpr int RING_OFF = 0, RING_BYTES = 131072;
constexpr int LDS_BYTES = 163840;
constexpr int LDSCTL_OFF = LDS_BYTES - 1024, MISC_OFF = LDSCTL_OFF + 320;
#define GAS __attribute__((address_space(1)))
#define LAS __attribute__((address_space(3)))
typedef unsigned short bf16;
typedef unsigned v4u __attribute__((ext_vector_type(4)));
typedef float f32x4 __attribute__((ext_vector_type(4)));
typedef short bf16x8 __attribute__((ext_vector_type(8)));
typedef GAS unsigned gu32;
typedef GAS unsigned long long gu64;
#define RLX_AGENT __ATOMIC_RELAXED, __HIP_MEMORY_SCOPE_AGENT
#define LDS_WAIT() asm volatile("s_waitcnt lgkmcnt(0)" ::: "memory")
#define VM_WAIT() asm volatile("s_waitcnt vmcnt(0)" ::: "memory")
__device__ __forceinline__ unsigned long long rt() { return __builtin_amdgcn_s_memrealtime(); }
__device__ __forceinline__ unsigned f2bf(float f) { unsigned u = __builtin_bit_cast(unsigned, f); return (u + 0x7fffu + ((u >> 16) & 1u)) >> 16; }
__device__ __forceinline__ unsigned pk2(float lo, float hi) { return f2bf(lo) | (f2bf(hi) << 16); }

#define XB_TMO      128
#define XB_XCNT(j)  (256  + 64 * (j))
#define XB_XSUB(j)  (1280 + 64 * (j))
#define XB_XGEN(j)  (2304 + 64 * (j))
#define XB_TOP      3328
#define XB_TOPGEN   3392
#define XCD_BAR_WORDS 3456
#define XB_SPIN_CAP (1u << 18)

__device__ __forceinline__ unsigned xb_ld(unsigned* p)              { return __hip_atomic_load(p, __ATOMIC_RELAXED, __HIP_MEMORY_SCOPE_AGENT); }
__device__ __forceinline__ unsigned xb_add(unsigned* p, unsigned v) { return __hip_atomic_fetch_add(p, v, __ATOMIC_RELAXED, __HIP_MEMORY_SCOPE_AGENT); }
__device__ __forceinline__ unsigned xb_xcc_id() { return (unsigned)__builtin_amdgcn_s_getreg((3 << 11) | 20) & 0xFu; }
#define XB_SPIN(cond, bar) do { unsigned _sp = 0; while (cond) { __builtin_amdgcn_s_sleep(1); \
    if ((++_sp & 255u) == 0u) { if (xb_ld(&(bar)[XB_TMO])) break; if (_sp > XB_SPIN_CAP) { atomicAdd(&(bar)[XB_TMO], 1u); break; } } } } while (0)

struct XcdBarrier {
    unsigned* bar; unsigned x;
    volatile LAS unsigned* st;
};

__device__ __forceinline__ XcdBarrier xcd_barrier_post(unsigned* bar, volatile LAS unsigned* st) {
    XcdBarrier b; b.bar = bar; b.x = xb_xcc_id(); b.st = st;
    if (threadIdx.x == 0) (void)xb_add(&bar[XB_XCNT(b.x)], 1u);
    return b;
}
__device__ __forceinline__ void xcd_barrier_complete(unsigned* bar, unsigned x, unsigned& nloc, unsigned& nx) {
    const unsigned G = gridDim.x * gridDim.y * gridDim.z;
    unsigned sum, cnt, mine, sp = 0u;
    for (;;) {
        sum = 0u; cnt = 0u; mine = 0u;
#pragma unroll
        for (unsigned j = 0; j < 16; ++j) { const unsigned c = xb_ld(&bar[XB_XCNT(j)]); sum += c; cnt += (c > 0u) ? 1u : 0u; mine = (j == x) ? c : mine; }
        if (sum == G) break;
        __builtin_amdgcn_s_sleep(1);
        if ((++sp & 255u) == 0u) { if (xb_ld(&bar[XB_TMO])) break; if (sp > XB_SPIN_CAP) { atomicAdd(&bar[XB_TMO], 1u); break; } }
    }
    nloc = mine > 0u ? mine : 1u; nx = cnt > 0u ? cnt : 1u;
}

__device__ __forceinline__ void xcd_barrier(const XcdBarrier& b) {
    asm volatile("s_waitcnt vmcnt(0)" ::: "memory");
    __syncthreads();
    if (threadIdx.x == 0) {
        unsigned* bar = b.bar;
        __builtin_amdgcn_s_waitcnt(0);
        unsigned nloc = b.st[0], nx = b.st[1];
        if (nloc == 0u) { xcd_barrier_complete(bar, b.x, nloc, nx); b.st[0] = nloc; b.st[1] = nx; }
        const unsigned old = xb_add(&bar[XB_XSUB(b.x)], 1u);
        const unsigned gen = old / nloc;
        if (old + 1u == (gen + 1u) * nloc) {
            __builtin_amdgcn_fence(__ATOMIC_RELEASE, "agent");
            asm volatile("s_waitcnt vmcnt(0)" ::: "memory");
            const unsigned og = xb_add(&bar[XB_TOP], 1u);
            const unsigned tg = og / nx;
            if (og + 1u == (tg + 1u) * nx) xb_add(&bar[XB_TOPGEN], 1u);
            else XB_SPIN(xb_ld(&bar[XB_TOPGEN]) == tg, bar);
            __builtin_amdgcn_fence(__ATOMIC_ACQUIRE, "agent");
            xb_add(&bar[XB_XGEN(b.x)], 1u);
            asm volatile("s_waitcnt vmcnt(0)" ::: "memory");
        } else {
            XB_SPIN(xb_ld(&bar[XB_XGEN(b.x)]) == gen, bar);
            __builtin_amdgcn_fence(__ATOMIC_ACQUIRE, "agent");
            asm volatile("s_waitcnt vmcnt(0)" ::: "memory");
        }
    }
    __syncthreads();
}

struct Frame {
    LAS unsigned char* lds;
    volatile LAS unsigned* MISC;
    gu32* ctl;
    int tid, lane, wave, vcu, G;
};
__device__ __forceinline__ float bf2f(bf16 v) { return __uint_as_float((unsigned)v << 16); }
__device__ __forceinline__ float wave_sum(float v) {
#pragma unroll
    for (int o = 1; o < 64; o <<= 1) v += __shfl_xor(v, o);
    return v;
}
__device__ __forceinline__ float ret_logg(int h) { return log1pf(-exp2f(-5.0f - (float)h)); }

struct PArgs { const float *x, *p; const int* pos; const float *mix_g, *w_in, *qn_g, *w_uq, *kvn_g, *w_ukv, *w_o, *ffn_g, *w_g, *w_u, *w_d, *ple_g, *w_pg, *w_pp, *fin_g; };
__device__ __forceinline__ const float* p0_src(const PArgs& a, int kind, int n, float& cs) {
    cs = 1.0f;
    switch (kind) {
    case 0: {
        if (n < 1024) { const int g = n & 127; if (n >= 512) cs = 0.08838834764831845f; return a.w_in + (n & ~127) + (g >> 1) + 64 * (g & 1); }
        if (n < 2432) return a.w_in + n;
        if (n < 2496) { const int g = n - 2432; return a.w_in + 2432 + (g >> 1) + 32 * (g & 1); }
        return nullptr; }
    case 1: {
        if (n < 512) return a.w_uq + (n >> 7) * 192 + (n & 127);
        const int r = n - 512, g = r & 63; return a.w_uq + (r >> 6) * 192 + 128 + (g >> 1) + 32 * (g & 1); }
    case 2: return a.w_ukv + n;
    case 3: return a.w_o + n;
    case 4: { const int t = n >> 8, r = n & 255; return (r < 128 ? a.w_g : a.w_u) + 128 * t + (r & 127); }
    case 5: return a.w_d + n;
    case 6: return a.w_pg + n;
    default: return a.w_pp + n;
    }
}
__device__ __forceinline__ void p0_item(const PArgs& a, int kind, int ldw, int K, const float* gk, bf16* WT, LAS float* scr, int item, int nblk, int lane) {
    const int kb = item / nblk, nb = item % nblk, k0 = 64 * kb, n0 = 32 * nb;
    float cs; const float* src = p0_src(a, kind, n0 + (lane & 31), cs);
#pragma unroll 8
    for (int i = 0; i < 32; ++i) { const int kk = 2 * i + (lane >> 5); float v = 0.f;
        if (src) { v = src[(size_t)(k0 + kk) * ldw] * cs; if (gk) v *= gk[k0 + kk]; }
        scr[kk * 33 + (lane & 31)] = v; }
    LDS_WAIT(); asm volatile("" ::: "memory");
    const int c = lane & 7;
#pragma unroll
    for (int j = 0; j < 4; ++j) { const int n = (lane >> 3) + 8 * j; const LAS float* s = scr + (8 * c) * 33 + n;
        v4u o; o.x = pk2(s[0 * 33], s[1 * 33]); o.y = pk2(s[2 * 33], s[3 * 33]); o.z = pk2(s[4 * 33], s[5 * 33]); o.w = pk2(s[6 * 33], s[7 * 33]);
        *(GAS v4u*)(WT + (size_t)(n0 + n) * K + k0 + 8 * c) = o; }
    LDS_WAIT(); asm volatile("" ::: "memory");
}
__device__ __forceinline__ void p0_prologue(Frame& F, const PArgs& a, unsigned char* ws) {
    LAS float* scr = (LAS float*)(F.lds + RING_OFF + F.wave * 16384);
    const int gw = F.vcu * NWAVES + F.wave, NGW = F.G * NWAVES;
    constexpr int NMAT = 8;
    const int Ks[NMAT] = {1024, 256, 128, 1024, 1024, 2816, 1024, 256}, Ns[NMAT] = {NZ, NQM, NKV, 1024, NGU, 1024, 1024, 1024}, LDW[NMAT] = {INC, NQM, NKV, 1024, DFF, 1024, 1024, 1024};
    const size_t OFF[NMAT] = {WS_WIN, WS_WUQ, WS_WUKV, WS_WO, WS_WGU, WS_WD, WS_WPG, WS_WPP};
    int base = 0;
#pragma unroll
    for (int k = 0; k < NMAT; ++k) {
        const int nblk = Ns[k] / 32, nit = (Ks[k] / 64) * nblk;
        const float* gk = k == 1 ? a.qn_g : k == 2 ? a.kvn_g : k == 4 ? a.ffn_g : k == 6 ? a.ple_g : nullptr;
        int first = gw - (base % NGW); if (first < 0) first += NGW;
        for (int it = first; it < nit; it += NGW) p0_item(a, k, LDW[k], Ks[k], gk, (bf16*)(ws + OFF[k]), scr, it, nblk, F.lane);
        base += nit;
    }
    bf16* XN = (bf16*)(ws + WS_XN);
    for (int m = gw; m < T; m += NGW) {
        const GAS f32x4* xr = (const GAS f32x4*)(a.x + (size_t)m * D) + F.lane; const GAS f32x4* gr = (const GAS f32x4*)a.mix_g + F.lane;
        f32x4 v[4]; float s = 0.f;
#pragma unroll
        for (int j = 0; j < 4; ++j) { v[j] = xr[64 * j]; s += (v[j].x * v[j].x + v[j].y * v[j].y) + (v[j].z * v[j].z + v[j].w * v[j].w); }
        const float rs = 1.0f / sqrtf(wave_sum(s) * (1.0f / D) + 1e-6f);
        GAS unsigned long long* o8 = (GAS unsigned long long*)(XN + (size_t)m * D) + F.lane;
#pragma unroll
        for (int j = 0; j < 4; ++j) { const f32x4 g = gr[64 * j]; o8[64 * j] = (unsigned long long)pk2(v[j].x * rs * g.x, v[j].y * rs * g.y) | ((unsigned long long)pk2(v[j].z * rs * g.z, v[j].w * rs * g.w) << 32); }
    }
    { const int gt = F.vcu * NTHR + F.tid, NGT = F.G * NTHR; bf16* PB = (bf16*)(ws + WS_PB);
      for (int i = gt; i < T * DPLE / 4; i += NGT) { const f32x4 v = ((const GAS f32x4*)a.p)[i]; ((GAS unsigned long long*)PB)[i] = (unsigned long long)pk2(v.x, v.y) | ((unsigned long long)pk2(v.z, v.w) << 32); } }
    { const int gt = F.vcu * NTHR + F.tid, NGT = F.G * NTHR; float* RC = (float*)(ws + WS_RC); float* RS = (float*)(ws + WS_RS); float* MC = (float*)(ws + WS_MC); float* MS = (float*)(ws + WS_MS);
      for (int i = gt; i < T * 64; i += NGT) { const int t = i >> 6, k = i & 63; const float ang = (float)a.pos[t] * expf(-logf(10000.0f) * (float)k / 64.0f); RC[i] = cosf(ang); RS[i] = sinf(ang); }
      for (int i = gt; i < T * 32; i += NGT) { const int t = i >> 5, k = i & 31; const float ang = (float)a.pos[t] * expf(-logf(10000.0f) * (float)k / 32.0f); MC[i] = cosf(ang); MS[i] = sinf(ang); } }
}

__device__ __forceinline__ void ret_kv_simple(Frame& F, const bf16* RK, const bf16* RV, bf16* KVS) {
    LAS float* ks = (LAS float*)F.lds; LAS float* vs = ks + 64 * 128;
    for (int blk = F.vcu; blk < BATCH * NCH * RH; blk += F.G) {
        const int h = blk % RH, n = (blk / RH) % NCH, b = blk / (RH * NCH);
        const float lg = ret_logg(h); const size_t t0 = (size_t)b * SEQ + (size_t)n * CHUNK;
        for (int idx = F.tid; idx < 64 * 128; idx += NTHR) { const int j = idx >> 7, d = idx & 127;
            ks[idx] = bf2f(RK[(t0 + j) * 512 + h * 128 + d]) * expf(lg * (float)(CHUNK - 1 - j)); vs[idx] = bf2f(RV[(t0 + j) * 512 + h * 128 + d]); }
        __syncthreads();
        const int d = F.tid >> 2, e0 = (F.tid & 3) * 32;
        float acc[32];
#pragma unroll
        for (int e = 0; e < 32; ++e) acc[e] = 0.f;
        for (int j = 0; j < 64; ++j) { const float kd = ks[j * 128 + d];
#pragma unroll
            for (int e = 0; e < 32; ++e) acc[e] += kd * vs[j * 128 + e0 + e]; }
        GAS unsigned* o = (GAS unsigned*)(KVS + (size_t)blk * 16384 + d * 128 + e0);
#pragma unroll
        for (int e = 0; e < 16; ++e) o[e] = pk2(acc[2 * e], acc[2 * e + 1]);
        __syncthreads();
    }
}
__device__ __forceinline__ void ret_scan_simple(Frame& F, bf16* KVS) {
    for (int gid = F.vcu * NTHR + F.tid; gid < BATCH * RH * 16384; gid += F.G * NTHR) {
        const int de = gid & 16383, h = (gid >> 14) % RH, b = gid >> 16;
        const float c = expf(ret_logg(h) * (float)CHUNK); float S = 0.f;
        for (int n = 0; n < NCH; ++n) { bf16* p = KVS + ((size_t)((b * NCH + n) * RH + h)) * 16384 + de; const float kv = bf2f(*p); *p = (bf16)f2bf(S); S = c * S + kv; }
    }
}
__device__ __forceinline__ void ret_out_simple(Frame& F, const bf16* RQ, const bf16* RK, const bf16* RV, const bf16* RG, const bf16* PREV, bf16* CAT) {
    LAS float* qs = (LAS float*)F.lds; LAS float* ks = qs + 64 * 129; LAS float* vs = ks + 64 * 129; LAS float* ss = vs + 64 * 128;
    for (int blk = F.vcu; blk < BATCH * NCH * RH; blk += F.G) {
        const int h = blk % RH, n = (blk / RH) % NCH, b = blk / (RH * NCH);
        const float lg = ret_logg(h); const size_t t0 = (size_t)b * SEQ + (size_t)n * CHUNK;
        for (int idx = F.tid; idx < 64 * 128; idx += NTHR) { const int j = idx >> 7, d = idx & 127; const size_t g = (t0 + j) * 512 + h * 128 + d;
            qs[j * 129 + d] = bf2f(RQ[g]); ks[j * 129 + d] = bf2f(RK[g]); vs[j * 128 + d] = bf2f(RV[g]); }
        __syncthreads();
        { const int i = F.tid >> 3, jq = F.tid & 7;
          for (int jj = 0; jj < 8; ++jj) { const int j = jq * 8 + jj; float dot = 0.f;
              for (int d = 0; d < 128; ++d) dot += qs[i * 129 + d] * ks[j * 129 + d];
              const int dij = i > j ? i - j : j - i; ss[i * 65 + j] = dot * expf(lg * (float)dij); } }
        __syncthreads();
        const int e = F.tid & 127, ih = F.tid >> 7;
        float acc[16], acc2[16];
#pragma unroll
        for (int ii = 0; ii < 16; ++ii) { acc[ii] = 0.f; acc2[ii] = 0.f; }
        for (int j = 0; j < 64; ++j) { const float vv = vs[j * 128 + e];
#pragma unroll
            for (int ii = 0; ii < 16; ++ii) acc[ii] += ss[(ih * 16 + ii) * 65 + j] * vv; }
        const bf16* pv = PREV + (size_t)blk * 16384;
        for (int d = 0; d < 128; ++d) { const float p = bf2f(pv[d * 128 + e]);
#pragma unroll
            for (int ii = 0; ii < 16; ++ii) acc2[ii] += qs[(ih * 16 + ii) * 129 + d] * p; }
        __syncthreads();
        LAS float* os = qs;
#pragma unroll
        for (int ii = 0; ii < 16; ++ii) { const int i = ih * 16 + ii; os[i * 128 + e] = acc[ii] + expf(lg * (float)(i + 1)) * acc2[ii]; }
        __syncthreads();
        for (int r = 0; r < 8; ++r) { const int i = F.wave * 8 + r;
            const float a0 = os[i * 128 + F.lane], a1 = os[i * 128 + F.lane + 64];
            const float mu = wave_sum(a0 + a1) * (1.0f / 128.0f); const float d0 = a0 - mu, d1 = a1 - mu;
            const float rs = 1.0f / sqrtf(wave_sum(d0 * d0 + d1 * d1) * (1.0f / 128.0f) + 1e-5f);
            const float g0 = bf2f(RG[(t0 + i) * 512 + h * 128 + F.lane]), g1 = bf2f(RG[(t0 + i) * 512 + h * 128 + F.lane + 64]);
            bf16* orow = CAT + (t0 + i) * D + h * 128;
            orow[F.lane] = (bf16)f2bf(d0 * rs * (g0 / (1.0f + expf(-g0)))); orow[F.lane + 64] = (bf16)f2bf(d1 * rs * (g1 / (1.0f + expf(-g1)))); }
        __syncthreads();
    }
}
__device__ __forceinline__ void attn_simple(Frame& F, const bf16* QM, const bf16* KVB, const bf16* KPE, bf16* CAT) {
    LAS float* Qs = (LAS float*)F.lds; LAS float* Ks = Qs + 64 * 193; LAS float* Vs = Ks + 64 * 193; LAS float* Ss = Vs + 64 * 128;
    for (int i = 0;; ++i) {
        const int L = i * F.G + F.vcu; if (L >= BATCH * MH * NCH) break;
        const int bh = L & 7, x = (L >> 3) & 31, rnd = L >> 8; const int c = (rnd & 1) ? (rnd * 32 + x) : (rnd * 32 + 31 - x);
        const int h = bh & 3, b = bh >> 2;
        const size_t tq0 = (size_t)b * SEQ + (size_t)c * CHUNK;
        __syncthreads();
        for (int idx = F.tid; idx < 64 * 192; idx += NTHR) { const int r = idx / 192, d = idx % 192;
            Qs[r * 193 + d] = bf2f(d < 128 ? QM[(tq0 + r) * NQM + h * 128 + d] : QM[(tq0 + r) * NQM + 512 + h * 64 + (d - 128)]); }
        const int qi = F.tid >> 3, part = F.tid & 7;
        float m = -INFINITY, l = 0.f; float acc[16];
#pragma unroll
        for (int e = 0; e < 16; ++e) acc[e] = 0.f;
        for (int kt = 0; kt <= c; ++kt) {
            __syncthreads();
            const size_t tk0 = (size_t)b * SEQ + (size_t)kt * CHUNK;
            for (int idx = F.tid; idx < 64 * 192; idx += NTHR) { const int j = idx / 192, d = idx % 192;
                Ks[j * 193 + d] = bf2f(d < 128 ? KVB[(tk0 + j) * NKV + h * 256 + d] : KPE[(tk0 + j) * 64 + (d - 128)]); }
            for (int idx = F.tid; idx < 64 * 128; idx += NTHR) { const int j = idx >> 7, e = idx & 127; Vs[idx] = bf2f(KVB[(tk0 + j) * NKV + h * 256 + 128 + e]); }
            __syncthreads();
            for (int jj = 0; jj < 8; ++jj) { const int j = part * 8 + jj; float dot = 0.f;
                for (int d = 0; d < 192; ++d) dot += Qs[qi * 193 + d] * Ks[j * 193 + d];
                Ss[qi * 65 + j] = dot; }
            __syncthreads();
            float mx = m;
            for (int j = 0; j < 64; ++j) mx = fmaxf(mx, Ss[qi * 65 + j]);
            const float alpha = exp2f(m - mx); l *= alpha;
#pragma unroll
            for (int e = 0; e < 16; ++e) acc[e] *= alpha;
            for (int j = 0; j < 64; ++j) { const float p = exp2f(Ss[qi * 65 + j] - mx); l += p; const LAS float* vr = Vs + j * 128 + part * 16;
#pragma unroll
                for (int e = 0; e < 16; ++e) acc[e] += p * vr[e]; }
            m = mx;
        }
        const float il = 1.0f / l;
        GAS unsigned* o = (GAS unsigned*)(CAT + (tq0 + qi) * D + 512 + h * 128 + part * 16);
#pragma unroll
        for (int e = 0; e < 8; ++e) o[e] = pk2(acc[2 * e] * il, acc[2 * e + 1] * il);
    }
    __syncthreads();
}
__device__ __forceinline__ void final_norm(Frame& F, float* X, const float* ssq, const float* g) {
    const int gw = F.vcu * NWAVES + F.wave, NGW = F.G * NWAVES;
    for (int m = gw; m < T; m += NGW) {
        const float rs = 1.0f / sqrtf(ssq[m] * (1.0f / D) + 1e-6f);
        GAS f32x4* xr = (GAS f32x4*)(X + (size_t)m * D) + F.lane; const GAS f32x4* gr = (const GAS f32x4*)g + F.lane;
#pragma unroll
        for (int j = 0; j < 4; ++j) { const f32x4 v = xr[64 * j], gg = gr[64 * j]; xr[64 * j] = (f32x4){v.x * rs * gg.x, v.y * rs * gg.y, v.z * rs * gg.z, v.w * rs * gg.w}; }
    }
}

struct Args { PArgs in; float* out; unsigned char* ws; int ph_lo, ph_hi, li, pad; };
__global__ void __launch_bounds__(NTHR, 2) mk_fwd(Args args) {
    extern __shared__ __attribute__((aligned(16))) unsigned char lds[];
    Frame F;
    F.lds = (LAS unsigned char*)lds;
    F.MISC = (volatile LAS unsigned*)(F.lds + MISC_OFF);
    F.tid = threadIdx.x; F.lane = F.tid & 63; F.wave = __builtin_amdgcn_readfirstlane(F.tid >> 6);
    F.G = gridDim.x; { const int bx = blockIdx.x; F.vcu = (F.G % 8 == 0) ? (bx % 8) * (F.G / 8) + bx / 8 : bx; }
    unsigned char* ws = args.ws;
    F.ctl = (gu32*)(ws + WS_CTL);
    for (int u = F.tid; u < (LDS_BYTES - LDSCTL_OFF) / 4; u += NTHR) ((LAS unsigned*)(F.lds + LDSCTL_OFF))[u] = 0u;
    __syncthreads();
    XcdBarrier bar; bar.bar = (unsigned*)(F.ctl + CW_BAR); bar.x = 0; bar.st = nullptr;
    if (N_LAUNCHES != PER_PHASE) bar = xcd_barrier_post((unsigned*)(F.ctl + CW_BAR), F.MISC + 8);
#define GRID_BAR() do { if (N_LAUNCHES != PER_PHASE) xcd_barrier(bar); } while (0)
    const int lo = args.ph_lo, hi = args.ph_hi;
#define IN(k) (lo <= (k) && (k) < hi)
#define BOTH(k) (IN(k) && IN((k) + 1))
    bf16* XN = (bf16*)(ws + WS_XN); bf16* RQ = (bf16*)(ws + WS_RQ); bf16* RK = (bf16*)(ws + WS_RK); bf16* RV = (bf16*)(ws + WS_RV); bf16* RG = (bf16*)(ws + WS_RG);
    bf16* QM = (bf16*)(ws + WS_QM); bf16* CQ = (bf16*)(ws + WS_CQ); bf16* CKV = (bf16*)(ws + WS_CKV); bf16* KPE = (bf16*)(ws + WS_KPE); bf16* KVB = (bf16*)(ws + WS_KVB);
    bf16* CAT = (bf16*)(ws + WS_CAT); bf16* PB = (bf16*)(ws + WS_PB); bf16* ACT = (bf16*)(ws + WS_ACT); bf16* KVS = XN; bf16* X1B = XN; bf16* PROJ = KVB;
    float* SSQ = (float*)(ws + WS_SSQ); float* ssq_cq = SSQ; float* ssq_ckv = SSQ + T; float* ssq_x1 = SSQ + 2 * T; float* ssq_x2 = SSQ + 3 * T; float* ssq_x3 = SSQ + 4 * T;
    const float* RC = (const float*)(ws + WS_RC); const float* RS = (const float*)(ws + WS_RS); const float* MC = (const float*)(ws + WS_MC); const float* MS = (const float*)(ws + WS_MS);
    const int cid = (int)blockIdx.x;

    if (IN(0)) { p0_prologue(F, args.in, ws); if (BOTH(0)) GRID_BAR(); }
    if (IN(1)) {
        pg8::Gemm g{XN, (const bf16*)(ws + WS_WIN), T, NZ, D}; pg8::StaticOrder S; S.init(T, NZ, F.G, cid);
        pg8::EpiZ E{RQ, RK, RV, RG, CQ, CKV, KPE, RC, RS, MC, MS, ssq_cq, ssq_ckv};
        pg8::gemm_phase<pg8::EpiZ, pg8::StaticOrder, true, true>(F.lds + RING_OFF, g, S, E);
        if (BOTH(1)) GRID_BAR();
    }
    if (IN(2)) {
        { pg8::Gemm g{CQ, (const bf16*)(ws + WS_WUQ), T, NQM, 256}; pg8::StaticOrder S; S.init(T, NQM, F.G, cid);
          pg8::EpiQM E{QM, MC, MS, ssq_cq, QSCALE};
          pg8::gemm_phase<pg8::EpiQM, pg8::StaticOrder, true, true>(F.lds + RING_OFF, g, S, E); }
        { pg8::Gemm g{CKV, (const bf16*)(ws + WS_WUKV), T, NKV, 128}; pg8::StaticOrder S; S.init(T, NKV, F.G, cid);
          pg8::EpiScaleBf16 E{KVB, NKV, ssq_ckv, 1.0f / 128.0f};
          pg8::gemm_phase<pg8::EpiScaleBf16, pg8::StaticOrder, true, true>(F.lds + RING_OFF, g, S, E); }
        ret_kv_simple(F, RK, RV, KVS);
        if (BOTH(2)) GRID_BAR();
    }
    if (IN(3)) {
        ret_scan_simple(F, KVS);
        attn_simple(F, QM, KVB, KPE, CAT);
        if (BOTH(3)) GRID_BAR();
    }
    if (IN(4)) {
        ret_out_simple(F, RQ, RK, RV, RG, KVS, CAT);
        if (BOTH(4)) GRID_BAR();
    }
    if (IN(5)) {
        { pg8::Gemm g{CAT, (const bf16*)(ws + WS_WO), T, D, D}; pg8::StaticOrder S; S.init(T, D, F.G, cid);
          pg8::EpiRes E{args.in.x, args.out, X1B, ssq_x1};
          pg8::gemm_phase<pg8::EpiRes, pg8::StaticOrder, true, true>(F.lds + RING_OFF, g, S, E); }
        { pg8::Gemm g{PB, (const bf16*)(ws + WS_WPP), T, D, DPLE}; pg8::StaticOrder S; S.init(T, D, F.G, cid);
          pg8::EpiScaleBf16 E{PROJ, D, nullptr, 0.f};
          pg8::gemm_phase<pg8::EpiScaleBf16, pg8::StaticOrder, true, true>(F.lds + RING_OFF, g, S, E); }
        if (BOTH(5)) GRID_BAR();
    }
    if (IN(6)) {
        pg8::Gemm g{X1B, (const bf16*)(ws + WS_WGU), T, NGU, D}; pg8::StaticOrder S; S.init(T, NGU, F.G, cid);
        pg8::EpiGU E{ACT, DFF, ssq_x1};
        pg8::gemm_phase<pg8::EpiGU, pg8::StaticOrder, true, true>(F.lds + RING_OFF, g, S, E);
        if (BOTH(6)) GRID_BAR();
    }
    if (IN(7)) {
        pg8::Gemm g{ACT, (const bf16*)(ws + WS_WD), T, D, DFF}; pg8::StaticOrder S; S.init(T, D, F.G, cid);
        pg8::EpiRes E{args.out, args.out, X1B, ssq_x2};
        pg8::gemm_phase<pg8::EpiRes, pg8::StaticOrder, true, true>(F.lds + RING_OFF, g, S, E);
        if (BOTH(7)) GRID_BAR();
    }
    if (IN(8)) {
        pg8::Gemm g{X1B, (const bf16*)(ws + WS_WPG), T, D, D}; pg8::StaticOrder S; S.init(T, D, F.G, cid);
        pg8::EpiPle E{args.out, PROJ, ssq_x2, ssq_x3};
        pg8::gemm_phase<pg8::EpiPle, pg8::StaticOrder, true, true>(F.lds + RING_OFF, g, S, E);
        if (BOTH(8)) GRID_BAR();
    }
    if (IN(9)) final_norm(F, args.out, ssq_x3, args.in.fin_g);
#undef IN
#undef BOTH
}

extern "C" void kernel_launch(void* const* d_in, const int* in_sizes, int n_in, void* d_out, int out_size, void* d_ws, size_t ws_size, hipStream_t stream) {
    static int grid = 0;
    if (grid == 0) {
        if (n_in != 18 || out_size != T * D || ws_size < WS_END) { fprintf(stderr, "kernel_launch: unexpected shapes (n_in %d out %d ws %zu)\n", n_in, out_size, ws_size); grid = -1; return; }
        int dev = 0, cus = 0;
        if (hipGetDevice(&dev) != hipSuccess || hipDeviceGetAttribute(&cus, hipDeviceAttributeMultiprocessorCount, dev) != hipSuccess) { grid = -1; return; }
        if (hipFuncSetAttribute((const void*)mk_fwd, hipFuncAttributeMaxDynamicSharedMemorySize, LDS_BYTES) != hipSuccess) { fprintf(stderr, "kernel_launch: hipFuncSetAttribute failed\n"); grid = -1; return; }
        grid = cus;
    }
    if (grid < 0) return;
    if (hipMemsetAsync((char*)d_ws + WS_CTL, 0, CTL_ZERO_BYTES, stream) != hipSuccess) return;
    Args a{};
    const void** pp = (const void**)&a.in;
    for (int i = 0; i < 18; ++i) pp[i] = d_in[i];
    a.out = (float*)d_out; a.ws = (unsigned char*)d_ws;
    for (int li = 0; li < N_LAUNCHES; ++li) {
        a.ph_lo = (N_LAUNCHES == PER_PHASE) ? li : 0; a.ph_hi = (N_LAUNCHES == PER_PHASE) ? li + 1 : PER_PHASE; a.li = li;
        hipLaunchKernelGGL(mk_fwd, dim3(grid), dim3(NTHR), LDS_BYTES, stream, a);
    }
}
```

```cpp
#include <hip/hip_runtime.h>
#include <cstdio>
#include <cstdint>
#include <cmath>
#define MK_N_LAUNCHES 1
namespace pg8 {
#define PG8_LAS __attribute__((address_space(3)))
typedef unsigned short bf16_t;
typedef short bf16x8 __attribute__((ext_vector_type(8)));
typedef float f32x4 __attribute__((ext_vector_type(4)));
typedef unsigned u32x4 __attribute__((ext_vector_type(4)));
constexpr int BM = 256, BK = 64, HALF = 128, HTB = HALF * BK * 2  , STAGE_BYTES = 8 * HTB, NXCD = 8, WGM = 8;

__host__ __device__ __forceinline__ int lds_byte(int r, int c) { const int st = (r >> 4) * 2 + (c >> 5), rr = r & 15, cc = c & 31, ob = rr * 64 + cc * 2; return st * 1024 + (ob ^ (((ob >> 9) & 1) << 5)); }
__host__ __device__ __forceinline__ void stage_rc(int b, int& R, int& C) { const int st = b / 1024, sb = b % 1024, swz = sb ^ (((sb >> 9) & 1) << 5); R = (st >> 1) * 16 + swz / 64; C = (st & 1) * 32 + (swz % 64) / 2; }
__host__ __device__ __forceinline__ int perm32(int rho) { const int n = rho >> 4, i = rho & 15; return 8 * (i >> 2) + 4 * n + (i & 3); }

struct Unit { int pm, pn; };
struct Gemm { const bf16_t* A; const bf16_t* Bt; int M, N, K; };

struct StaticOrder {
    int nM, nN, nwg, G, c;
    __host__ __device__ void init(int M, int N, int G_, int c_) { nM = M / BM; nN = N / BM; nwg = nM * nN; G = G_; c = c_; }
    __host__ __device__ bool next(int i, Unit& u) const {
        const long L = (long)i * G + c; if (L >= nwg) return false;
        int wgid = (int)L; { const int q = nwg / NXCD, r = nwg % NXCD, xcd = wgid % NXCD, off = wgid / NXCD; wgid = (xcd < r ? xcd * (q + 1) : r * (q + 1) + (xcd - r) * q) + off; }
        const int nig = WGM * nN, gid = wgid / nig, fm = gid * WGM, gsz = (nM - fm) < WGM ? (nM - fm) : WGM;
        u.pm = fm + ((wgid % nig) % gsz); u.pn = (wgid % nig) / gsz; return true;
    }
    __device__ __forceinline__ void a_ready(const Unit&) const {}
    __device__ __forceinline__ void done(const Unit&) const {}
};

__device__ __forceinline__ unsigned cvt_pk_bf16(float lo, float hi) { unsigned r; asm volatile("v_cvt_pk_bf16_f32 %0, %1, %2" : "=v"(r) : "v"(lo), "v"(hi)); return r; }
__device__ __forceinline__ u32x4 pack8(const f32x4 v0, const f32x4 v1) { u32x4 w; w.x = cvt_pk_bf16(v0[0], v0[1]); w.y = cvt_pk_bf16(v0[2], v0[3]); w.z = cvt_pk_bf16(v1[0], v1[1]); w.w = cvt_pk_bf16(v1[2], v1[3]); return w; }
__device__ __forceinline__ float sq8(const f32x4 a, const f32x4 b) { return (a[0] * a[0] + a[1] * a[1]) + (a[2] * a[2] + a[3] * a[3]) + (b[0] * b[0] + b[1] * b[1]) + (b[2] * b[2] + b[3] * b[3]); }
__device__ __forceinline__ float fast_sigmoid(float v) { return __builtin_amdgcn_rcpf(1.0f + __builtin_amdgcn_exp2f(-1.4426950408889634f * v)); }
__device__ __forceinline__ void rope8(f32x4& v0, f32x4& v1, const f32x4 c, const f32x4 s) {
    const float a0 = v0[0] * c[0] - v0[1] * s[0], b0 = v0[1] * c[0] + v0[0] * s[0];
    const float a1 = v0[2] * c[1] - v0[3] * s[1], b1 = v0[3] * c[1] + v0[2] * s[1];
    const float a2 = v1[0] * c[2] - v1[1] * s[2], b2 = v1[1] * c[2] + v1[0] * s[2];
    const float a3 = v1[2] * c[3] - v1[3] * s[3], b3 = v1[3] * c[3] + v1[2] * s[3];
    v0 = (f32x4){a0, b0, a1, b1}; v1 = (f32x4){a2, b2, a3, b3};
}
__device__ __forceinline__ void ssq_add(float* ssq, int row, float s, int fq) { s += __shfl_xor(s, 16); s += __shfl_xor(s, 32); if (fq == 0) atomicAdd(ssq + row, s); }

#define EPI_ROWS_BEGIN _Pragma("unroll") for (int ai = 0; ai < 2; ++ai) _Pragma("unroll") for (int m = 0; m < 4; ++m) { const int row = row0 + ai * HALF + m * 16;
#define EPI_ROWS_END }

struct EpiZ {
    static constexpr bool PERM = true, AFTER_DRAIN = false;
    bf16_t *RQ, *RK, *RV, *RG, *CQ, *CKV, *KPE; const float *RC, *RS, *MC, *MS; float *ssq_cq, *ssq_ckv;
    __device__ __forceinline__ void operator()(const f32x4 (&acc)[2][2][4][2], const Unit& u, int wr, int wc, int fr, int fq) const {
        const int pn = u.pn, row0 = u.pm * BM + wr * 64 + fr, cw = wc * 32 + 8 * fq;
        if (pn < 4) {
            bf16_t* dst = (pn < 2 ? RQ : RK) + (pn & 1) * 256 + cw; const int i0 = 16 * wc + 4 * fq;
            EPI_ROWS_BEGIN
                const f32x4 c = *(const f32x4*)(RC + (size_t)row * 64 + i0), s = *(const f32x4*)(RS + (size_t)row * 64 + i0);
#pragma unroll
                for (int bj = 0; bj < 2; ++bj) { f32x4 v0 = acc[ai][bj][m][0], v1 = acc[ai][bj][m][1]; rope8(v0, v1, c, s); *(u32x4*)(dst + (size_t)row * 512 + bj * HALF) = pack8(v0, v1); }
            EPI_ROWS_END
        } else if (pn < 8) {
            bf16_t* dst = (pn < 6 ? RV : RG) + (pn & 1) * 256 + cw;
            EPI_ROWS_BEGIN
#pragma unroll
                for (int bj = 0; bj < 2; ++bj) *(u32x4*)(dst + (size_t)row * 512 + bj * HALF) = pack8(acc[ai][bj][m][0], acc[ai][bj][m][1]);
            EPI_ROWS_END
        } else if (pn == 8) {
            EPI_ROWS_BEGIN
                float s = 0.f;
#pragma unroll
                for (int bj = 0; bj < 2; ++bj) { *(u32x4*)(CQ + (size_t)row * 256 + bj * HALF + cw) = pack8(acc[ai][bj][m][0], acc[ai][bj][m][1]); s += sq8(acc[ai][bj][m][0], acc[ai][bj][m][1]); }
                ssq_add(ssq_cq, row, s, fq);
            EPI_ROWS_END
        } else {
            const int i0 = 16 * wc + 4 * fq;
            EPI_ROWS_BEGIN
                *(u32x4*)(CKV + (size_t)row * 128 + cw) = pack8(acc[ai][0][m][0], acc[ai][0][m][1]);
                ssq_add(ssq_ckv, row, sq8(acc[ai][0][m][0], acc[ai][0][m][1]), fq);
                if (wc < 2) { const f32x4 c = *(const f32x4*)(MC + (size_t)row * 32 + i0), s = *(const f32x4*)(MS + (size_t)row * 32 + i0);
                    f32x4 v0 = acc[ai][1][m][0], v1 = acc[ai][1][m][1]; rope8(v0, v1, c, s); *(u32x4*)(KPE + (size_t)row * 64 + cw) = pack8(v0, v1); }
            EPI_ROWS_END
        }
    }
};
struct EpiQM {
    static constexpr bool PERM = true, AFTER_DRAIN = false;
    bf16_t* QM; const float *MC, *MS; const float* ssq; float qscale;
    __device__ __forceinline__ void operator()(const f32x4 (&acc)[2][2][4][2], const Unit& u, int wr, int wc, int fr, int fq) const {
        const int pn = u.pn, row0 = u.pm * BM + wr * 64 + fr, cw = wc * 32 + 8 * fq; const int i0 = 16 * (wc & 1) + 4 * fq;
        EPI_ROWS_BEGIN
            const float rs = qscale / sqrtf(ssq[row] * (1.0f / 256.0f) + 1e-6f);
            f32x4 c, s; if (pn == 2) { c = *(const f32x4*)(MC + (size_t)row * 32 + i0); s = *(const f32x4*)(MS + (size_t)row * 32 + i0); }
#pragma unroll
            for (int bj = 0; bj < 2; ++bj) { f32x4 v0 = acc[ai][bj][m][0] * rs, v1 = acc[ai][bj][m][1] * rs; if (pn == 2) rope8(v0, v1, c, s);
                *(u32x4*)(QM + (size_t)row * 768 + pn * 256 + bj * HALF + cw) = pack8(v0, v1); }
        EPI_ROWS_END
    }
};
struct EpiScaleBf16 {
    static constexpr bool PERM = true, AFTER_DRAIN = false;
    bf16_t* O; int ldc; const float* ssq; float inv_n;
    __device__ __forceinline__ void operator()(const f32x4 (&acc)[2][2][4][2], const Unit& u, int wr, int wc, int fr, int fq) const {
        const int row0 = u.pm * BM + wr * 64 + fr, col0 = u.pn * BM + wc * 32 + 8 * fq;
        EPI_ROWS_BEGIN
            const float rs = ssq ? 1.0f / sqrtf(ssq[row] * inv_n + 1e-6f) : 1.0f;
#pragma unroll
            for (int bj = 0; bj < 2; ++bj) *(u32x4*)(O + (size_t)row * ldc + col0 + bj * HALF) = pack8(acc[ai][bj][m][0] * rs, acc[ai][bj][m][1] * rs);
        EPI_ROWS_END
    }
};
struct EpiRes {
    static constexpr bool PERM = true, AFTER_DRAIN = false;
    const float* base; float* X; bf16_t* XB; float* ssq;
    __device__ __forceinline__ void operator()(const f32x4 (&acc)[2][2][4][2], const Unit& u, int wr, int wc, int fr, int fq) const {
        const int row0 = u.pm * BM + wr * 64 + fr, col0 = u.pn * BM + wc * 32 + 8 * fq;
        EPI_ROWS_BEGIN
            float s = 0.f;
#pragma unroll
            for (int bj = 0; bj < 2; ++bj) { const size_t off = (size_t)row * 1024 + col0 + bj * HALF;
                const f32x4 v0 = acc[ai][bj][m][0] + *(const f32x4*)(base + off), v1 = acc[ai][bj][m][1] + *(const f32x4*)(base + off + 4);
                *(f32x4*)(X + off) = v0; *(f32x4*)(X + off + 4) = v1; *(u32x4*)(XB + off) = pack8(v0, v1); s += sq8(v0, v1); }
            ssq_add(ssq, row, s, fq);
        EPI_ROWS_END
    }
};
struct EpiGU {
    static constexpr bool PERM = true, AFTER_DRAIN = false;
    bf16_t* ACT; int ldc; const float* ssq;
    __device__ __forceinline__ void operator()(const f32x4 (&acc)[2][2][4][2], const Unit& u, int wr, int wc, int fr, int fq) const {
        const int row0 = u.pm * BM + wr * 64 + fr, col0 = u.pn * HALF + wc * 32 + 8 * fq;
        EPI_ROWS_BEGIN
            const float rs = 1.0f / sqrtf(ssq[row] * (1.0f / 1024.0f) + 1e-6f);
            f32x4 o[2];
#pragma unroll
            for (int n = 0; n < 2; ++n) { const f32x4 g = acc[ai][0][m][n] * rs, up = acc[ai][1][m][n] * rs;
#pragma unroll
                for (int q = 0; q < 4; ++q) o[n][q] = g[q] * fast_sigmoid(g[q]) * up[q]; }
            *(u32x4*)(ACT + (size_t)row * ldc + col0) = pack8(o[0], o[1]);
        EPI_ROWS_END
    }
};
struct EpiPle {
    static constexpr bool PERM = true, AFTER_DRAIN = false;
    float* X; const bf16_t* PROJ; const float* ssq_in; float* ssq_out;
    __device__ __forceinline__ void operator()(const f32x4 (&acc)[2][2][4][2], const Unit& u, int wr, int wc, int fr, int fq) const {
        const int row0 = u.pm * BM + wr * 64 + fr, col0 = u.pn * BM + wc * 32 + 8 * fq;
        EPI_ROWS_BEGIN
            const float rs = 1.0f / sqrtf(ssq_in[row] * (1.0f / 1024.0f) + 1e-6f);
            float s = 0.f;
#pragma unroll
            for (int bj = 0; bj < 2; ++bj) { const size_t off = (size_t)row * 1024 + col0 + bj * HALF;
                const u32x4 pw = *(const u32x4*)(PROJ + off); const f32x4 x0 = *(const f32x4*)(X + off), x1 = *(const f32x4*)(X + off + 4);
                const f32x4 p0 = {__uint_as_float(pw.x << 16), __uint_as_float(pw.x & 0xffff0000u), __uint_as_float(pw.y << 16), __uint_as_float(pw.y & 0xffff0000u)};
                const f32x4 p1 = {__uint_as_float(pw.z << 16), __uint_as_float(pw.z & 0xffff0000u), __uint_as_float(pw.w << 16), __uint_as_float(pw.w & 0xffff0000u)};
                f32x4 v0, v1;
#pragma unroll
                for (int q = 0; q < 4; ++q) { v0[q] = x0[q] + fast_sigmoid(acc[ai][bj][m][0][q] * rs) * p0[q]; v1[q] = x1[q] + fast_sigmoid(acc[ai][bj][m][1][q] * rs) * p1[q]; }
                *(f32x4*)(X + off) = v0; *(f32x4*)(X + off + 4) = v1; s += sq8(v0, v1); }
            ssq_add(ssq_out, row, s, fq);
        EPI_ROWS_END
    }
};
template <class Epi, class Sched, bool ALIGN_EPI = false, bool SP2 = false>
__device__ __forceinline__ void gemm_phase(PG8_LAS unsigned char* lds, const Gemm g, const Sched& S, const Epi& E) {
    const int tid = threadIdx.x, wid = __builtin_amdgcn_readfirstlane(tid >> 6), lane = tid & 63, wr = wid >> 2, wc = wid & 3, fr = lane & 15, fq = lane >> 4;
    int Kop = g.K; asm volatile("" : "+s"(Kop));
    const int K = Kop, nt = K / BK;
    unsigned voffA[2], voffB[2];
#pragma unroll
    for (int i = 0; i < 2; ++i) { int R, C; stage_rc(tid * 16 + i * 8192, R, C); const int Rb = Epi::PERM ? ((R & ~31) + perm32(R & 31)) : R;
        voffA[i] = (unsigned)(R * K + C) * 2u; voffB[i] = (unsigned)(Rb * K + C) * 2u; }
    const size_t kstep = (size_t)(BK * 2);
    const size_t hstep = (size_t)HALF * K * 2;
    const size_t tstep = 2 * hstep;
    const unsigned ldsw = (unsigned)wid * 1024u;
    const int aoff = lds_byte(wr * 64 + fr, fq * 8), boff = lds_byte(wc * 32 + fr, fq * 8);
#define PG8_SA(b, h) (((b) * 2 + (h)) * HTB)
#define PG8_SB(b, h) ((4 + (b) * 2 + (h)) * HTB)
#define PG8_STAGE(bufoff, gbase, voff) do { _Pragma("unroll") for (int _i = 0; _i < 2; ++_i) \
        __builtin_amdgcn_global_load_lds((const unsigned*)((const char*)(gbase) + (voff)[_i]), (PG8_LAS unsigned*)(lds + (bufoff) + ldsw + _i * 8192), 16, 0, 0); } while (0)
#define PG8_LDA(dst, b, h) do { _Pragma("unroll") for (int m = 0; m < 4; ++m) _Pragma("unroll") for (int k = 0; k < 2; ++k) dst[m][k] = *(const PG8_LAS bf16x8*)(lds + PG8_SA(b, h) + aoff + m * 2048 + k * 1024); } while (0)
#define PG8_LDB(dst, b, h) do { _Pragma("unroll") for (int n = 0; n < 2; ++n) _Pragma("unroll") for (int k = 0; k < 2; ++k) dst[n][k] = *(const PG8_LAS bf16x8*)(lds + PG8_SB(b, h) + boff + n * 2048 + k * 1024); } while (0)
#define PG8_MMA(ai, bj, At, Bt) do { __builtin_amdgcn_s_setprio(1); _Pragma("unroll") for (int m = 0; m < 4; ++m) _Pragma("unroll") for (int n = 0; n < 2; ++n) _Pragma("unroll") for (int k = 0; k < 2; ++k) \
        acc[ai][bj][m][n] = __builtin_amdgcn_mfma_f32_16x16x32_bf16(Bt[n][k], At[m][k], acc[ai][bj][m][n], 0, 0, 0); __builtin_amdgcn_s_setprio(0); } while (0)
#define PG8_WAIT_V(n) asm volatile("s_waitcnt vmcnt(" #n ")" ::: "memory")
#define PG8_WAIT_L(n) asm volatile("s_waitcnt lgkmcnt(" #n ")" ::: "memory")
#define PG8_BAR __builtin_amdgcn_s_barrier()
#define PG8_SCHED __builtin_amdgcn_sched_barrier(0)
    Unit cur, nxt; int ui = 0;
    if (!S.next(0, cur)) return;
    f32x4 acc[2][2][4][2];
#pragma unroll
    for (int a = 0; a < 2; ++a)
#pragma unroll
        for (int b = 0; b < 2; ++b)
#pragma unroll
            for (int m = 0; m < 4; ++m)
#pragma unroll
                for (int n = 0; n < 2; ++n) acc[a][b][m][n] = (f32x4){0.f, 0.f, 0.f, 0.f};
    bf16x8 At[4][2], B0[2][2], B1[2][2];
    const char* cA = (const char*)g.A + (size_t)cur.pm * tstep; const char* cB = (const char*)g.Bt + (size_t)cur.pn * tstep;
    S.a_ready(cur);
    if constexpr (SP2) {
        PG8_STAGE(PG8_SB(0, 0), cB, voffB); PG8_STAGE(PG8_SB(0, 1), cB + hstep, voffB); PG8_STAGE(PG8_SA(0, 0), cA, voffA); PG8_STAGE(PG8_SA(0, 1), cA + hstep, voffA);
        if (wr == 1) PG8_BAR;
        PG8_WAIT_V(2); PG8_BAR;
        PG8_STAGE(PG8_SB(1, 0), cB + kstep, voffB); PG8_STAGE(PG8_SA(1, 0), cA + kstep, voffA); PG8_STAGE(PG8_SB(1, 1), cB + hstep + kstep, voffB);
        PG8_WAIT_V(6); PG8_BAR;
    } else {
        PG8_STAGE(PG8_SB(0, 0), cB, voffB); PG8_STAGE(PG8_SA(0, 0), cA, voffA); PG8_STAGE(PG8_SB(0, 1), cB + hstep, voffB); PG8_STAGE(PG8_SA(0, 1), cA + hstep, voffA);
        if (wr == 1) PG8_BAR;
        PG8_WAIT_V(4); PG8_BAR;
        PG8_STAGE(PG8_SB(1, 0), cB + kstep, voffB); PG8_STAGE(PG8_SA(1, 0), cA + kstep, voffA); PG8_STAGE(PG8_SB(1, 1), cB + hstep + kstep, voffB);
        PG8_WAIT_V(6); PG8_BAR;
    }
    for (;;) {
        const bool has_next = S.next(ui + 1, nxt);
        const char* nA = has_next ? (const char*)g.A + (size_t)nxt.pm * tstep : cA; const char* nB = has_next ? (const char*)g.Bt + (size_t)nxt.pn * tstep : cB;
        for (int t = 0; t < nt; t += 2) {
            const bool last = (t == nt - 2);
            const char* a1 = cA + (size_t)(t + 1) * kstep;
            const char* a2 = last ? nA : cA + (size_t)(t + 2) * kstep; const char* b2 = last ? nB : cB + (size_t)(t + 2) * kstep;
            const char* a3 = a2 + kstep; const char* b3 = b2 + kstep;
            if (last && has_next) S.a_ready(nxt);
            if constexpr (SP2) {
            PG8_LDB(B0, 0, 0); PG8_LDB(B1, 0, 1); PG8_SCHED; PG8_LDA(At, 0, 0); PG8_STAGE(PG8_SA(1, 1), a1 + hstep, voffA);
            PG8_WAIT_V(8); PG8_WAIT_L(0); PG8_BAR; PG8_MMA(0, 0, At, B0); PG8_MMA(0, 1, At, B1); PG8_BAR; PG8_SCHED;
            PG8_LDA(At, 0, 1); PG8_STAGE(PG8_SB(0, 0), b2, voffB); PG8_STAGE(PG8_SB(0, 1), b2 + hstep, voffB); PG8_STAGE(PG8_SA(0, 0), a2, voffA);
            PG8_WAIT_V(8); PG8_WAIT_L(0); PG8_BAR; PG8_MMA(1, 0, At, B0); PG8_MMA(1, 1, At, B1); PG8_BAR; PG8_SCHED;
            PG8_LDB(B0, 1, 0); PG8_LDB(B1, 1, 1); PG8_SCHED; PG8_LDA(At, 1, 0); PG8_STAGE(PG8_SA(0, 1), a2 + hstep, voffA);
            PG8_WAIT_V(8); PG8_WAIT_L(0); PG8_BAR; PG8_MMA(0, 0, At, B0); PG8_MMA(0, 1, At, B1); PG8_BAR; PG8_SCHED;
            PG8_LDA(At, 1, 1); PG8_STAGE(PG8_SB(1, 0), b3, voffB); PG8_STAGE(PG8_SB(1, 1), b3 + hstep, voffB); PG8_STAGE(PG8_SA(1, 0), a3, voffA);
            PG8_WAIT_V(8); PG8_WAIT_L(0); PG8_BAR; PG8_MMA(1, 0, At, B0); PG8_MMA(1, 1, At, B1); PG8_BAR; PG8_SCHED;
            } else {
            PG8_LDB(B0, 0, 0); PG8_SCHED; PG8_LDA(At, 0, 0); PG8_STAGE(PG8_SA(1, 1), a1 + hstep, voffA);
            PG8_WAIT_L(8); PG8_BAR; PG8_WAIT_L(0); PG8_MMA(0, 0, At, B0); PG8_BAR; PG8_SCHED;
            PG8_LDB(B1, 0, 1); PG8_STAGE(PG8_SB(0, 0), b2, voffB);
            PG8_BAR; PG8_WAIT_L(0); PG8_MMA(0, 1, At, B1); PG8_BAR;
            PG8_LDA(At, 0, 1); PG8_STAGE(PG8_SA(0, 0), a2, voffA);
            PG8_BAR; PG8_WAIT_L(0); PG8_MMA(1, 0, At, B0); PG8_BAR; PG8_SCHED;
            PG8_STAGE(PG8_SB(0, 1), b2 + hstep, voffB);
            PG8_WAIT_V(6); PG8_BAR; PG8_MMA(1, 1, At, B1); PG8_BAR;
            PG8_LDB(B0, 1, 0); PG8_SCHED; PG8_LDA(At, 1, 0); PG8_STAGE(PG8_SA(0, 1), a2 + hstep, voffA);
            PG8_WAIT_L(8); PG8_BAR; PG8_WAIT_L(0); PG8_MMA(0, 0, At, B0); PG8_BAR; PG8_SCHED;
            PG8_LDB(B1, 1, 1); PG8_STAGE(PG8_SB(1, 0), b3, voffB);
            PG8_BAR; PG8_WAIT_L(0); PG8_MMA(0, 1, At, B1); PG8_BAR;
            PG8_LDA(At, 1, 1); PG8_STAGE(PG8_SA(1, 0), a3, voffA);
            PG8_BAR; PG8_WAIT_L(0); PG8_MMA(1, 0, At, B0); PG8_BAR; PG8_SCHED;
            PG8_STAGE(PG8_SB(1, 1), b3 + hstep, voffB);
            PG8_WAIT_V(6); PG8_BAR; PG8_MMA(1, 1, At, B1); PG8_BAR;
            }
        }
        if constexpr (ALIGN_EPI) { if (wr == 0) PG8_BAR; }
        if constexpr (!Epi::AFTER_DRAIN) { E(acc, cur, wr, wc, fr, fq); S.done(cur); }
        if (!has_next) break;
#pragma unroll
        for (int a = 0; a < 2; ++a)
#pragma unroll
            for (int b = 0; b < 2; ++b)
#pragma unroll
                for (int m = 0; m < 4; ++m)
#pragma unroll
                    for (int n = 0; n < 2; ++n) acc[a][b][m][n] = (f32x4){0.f, 0.f, 0.f, 0.f};
        cur = nxt; cA = nA; cB = nB; ++ui;
        if constexpr (ALIGN_EPI) { if (wr == 1) PG8_BAR; }
    }
    PG8_WAIT_V(0);
    if constexpr (!ALIGN_EPI) { if (wr == 0) PG8_BAR; }
    PG8_BAR;
    if constexpr (Epi::AFTER_DRAIN) { E.fused(acc, cur, wr, wc, fr, fq, lds, wid, lane); S.done(cur); }
#undef PG8_SA
#undef PG8_SB
#undef PG8_STAGE
#undef PG8_LDA
#undef PG8_LDB
#undef PG8_MMA
#undef PG8_WAIT_V
#undef PG8_WAIT_L
#undef PG8_BAR
#undef PG8_SCHED
}
}

constexpr int NWAVES = 8, NTHR = 512;
constexpr int BATCH = 2, SEQ = 8192, T = BATCH * SEQ, D = 1024, CHUNK = 64, NCH = SEQ / CHUNK;
constexpr int RH = 4, MH = 4, DFF = 2816, INC = 2496, NZ = 2560, NQM = 768, NKV = 1024, NGU = 2 * DFF, DPLE = 256;
constexpr float QSCALE = 0.07216878364870322f * 1.4426950408889634f;
#ifndef MK_N_LAUNCHES
#define MK_N_LAUNCHES 1
#endif
constexpr int PER_PHASE = 10;
constexpr int N_LAUNCHES = MK_N_LAUNCHES;

constexpr size_t MiB = 1u << 20;
constexpr size_t WS_CTL = 0, CTL_ZERO_BYTES = 1 * MiB;
constexpr size_t WS_SSQ = 256 * 1024;
constexpr size_t WS_WIN = 1 * MiB, WS_WUQ = 6 * MiB, WS_WUKV = 6 * MiB + 512 * 1024, WS_WO = 7 * MiB, WS_WGU = 9 * MiB, WS_WD = 20 * MiB, WS_WPG = 26 * MiB, WS_WPP = 28 * MiB;
constexpr size_t WS_RC = 29 * MiB, WS_RS = 33 * MiB, WS_MC = 37 * MiB, WS_MS = 39 * MiB;
constexpr size_t WS_XN = 42 * MiB;
constexpr size_t WS_RQ = 74 * MiB, WS_RK = 90 * MiB, WS_RV = 106 * MiB, WS_RG = 122 * MiB, WS_QM = 138 * MiB;
constexpr size_t WS_ACT = 74 * MiB;
constexpr size_t WS_CQ = 162 * MiB, WS_CKV = 170 * MiB, WS_KPE = 174 * MiB;
constexpr size_t WS_KVB = 176 * MiB;
constexpr size_t WS_CAT = 208 * MiB;
constexpr size_t WS_PB = 240 * MiB;
constexpr size_t WS_END = 248 * MiB;
constexpr int CW_TMO = 0, CW_CODE = 1, CW_BAR = 4096;

constexpr int RING_OFF = 0, RING_BYTES = 131072;
constexpr int LDS_BYTES = 163840;
constexpr int LDSCTL_OFF = LDS_BYTES - 1024, MISC_OFF = LDSCTL_OFF + 320;
#define GAS __attribute__((address_space(1)))
#define LAS __attribute__((address_space(3)))
typedef unsigned short bf16;
typedef unsigned v4u __attribute__((ext_vector_type(4)));
typedef float f32x4 __attribute__((ext_vector_type(4)));
typedef short bf16x8 __attribute__((ext_vector_type(8)));
typedef GAS unsigned gu32;
typedef GAS unsigned long long gu64;
#define RLX_AGENT __ATOMIC_RELAXED, __HIP_MEMORY_SCOPE_AGENT
#define LDS_WAIT() asm volatile("s_waitcnt lgkmcnt(0)" ::: "memory")
#define VM_WAIT() asm volatile("s_waitcnt vmcnt(0)" ::: "memory")
__device__ __forceinline__ unsigned long long rt() { return __builtin_amdgcn_s_memrealtime(); }
__device__ __forceinline__ unsigned f2bf(float f) { unsigned u = __builtin_bit_cast(unsigned, f); return (u + 0x7fffu + ((u >> 16) & 1u)) >> 16; }
__device__ __forceinline__ unsigned pk2(float lo, float hi) { return f2bf(lo) | (f2bf(hi) << 16); }

#define XB_TMO      128
#define XB_XCNT(j)  (256  + 64 * (j))
#define XB_XSUB(j)  (1280 + 64 * (j))
#define XB_XGEN(j)  (2304 + 64 * (j))
#define XB_TOP      3328
#define XB_TOPGEN   3392
#define XCD_BAR_WORDS 3456
#define XB_SPIN_CAP (1u << 18)

__device__ __forceinline__ unsigned xb_ld(unsigned* p)              { return __hip_atomic_load(p, __ATOMIC_RELAXED, __HIP_MEMORY_SCOPE_AGENT); }
__device__ __forceinline__ unsigned xb_add(unsigned* p, unsigned v) { return __hip_atomic_fetch_add(p, v, __ATOMIC_RELAXED, __HIP_MEMORY_SCOPE_AGENT); }
__device__ __forceinline__ unsigned xb_xcc_id() { return (unsigned)__builtin_amdgcn_s_getreg((3 << 11) | 20) & 0xFu; }
#define XB_SPIN(cond, bar) do { unsigned _sp = 0; while (cond) { __builtin_amdgcn_s_sleep(1); \
    if ((++_sp & 255u) == 0u) { if (xb_ld(&(bar)[XB_TMO])) break; if (_sp > XB_SPIN_CAP) { atomicAdd(&(bar)[XB_TMO], 1u); break; } } } } while (0)

struct XcdBarrier {
    unsigned* bar; unsigned x;
    volatile LAS unsigned* st;
};

__device__ __forceinline__ XcdBarrier xcd_barrier_post(unsigned* bar, volatile LAS unsigned* st) {
    XcdBarrier b; b.bar = bar; b.x = xb_xcc_id(); b.st = st;
    if (threadIdx.x == 0) (void)xb_add(&bar[XB_XCNT(b.x)], 1u);
    return b;
}
__device__ __forceinline__ void xcd_barrier_complete(unsigned* bar, unsigned x, unsigned& nloc, unsigned& nx) {
    const unsigned G = gridDim.x * gridDim.y * gridDim.z;
    unsigned sum, cnt, mine, sp = 0u;
    for (;;) {
        sum = 0u; cnt = 0u; mine = 0u;
#pragma unroll
        for (unsigned j = 0; j < 16; ++j) { const unsigned c = xb_ld(&bar[XB_XCNT(j)]); sum += c; cnt += (c > 0u) ? 1u : 0u; mine = (j == x) ? c : mine; }
        if (sum == G) break;
        __builtin_amdgcn_s_sleep(1);
        if ((++sp & 255u) == 0u) { if (xb_ld(&bar[XB_TMO])) break; if (sp > XB_SPIN_CAP) { atomicAdd(&bar[XB_TMO], 1u); break; } }
    }
    nloc = mine > 0u ? mine : 1u; nx = cnt > 0u ? cnt : 1u;
}

__device__ __forceinline__ void xcd_barrier(const XcdBarrier& b) {
    asm volatile("s_waitcnt vmcnt(0)" ::: "memory");
    __syncthreads();
    if (threadIdx.x == 0) {
        unsigned* bar = b.bar;
        __builtin_amdgcn_s_waitcnt(0);
        unsigned nloc = b.st[0], nx = b.st[1];
        if (nloc == 0u) { xcd_barrier_complete(bar, b.x, nloc, nx); b.st[0] = nloc; b.st[1] = nx; }
        const unsigned old = xb_add(&bar[XB_XSUB(b.x)], 1u);
        const unsigned gen = old / nloc;
        if (old + 1u == (gen + 1u) * nloc) {
            __builtin_amdgcn_fence(__ATOMIC_RELEASE, "agent");
            asm volatile("s_waitcnt vmcnt(0)" ::: "memory");
            const unsigned og = xb_add(&bar[XB_TOP], 1u);
            const unsigned tg = og / nx;
            if (og + 1u == (tg + 1u) * nx) xb_add(&bar[XB_TOPGEN], 1u);
            else XB_SPIN(xb_ld(&bar[XB_TOPGEN]) == tg, bar);
            __builtin_amdgcn_fence(__ATOMIC_ACQUIRE, "agent");
            xb_add(&bar[XB_XGEN(b.x)], 1u);
            asm volatile("s_waitcnt vmcnt(0)" ::: "memory");
        } else {
            XB_SPIN(xb_ld(&bar[XB_XGEN(b.x)]) == gen, bar);
            __builtin_amdgcn_fence(__ATOMIC_ACQUIRE, "agent");
            asm volatile("s_waitcnt vmcnt(0)" ::: "memory");
        }
    }
    __syncthreads();
}

struct Frame {
    LAS unsigned char* lds;
    volatile LAS unsigned* MISC;
    gu32* ctl;
    int tid, lane, wave, vcu, G;
};
__device__ __forceinline__ float bf2f(bf16 v) { return __uint_as_float((unsigned)v << 16); }
__device__ __forceinline__ float wave_sum(float v) {
#pragma unroll
    for (int o = 1; o < 64; o <<= 1) v += __shfl_xor(v, o);
    return v;
}
__device__ __forceinline__ float ret_logg(int h) { return log1pf(-exp2f(-5.0f - (float)h)); }

struct PArgs { const float *x, *p; const int* pos; const float *mix_g, *w_in, *qn_g, *w_uq, *kvn_g, *w_ukv, *w_o, *ffn_g, *w_g, *w_u, *w_d, *ple_g, *w_pg, *w_pp, *fin_g; };
__device__ __forceinline__ const float* p0_src(const PArgs& a, int kind, int n, float& cs) {
    cs = 1.0f;
    switch (kind) {
    case 0: {
        if (n < 1024) { const int g = n & 127; if (n >= 512) cs = 0.08838834764831845f; return a.w_in + (n & ~127) + (g >> 1) + 64 * (g & 1); }
        if (n < 2432) return a.w_in + n;
        if (n < 2496) { const int g = n - 2432; return a.w_in + 2432 + (g >> 1) + 32 * (g & 1); }
        return nullptr; }
    case 1: {
        if (n < 512) return a.w_uq + (n >> 7) * 192 + (n & 127);
        const int r = n - 512, g = r & 63; return a.w_uq + (r >> 6) * 192 + 128 + (g >> 1) + 32 * (g & 1); }
    case 2: return a.w_ukv + n;
    case 3: return a.w_o + n;
    case 4: { const int t = n >> 8, r = n & 255; return (r < 128 ? a.w_g : a.w_u) + 128 * t + (r & 127); }
    case 5: return a.w_d + n;
    case 6: return a.w_pg + n;
    default: return a.w_pp + n;
    }
}
__device__ __forceinline__ void p0_item(const PArgs& a, int kind, int ldw, int K, const float* gk, bf16* WT, LAS float* scr, int item, int nblk, int lane) {
    const int kb = item / nblk, nb = item % nblk, k0 = 64 * kb, n0 = 32 * nb;
    float cs; const float* src = p0_src(a, kind, n0 + (lane & 31), cs);
#pragma unroll 8
    for (int i = 0; i < 32; ++i) { const int kk = 2 * i + (lane >> 5); float v = 0.f;
        if (src) { v = src[(size_t)(k0 + kk) * ldw] * cs; if (gk) v *= gk[k0 + kk]; }
        scr[kk * 33 + (lane & 31)] = v; }
    LDS_WAIT(); asm volatile("" ::: "memory");
    const int c = lane & 7;
#pragma unroll
    for (int j = 0; j < 4; ++j) { const int n = (lane >> 3) + 8 * j; const LAS float* s = scr + (8 * c) * 33 + n;
        v4u o; o.x = pk2(s[0 * 33], s[1 * 33]); o.y = pk2(s[2 * 33], s[3 * 33]); o.z = pk2(s[4 * 33], s[5 * 33]); o.w = pk2(s[6 * 33], s[7 * 33]);
        *(GAS v4u*)(WT + (size_t)(n0 + n) * K + k0 + 8 * c) = o; }
    LDS_WAIT(); asm volatile("" ::: "memory");
}
__device__ __forceinline__ void p0_prologue(Frame& F, const PArgs& a, unsigned char* ws) {
    LAS float* scr = (LAS float*)(F.lds + RING_OFF + F.wave * 16384);
    const int gw = F.vcu * NWAVES + F.wave, NGW = F.G * NWAVES;
    constexpr int NMAT = 8;
    const int Ks[NMAT] = {1024, 256, 128, 1024, 1024, 2816, 1024, 256}, Ns[NMAT] = {NZ, NQM, NKV, 1024, NGU, 1024, 1024, 1024}, LDW[NMAT] = {INC, NQM, NKV, 1024, DFF, 1024, 1024, 1024};
    const size_t OFF[NMAT] = {WS_WIN, WS_WUQ, WS_WUKV, WS_WO, WS_WGU, WS_WD, WS_WPG, WS_WPP};
    int base = 0;
#pragma unroll
    for (int k = 0; k < NMAT; ++k) {
        const int nblk = Ns[k] / 32, nit = (Ks[k] / 64) * nblk;
        const float* gk = k == 1 ? a.qn_g : k == 2 ? a.kvn_g : k == 4 ? a.ffn_g : k == 6 ? a.ple_g : nullptr;
        int first = gw - (base % NGW); if (first < 0) first += NGW;
        for (int it = first; it < nit; it += NGW) p0_item(a, k, LDW[k], Ks[k], gk, (bf16*)(ws + OFF[k]), scr, it, nblk, F.lane);
        base += nit;
    }
    bf16* XN = (bf16*)(ws + WS_XN);
    for (int m = gw; m < T; m += NGW) {
        const GAS f32x4* xr = (const GAS f32x4*)(a.x + (size_t)m * D) + F.lane; const GAS f32x4* gr = (const GAS f32x4*)a.mix_g + F.lane;
        f32x4 v[4]; float s = 0.f;
#pragma unroll
        for (int j = 0; j < 4; ++j) { v[j] = xr[64 * j]; s += (v[j].x * v[j].x + v[j].y * v[j].y) + (v[j].z * v[j].z + v[j].w * v[j].w); }
        const float rs = 1.0f / sqrtf(wave_sum(s) * (1.0f / D) + 1e-6f);
        GAS unsigned long long* o8 = (GAS unsigned long long*)(XN + (size_t)m * D) + F.lane;
#pragma unroll
        for (int j = 0; j < 4; ++j) { const f32x4 g = gr[64 * j]; o8[64 * j] = (unsigned long long)pk2(v[j].x * rs * g.x, v[j].y * rs * g.y) | ((unsigned long long)pk2(v[j].z * rs * g.z, v[j].w * rs * g.w) << 32); }
    }
    { const int gt = F.vcu * NTHR + F.tid, NGT = F.G * NTHR; bf16* PB = (bf16*)(ws + WS_PB);
      for (int i = gt; i < T * DPLE / 4; i += NGT) { const f32x4 v = ((const GAS f32x4*)a.p)[i]; ((GAS unsigned long long*)PB)[i] = (unsigned long long)pk2(v.x, v.y) | ((unsigned long long)pk2(v.z, v.w) << 32); } }
    { const int gt = F.vcu * NTHR + F.tid, NGT = F.G * NTHR; float* RC = (float*)(ws + WS_RC); float* RS = (float*)(ws + WS_RS); float* MC = (float*)(ws + WS_MC); float* MS = (float*)(ws + WS_MS);
      for (int i = gt; i < T * 64; i += NGT) { const int t = i >> 6, k = i & 63; const float ang = (float)a.pos[t] * expf(-logf(10000.0f) * (float)k / 64.0f); RC[i] = cosf(ang); RS[i] = sinf(ang); }
      for (int i = gt; i < T * 32; i += NGT) { const int t = i >> 5, k = i & 31; const float ang = (float)a.pos[t] * expf(-logf(10000.0f) * (float)k / 32.0f); MC[i] = cosf(ang); MS[i] = sinf(ang); } }
}

__device__ __forceinline__ void ret_kv_simple(Frame& F, const bf16* RK, const bf16* RV, bf16* KVS) {
    LAS float* ks = (LAS float*)F.lds; LAS float* vs = ks + 64 * 128;
    for (int blk = F.vcu; blk < BATCH * NCH * RH; blk += F.G) {
        const int h = blk % RH, n = (blk / RH) % NCH, b = blk / (RH * NCH);
        const float lg = ret_logg(h); const size_t t0 = (size_t)b * SEQ + (size_t)n * CHUNK;
        for (int idx = F.tid; idx < 64 * 128; idx += NTHR) { const int j = idx >> 7, d = idx & 127;
            ks[idx] = bf2f(RK[(t0 + j) * 512 + h * 128 + d]) * expf(lg * (float)(CHUNK - 1 - j)); vs[idx] = bf2f(RV[(t0 + j) * 512 + h * 128 + d]); }
        __syncthreads();
        const int d = F.tid >> 2, e0 = (F.tid & 3) * 32;
        float acc[32];
#pragma unroll
        for (int e = 0; e < 32; ++e) acc[e] = 0.f;
        for (int j = 0; j < 64; ++j) { const float kd = ks[j * 128 + d];
#pragma unroll
            for (int e = 0; e < 32; ++e) acc[e] += kd * vs[j * 128 + e0 + e]; }
        GAS unsigned* o = (GAS unsigned*)(KVS + (size_t)blk * 16384 + d * 128 + e0);
#pragma unroll
        for (int e = 0; e < 16; ++e) o[e] = pk2(acc[2 * e], acc[2 * e + 1]);
        __syncthreads();
    }
}
__device__ __forceinline__ void ret_scan_simple(Frame& F, bf16* KVS) {
    for (int gid = F.vcu * NTHR + F.tid; gid < BATCH * RH * 16384; gid += F.G * NTHR) {
        const int de = gid & 16383, h = (gid >> 14) % RH, b = gid >> 16;
        const float c = expf(ret_logg(h) * (float)CHUNK); float S = 0.f;
        for (int n = 0; n < NCH; ++n) { bf16* p = KVS + ((size_t)((b * NCH + n) * RH + h)) * 16384 + de; const float kv = bf2f(*p); *p = (bf16)f2bf(S); S = c * S + kv; }
    }
}
__device__ __forceinline__ void ret_out_simple(Frame& F, const bf16* RQ, const bf16* RK, const bf16* RV, const bf16* RG, const bf16* PREV, bf16* CAT) {
    LAS float* qs = (LAS float*)F.lds; LAS float* ks = qs + 64 * 129; LAS float* vs = ks + 64 * 129; LAS float* ss = vs + 64 * 128;
    for (int blk = F.vcu; blk < BATCH * NCH * RH; blk += F.G) {
        const int h = blk % RH, n = (blk / RH) % NCH, b = blk / (RH * NCH);
        const float lg = ret_logg(h); const size_t t0 = (size_t)b * SEQ + (size_t)n * CHUNK;
        for (int idx = F.tid; idx < 64 * 128; idx += NTHR) { const int j = idx >> 7, d = idx & 127; const size_t g = (t0 + j) * 512 + h * 128 + d;
            qs[j * 129 + d] = bf2f(RQ[g]); ks[j * 129 + d] = bf2f(RK[g]); vs[j * 128 + d] = bf2f(RV[g]); }
        __syncthreads();
        { const int i = F.tid >> 3, jq = F.tid & 7;
          for (int jj = 0; jj < 8; ++jj) { const int j = jq * 8 + jj; float dot = 0.f;
              for (int d = 0; d < 128; ++d) dot += qs[i * 129 + d] * ks[j * 129 + d];
              const int dij = i > j ? i - j : j - i; ss[i * 65 + j] = dot * expf(lg * (float)dij); } }
        __syncthreads();
        const int e = F.tid & 127, ih = F.tid >> 7;
        float acc[16], acc2[16];
#pragma unroll
        for (int ii = 0; ii < 16; ++ii) { acc[ii] = 0.f; acc2[ii] = 0.f; }
        for (int j = 0; j < 64; ++j) { const float vv = vs[j * 128 + e];
#pragma unroll
            for (int ii = 0; ii < 16; ++ii) acc[ii] += ss[(ih * 16 + ii) * 65 + j] * vv; }
        const bf16* pv = PREV + (size_t)blk * 16384;
        for (int d = 0; d < 128; ++d) { const float p = bf2f(pv[d * 128 + e]);
#pragma unroll
            for (int ii = 0; ii < 16; ++ii) acc2[ii] += qs[(ih * 16 + ii) * 129 + d] * p; }
        __syncthreads();
        LAS float* os = qs;
#pragma unroll
        for (int ii = 0; ii < 16; ++ii) { const int i = ih * 16 + ii; os[i * 128 + e] = acc[ii] + expf(lg * (float)(i + 1)) * acc2[ii]; }
        __syncthreads();
        for (int r = 0; r < 8; ++r) { const int i = F.wave * 8 + r;
            const float a0 = os[i * 128 + F.lane], a1 = os[i * 128 + F.lane + 64];
            const float mu = wave_sum(a0 + a1) * (1.0f / 128.0f); const float d0 = a0 - mu, d1 = a1 - mu;
            const float rs = 1.0f / sqrtf(wave_sum(d0 * d0 + d1 * d1) * (1.0f / 128.0f) + 1e-5f);
            const float g0 = bf2f(RG[(t0 + i) * 512 + h * 128 + F.lane]), g1 = bf2f(RG[(t0 + i) * 512 + h * 128 + F.lane + 64]);
            bf16* orow = CAT + (t0 + i) * D + h * 128;
            orow[F.lane] = (bf16)f2bf(d0 * rs * (g0 / (1.0f + expf(-g0)))); orow[F.lane + 64] = (bf16)f2bf(d1 * rs * (g1 / (1.0f + expf(-g1)))); }
        __syncthreads();
    }
}
__device__ __forceinline__ void attn_simple(Frame& F, const bf16* QM, const bf16* KVB, const bf16* KPE, bf16* CAT) {
    LAS float* Qs = (LAS float*)F.lds; LAS float* Ks = Qs + 64 * 193; LAS float* Vs = Ks + 64 * 193; LAS float* Ss = Vs + 64 * 128;
    for (int i = 0;; ++i) {
        const int L = i * F.G + F.vcu; if (L >= BATCH * MH * NCH) break;
        const int bh = L & 7, x = (L >> 3) & 31, rnd = L >> 8; const int c = (rnd & 1) ? (rnd * 32 + x) : (rnd * 32 + 31 - x);
        const int h = bh & 3, b = bh >> 2;
        const size_t tq0 = (size_t)b * SEQ + (size_t)c * CHUNK;
        __syncthreads();
        for (int idx = F.tid; idx < 64 * 192; idx += NTHR) { const int r = idx / 192, d = idx % 192;
            Qs[r * 193 + d] = bf2f(d < 128 ? QM[(tq0 + r) * NQM + h * 128 + d] : QM[(tq0 + r) * NQM + 512 + h * 64 + (d - 128)]); }
        const int qi = F.tid >> 3, part = F.tid & 7;
        float m = -INFINITY, l = 0.f; float acc[16];
#pragma unroll
        for (int e = 0; e < 16; ++e) acc[e] = 0.f;
        for (int kt = 0; kt <= c; ++kt) {
            __syncthreads();
            const size_t tk0 = (size_t)b * SEQ + (size_t)kt * CHUNK;
            for (int idx = F.tid; idx < 64 * 192; idx += NTHR) { const int j = idx / 192, d = idx % 192;
                Ks[j * 193 + d] = bf2f(d < 128 ? KVB[(tk0 + j) * NKV + h * 256 + d] : KPE[(tk0 + j) * 64 + (d - 128)]); }
            for (int idx = F.tid; idx < 64 * 128; idx += NTHR) { const int j = idx >> 7, e = idx & 127; Vs[idx] = bf2f(KVB[(tk0 + j) * NKV + h * 256 + 128 + e]); }
            __syncthreads();
            for (int jj = 0; jj < 8; ++jj) { const int j = part * 8 + jj; float dot = 0.f;
                for (int d = 0; d < 192; ++d) dot += Qs[qi * 193 + d] * Ks[j * 193 + d];
                Ss[qi * 65 + j] = dot; }
            __syncthreads();
            float mx = m;
            for (int j = 0; j < 64; ++j) mx = fmaxf(mx, Ss[qi * 65 + j]);
            const float alpha = exp2f(m - mx); l *= alpha;
#pragma unroll
            for (int e = 0; e < 16; ++e) acc[e] *= alpha;
            for (int j = 0; j < 64; ++j) { const float p = exp2f(Ss[qi * 65 + j] - mx); l += p; const LAS float* vr = Vs + j * 128 + part * 16;
#pragma unroll
                for (int e = 0; e < 16; ++e) acc[e] += p * vr[e]; }
            m = mx;
        }
        const float il = 1.0f / l;
        GAS unsigned* o = (GAS unsigned*)(CAT + (tq0 + qi) * D + 512 + h * 128 + part * 16);
#pragma unroll
        for (int e = 0; e < 8; ++e) o[e] = pk2(acc[2 * e] * il, acc[2 * e + 1] * il);
    }
    __syncthreads();
}
__device__ __forceinline__ void final_norm(Frame& F, float* X, const float* ssq, const float* g) {
    const int gw = F.vcu * NWAVES + F.wave, NGW = F.G * NWAVES;
    for (int m = gw; m < T; m += NGW) {
        const float rs = 1.0f / sqrtf(ssq[m] * (1.0f / D) + 1e-6f);
        GAS f32x4* xr = (GAS f32x4*)(X + (size_t)m * D) + F.lane; const GAS f32x4* gr = (const GAS f32x4*)g + F.lane;
#pragma unroll
        for (int j = 0; j < 4; ++j) { const f32x4 v = xr[64 * j], gg = gr[64 * j]; xr[64 * j] = (f32x4){v.x * rs * gg.x, v.y * rs * gg.y, v.z * rs * gg.z, v.w * rs * gg.w}; }
    }
}


namespace att {
typedef float f32x16 __attribute__((ext_vector_type(16)));
typedef short s16x4 __attribute__((ext_vector_type(4)));
typedef short v4i16_t __attribute__((ext_vector_type(4)));
constexpr int KB_OFF = 0, KSLOT = 24576, VB_OFF = 49152, VSLOT = 16384, MERGE_OFF = 0, STAGE_OFF = 65536, WSF_OFF = 122880, ST_OFF = 124928;
constexpr float THR = 8.0f;
__device__ __forceinline__ void glds16(const void* gsrc, unsigned lds_dst) { unsigned keep;
    asm volatile("s_mov_b32 %0, m0\n\ts_mov_b32 m0, %2\n\ts_nop 0\n\tglobal_load_lds_dwordx4 %1, off\n\ts_mov_b32 m0, %0" : "=&s"(keep) : "v"(gsrc), "s"(lds_dst) : "memory"); }
__device__ __forceinline__ int crow(int r, int hi) { return (r & 3) + 8 * (r >> 2) + 4 * hi; }
__device__ __forceinline__ s16x4 vtr(const LAS char* p) { return __builtin_bit_cast(s16x4, __builtin_amdgcn_ds_read_tr16_b64_v4i16((LAS v4i16_t*)p)); }
__device__ __forceinline__ unsigned cvtpk(float lo, float hi) { unsigned r; asm volatile("v_cvt_pk_bf16_f32 %0, %1, %2" : "=v"(r) : "v"(lo), "v"(hi)); return r; }
__device__ __forceinline__ float swap_max(float m) { auto rr = __builtin_amdgcn_permlane32_swap(__float_as_uint(m), __float_as_uint(m), false, false); return fmaxf(__uint_as_float(rr[0]), __uint_as_float(rr[1])); }
__device__ __forceinline__ float swap_sum(float m) { auto rr = __builtin_amdgcn_permlane32_swap(__float_as_uint(m), __float_as_uint(m), false, false); return __uint_as_float(rr[0]) + __uint_as_float(rr[1]); }
#define ATT_WAIT_BAR() asm volatile("s_waitcnt vmcnt(0) lgkmcnt(0)\n\ts_barrier" ::: "memory")

__device__ __forceinline__ void attn_unit(Frame& F, int b, int h, int qb, const bf16* QM, const bf16* KVB, const bf16* KPE, bf16* CAT) {
    const int lane = F.lane, r32 = lane & 31, hi = lane >> 5, w = F.wave, g = w >> 2, wq = w & 3;
    const LAS char* L = (const LAS char*)F.lds;
    const unsigned lds0 = (unsigned)(uintptr_t)F.lds;
    const size_t tb = (size_t)b * SEQ;
    const int NT = 2 * qb + 2;
    const bf16* kp0 = KVB + (tb + lane) * NKV + h * 256 + w * 8;
    const bf16* kp2 = KPE + (tb + lane) * 64 + w * 8;
    const bf16* vp0 = KVB + (tb + 16 * (w & 3) + (lane >> 2)) * NKV + h * 256 + 128 + 32 * (w >> 2) + (lane & 3) * 8;
#define ATT_DMA(hh) do { const int _h = (hh); \
        if (_h + 1 < NT) { const unsigned kd = (unsigned)__builtin_amdgcn_readfirstlane(lds0 + KB_OFF + ((_h + 1) & 1) * KSLOT + w * 1024); const size_t to = (size_t)(_h + 1) * 64; \
            glds16(kp0 + to * NKV, kd); glds16(kp0 + to * NKV + 64, kd + 8192); glds16(kp2 + to * 64, kd + 16384); } \
        if (_h < NT) { const unsigned vd = (unsigned)__builtin_amdgcn_readfirstlane(lds0 + VB_OFF + (_h & 1) * VSLOT + w * 1024); const size_t to = (size_t)_h * 64; \
            glds16(vp0 + to * NKV, vd); glds16(vp0 + to * NKV + 64, vd + 8192); } } while (0)
    { const unsigned kd = (unsigned)__builtin_amdgcn_readfirstlane(lds0 + KB_OFF + w * 1024); glds16(kp0, kd); glds16(kp0 + 64, kd + 8192); glds16(kp2, kd + 16384); }
    bf16x8 qf[12];
    { const bf16* qrow = QM + (tb + (size_t)qb * 128 + wq * 32 + r32) * NQM;
#pragma unroll
      for (int kk = 0; kk < 8; ++kk) qf[kk] = *(const bf16x8*)(qrow + h * 128 + kk * 16 + hi * 8);
#pragma unroll
      for (int kk = 0; kk < 4; ++kk) qf[8 + kk] = *(const bf16x8*)(qrow + 512 + h * 64 + kk * 16 + hi * 8); }
    f32x16 o[4];
#pragma unroll
    for (int d0 = 0; d0 < 4; ++d0) o[d0] = f32x16{};
    f32x16 p0 = f32x16{}, p1 = f32x16{};
    float m_run = -1e30f, l_run = 0.f;
    LAS float* wsf = (LAS float*)(F.lds + WSF_OFF) + w * 64;
    const LAS char* kb = L + KB_OFF + g * KSLOT + hi * 1024 + r32 * 16;
    const LAS char* vb = L + VB_OFF + g * VSLOT + ((lane >> 4) & 1) * 32 + (lane & 3) * 8 + (4 * hi + ((lane & 15) >> 2)) * 64;
    ATT_WAIT_BAR();
    if (g == 1) { ATT_DMA(0); ATT_WAIT_BAR(); }
    for (int t = g; t < NT; t += 2) {
        const bool vis = (t < NT - 1) || (wq >= 2);
        ATT_DMA(t);
        if (vis) {
            p0 = f32x16{}; p1 = f32x16{};
            bf16x8 ka[4], kn[4];
            ka[0] = *(const LAS bf16x8*)(kb); ka[1] = *(const LAS bf16x8*)(kb + 512); ka[2] = *(const LAS bf16x8*)(kb + 2048); ka[3] = *(const LAS bf16x8*)(kb + 2048 + 512);
#pragma unroll
            for (int kg = 0; kg < 6; ++kg) {
                if (kg < 5) { kn[0] = *(const LAS bf16x8*)(kb + (2 * kg + 2) * 2048); kn[1] = *(const LAS bf16x8*)(kb + (2 * kg + 2) * 2048 + 512);
                              kn[2] = *(const LAS bf16x8*)(kb + (2 * kg + 3) * 2048); kn[3] = *(const LAS bf16x8*)(kb + (2 * kg + 3) * 2048 + 512); }
                p0 = __builtin_amdgcn_mfma_f32_32x32x16_bf16(ka[0], qf[2 * kg], p0, 0, 0, 0);
                p1 = __builtin_amdgcn_mfma_f32_32x32x16_bf16(ka[1], qf[2 * kg], p1, 0, 0, 0);
                p0 = __builtin_amdgcn_mfma_f32_32x32x16_bf16(ka[2], qf[2 * kg + 1], p0, 0, 0, 0);
                p1 = __builtin_amdgcn_mfma_f32_32x32x16_bf16(ka[3], qf[2 * kg + 1], p1, 0, 0, 0);
                __builtin_amdgcn_sched_barrier(0);
                if (kg < 5) { ka[0] = kn[0]; ka[1] = kn[1]; ka[2] = kn[2]; ka[3] = kn[3]; }
            }
        }
        ATT_WAIT_BAR();
        ATT_DMA(t + 1);
        if (vis) {
            float rm = fmaxf(p0[0], p1[0]);
#pragma unroll
            for (int r = 1; r < 16; ++r) rm = fmaxf(rm, fmaxf(p0[r], p1[r]));
            rm = swap_max(rm);
            const float mnew = fmaxf(m_run, rm);
            if (__any(mnew > m_run + THR)) {
                const float f = __builtin_amdgcn_exp2f(m_run - mnew); l_run *= f; m_run = mnew;
                if (hi == 0) wsf[r32] = f;
                asm volatile("s_waitcnt lgkmcnt(0)" ::: "memory");
#pragma unroll
                for (int r = 0; r < 16; ++r) { const float fr_ = wsf[crow(r, hi)];
#pragma unroll
                    for (int d0 = 0; d0 < 4; ++d0) o[d0][r] *= fr_; }
            }
            float ls = 0.f;
#pragma unroll
            for (int r = 0; r < 16; ++r) { p0[r] = __builtin_amdgcn_exp2f(p0[r] - m_run); p1[r] = __builtin_amdgcn_exp2f(p1[r] - m_run); ls += p0[r] + p1[r]; }
            l_run += ls;
            bf16x8 pw[4];
            { v4u t0 = {cvtpk(p0[0], p0[1]), cvtpk(p0[2], p0[3]), cvtpk(p0[4], p0[5]), cvtpk(p0[6], p0[7])};
              v4u t1 = {cvtpk(p0[8], p0[9]), cvtpk(p0[10], p0[11]), cvtpk(p0[12], p0[13]), cvtpk(p0[14], p0[15])};
              v4u t2 = {cvtpk(p1[0], p1[1]), cvtpk(p1[2], p1[3]), cvtpk(p1[4], p1[5]), cvtpk(p1[6], p1[7])};
              v4u t3 = {cvtpk(p1[8], p1[9]), cvtpk(p1[10], p1[11]), cvtpk(p1[12], p1[13]), cvtpk(p1[14], p1[15])};
              pw[0] = __builtin_bit_cast(bf16x8, t0); pw[1] = __builtin_bit_cast(bf16x8, t1); pw[2] = __builtin_bit_cast(bf16x8, t2); pw[3] = __builtin_bit_cast(bf16x8, t3); }
#pragma unroll
            for (int d0 = 0; d0 < 4; ++d0) {
                bf16x8 vf[4];
#pragma unroll
                for (int ks = 0; ks < 4; ++ks) { const s16x4 lo = vtr(vb + d0 * 4096 + ks * 1024), hh = vtr(vb + d0 * 4096 + ks * 1024 + 512);
                    vf[ks] = (bf16x8){lo[0], lo[1], lo[2], lo[3], hh[0], hh[1], hh[2], hh[3]}; }
#pragma unroll
                for (int ks = 0; ks < 4; ++ks) o[d0] = __builtin_amdgcn_mfma_f32_32x32x16_bf16(pw[ks], vf[ks], o[d0], 0, 0, 0);
                __builtin_amdgcn_sched_barrier(0);
            }
        }
        ATT_WAIT_BAR();
    }
    if (g == 0) { ATT_DMA(NT); ATT_WAIT_BAR(); }
    l_run = swap_sum(l_run);
    int lane_b = F.tid & 63; asm volatile("" : "+v"(lane_b));
    const int r32b = lane_b & 31, hib = lane_b >> 5;
    LAS float* MG = (LAS float*)(F.lds + MERGE_OFF) + wq * 4096;
    LAS float* ST = (LAS float*)(F.lds + ST_OFF) + wq * 64;
    if (g == 1) {
#pragma unroll
        for (int d0 = 0; d0 < 4; ++d0)
#pragma unroll
            for (int r = 0; r < 16; ++r) MG[(d0 * 16 + r) * 64 + lane_b] = o[d0][r];
        if (hib == 0) { ST[r32b] = m_run; ST[32 + r32b] = l_run; }
    }
    ATT_WAIT_BAR();
    if (g == 0) {
        const float m1 = ST[r32b], l1 = ST[32 + r32b];
        const float m = fmaxf(m_run, m1), f0 = __builtin_amdgcn_exp2f(m_run - m), f1 = __builtin_amdgcn_exp2f(m1 - m);
        const float il = 1.0f / (l_run * f0 + l1 * f1);
        if (hib == 0) { wsf[r32b] = f0 * il; wsf[32 + r32b] = f1 * il; }
        asm volatile("s_waitcnt lgkmcnt(0)" ::: "memory");
        LAS bf16* stg = (LAS bf16*)(F.lds + STAGE_OFF) + wq * 4096;
#pragma unroll
        for (int r = 0; r < 16; ++r) { const int row = crow(r, hib); const float a0 = wsf[row], a1 = wsf[32 + row];
#pragma unroll
            for (int d0 = 0; d0 < 4; ++d0) stg[row * 128 + d0 * 32 + r32b] = (bf16)f2bf(o[d0][r] * a0 + MG[(d0 * 16 + r) * 64 + lane_b] * a1);
            if ((r & 3) == 3) __builtin_amdgcn_sched_barrier(0); }
        asm volatile("s_waitcnt lgkmcnt(0)" ::: "memory");
        bf16* orow = CAT + (tb + (size_t)qb * 128 + wq * 32) * D + 512 + h * 128;
#pragma unroll
        for (int i = 0; i < 8; ++i) { const int id = i * 64 + lane_b, row = id >> 4, ch = id & 15; *(GAS v4u*)(orow + (size_t)row * D + ch * 8) = *(const LAS v4u*)(stg + row * 128 + ch * 8); }
    }
    ATT_WAIT_BAR();
#undef ATT_DMA
}
__device__ __forceinline__ void attn_phase(Frame& F, const bf16* QM, const bf16* KVB, const bf16* KPE, bf16* CAT) {
#pragma unroll 1
    for (int it = 2 * F.vcu; it < 512; it += 2 * F.G) {
#pragma unroll 1
        for (int u = 0; u < 2; ++u) { const int v = it >> 1, bh = v >> 5, s = v & 31;
            attn_unit(F, bh >> 2, bh & 3, u ? s : 63 - s, QM, KVB, KPE, CAT); } }
}
#undef ATT_WAIT_BAR
}
struct Args { PArgs in; float* out; unsigned char* ws; int ph_lo, ph_hi, li, pad; };
__global__ void __launch_bounds__(NTHR, 2) mk_fwd(Args args) {
    extern __shared__ __attribute__((aligned(16))) unsigned char lds[];
    Frame F;
    F.lds = (LAS unsigned char*)lds;
    F.MISC = (volatile LAS unsigned*)(F.lds + MISC_OFF);
    F.tid = threadIdx.x; F.lane = F.tid & 63; F.wave = __builtin_amdgcn_readfirstlane(F.tid >> 6);
    F.G = gridDim.x; { const int bx = blockIdx.x; F.vcu = (F.G % 8 == 0) ? (bx % 8) * (F.G / 8) + bx / 8 : bx; }
    unsigned char* ws = args.ws;
    F.ctl = (gu32*)(ws + WS_CTL);
    for (int u = F.tid; u < (LDS_BYTES - LDSCTL_OFF) / 4; u += NTHR) ((LAS unsigned*)(F.lds + LDSCTL_OFF))[u] = 0u;
    __syncthreads();
    XcdBarrier bar; bar.bar = (unsigned*)(F.ctl + CW_BAR); bar.x = 0; bar.st = nullptr;
    if (N_LAUNCHES != PER_PHASE) bar = xcd_barrier_post((unsigned*)(F.ctl + CW_BAR), F.MISC + 8);
#define GRID_BAR() do { if (N_LAUNCHES != PER_PHASE) xcd_barrier(bar); } while (0)
    const int lo = args.ph_lo, hi = args.ph_hi;
#define IN(k) (lo <= (k) && (k) < hi)
#define BOTH(k) (IN(k) && IN((k) + 1))
    bf16* XN = (bf16*)(ws + WS_XN); bf16* RQ = (bf16*)(ws + WS_RQ); bf16* RK = (bf16*)(ws + WS_RK); bf16* RV = (bf16*)(ws + WS_RV); bf16* RG = (bf16*)(ws + WS_RG);
    bf16* QM = (bf16*)(ws + WS_QM); bf16* CQ = (bf16*)(ws + WS_CQ); bf16* CKV = (bf16*)(ws + WS_CKV); bf16* KPE = (bf16*)(ws + WS_KPE); bf16* KVB = (bf16*)(ws + WS_KVB);
    bf16* CAT = (bf16*)(ws + WS_CAT); bf16* PB = (bf16*)(ws + WS_PB); bf16* ACT = (bf16*)(ws + WS_ACT); bf16* KVS = XN; bf16* X1B = XN; bf16* PROJ = KVB;
    float* SSQ = (float*)(ws + WS_SSQ); float* ssq_cq = SSQ; float* ssq_ckv = SSQ + T; float* ssq_x1 = SSQ + 2 * T; float* ssq_x2 = SSQ + 3 * T; float* ssq_x3 = SSQ + 4 * T;
    const float* RC = (const float*)(ws + WS_RC); const float* RS = (const float*)(ws + WS_RS); const float* MC = (const float*)(ws + WS_MC); const float* MS = (const float*)(ws + WS_MS);
    const int cid = (int)blockIdx.x;

    if (IN(0)) { p0_prologue(F, args.in, ws); if (BOTH(0)) GRID_BAR(); }
    if (IN(1)) {
        pg8::Gemm g{XN, (const bf16*)(ws + WS_WIN), T, NZ, D}; pg8::StaticOrder S; S.init(T, NZ, F.G, cid);
        pg8::EpiZ E{RQ, RK, RV, RG, CQ, CKV, KPE, RC, RS, MC, MS, ssq_cq, ssq_ckv};
        pg8::gemm_phase<pg8::EpiZ, pg8::StaticOrder, true, true>(F.lds + RING_OFF, g, S, E);
        if (BOTH(1)) GRID_BAR();
    }
    if (IN(2)) {
        { pg8::Gemm g{CQ, (const bf16*)(ws + WS_WUQ), T, NQM, 256}; pg8::StaticOrder S; S.init(T, NQM, F.G, cid);
          pg8::EpiQM E{QM, MC, MS, ssq_cq, QSCALE};
          pg8::gemm_phase<pg8::EpiQM, pg8::StaticOrder, true, true>(F.lds + RING_OFF, g, S, E); }
        { pg8::Gemm g{CKV, (const bf16*)(ws + WS_WUKV), T, NKV, 128}; pg8::StaticOrder S; S.init(T, NKV, F.G, cid);
          pg8::EpiScaleBf16 E{KVB, NKV, ssq_ckv, 1.0f / 128.0f};
          pg8::gemm_phase<pg8::EpiScaleBf16, pg8::StaticOrder, true, true>(F.lds + RING_OFF, g, S, E); }
        ret_kv_simple(F, RK, RV, KVS);
        if (BOTH(2)) GRID_BAR();
    }
    if (IN(3)) {
        ret_scan_simple(F, KVS);
        att::attn_phase(F, QM, KVB, KPE, CAT);
        if (BOTH(3)) GRID_BAR();
    }
    if (IN(4)) {
        ret_out_simple(F, RQ, RK, RV, RG, KVS, CAT);
        if (BOTH(4)) GRID_BAR();
    }
    if (IN(5)) {
        { pg8::Gemm g{CAT, (const bf16*)(ws + WS_WO), T, D, D}; pg8::StaticOrder S; S.init(T, D, F.G, cid);
          pg8::EpiRes E{args.in.x, args.out, X1B, ssq_x1};
          pg8::gemm_phase<pg8::EpiRes, pg8::StaticOrder, true, true>(F.lds + RING_OFF, g, S, E); }
        { pg8::Gemm g{PB, (const bf16*)(ws + WS_WPP), T, D, DPLE}; pg8::StaticOrder S; S.init(T, D, F.G, cid);
          pg8::EpiScaleBf16 E{PROJ, D, nullptr, 0.f};
          pg8::gemm_phase<pg8::EpiScaleBf16, pg8::StaticOrder, true, true>(F.lds + RING_OFF, g, S, E); }
        if (BOTH(5)) GRID_BAR();
    }
    if (IN(6)) {
        pg8::Gemm g{X1B, (const bf16*)(ws + WS_WGU), T, NGU, D}; pg8::StaticOrder S; S.init(T, NGU, F.G, cid);
        pg8::EpiGU E{ACT, DFF, ssq_x1};
        pg8::gemm_phase<pg8::EpiGU, pg8::StaticOrder, true, true>(F.lds + RING_OFF, g, S, E);
        if (BOTH(6)) GRID_BAR();
    }
    if (IN(7)) {
        pg8::Gemm g{ACT, (const bf16*)(ws + WS_WD), T, D, DFF}; pg8::StaticOrder S; S.init(T, D, F.G, cid);
        pg8::EpiRes E{args.out, args.out, X1B, ssq_x2};
        pg8::gemm_phase<pg8::EpiRes, pg8::StaticOrder, true, true>(F.lds + RING_OFF, g, S, E);
        if (BOTH(7)) GRID_BAR();
    }
    if (IN(8)) {
        pg8::Gemm g{X1B, (const bf16*)(ws + WS_WPG), T, D, D}; pg8::StaticOrder S; S.init(T, D, F.G, cid);
        pg8::EpiPle E{args.out, PROJ, ssq_x2, ssq_x3};
        pg8::gemm_phase<pg8::EpiPle, pg8::StaticOrder, true, true>(F.lds + RING_OFF, g, S, E);
        if (BOTH(8)) GRID_BAR();
    }
    if (IN(9)) final_norm(F, args.out, ssq_x3, args.in.fin_g);
#undef IN
#undef BOTH
}

extern "C" void kernel_launch(void* const* d_in, const int* in_sizes, int n_in, void* d_out, int out_size, void* d_ws, size_t ws_size, hipStream_t stream) {
    static int grid = 0;
    if (grid == 0) {
        if (n_in != 18 || out_size != T * D || ws_size < WS_END) { fprintf(stderr, "kernel_launch: unexpected shapes (n_in %d out %d ws %zu)\n", n_in, out_size, ws_size); grid = -1; return; }
        int dev = 0, cus = 0;
        if (hipGetDevice(&dev) != hipSuccess || hipDeviceGetAttribute(&cus, hipDeviceAttributeMultiprocessorCount, dev) != hipSuccess) { grid = -1; return; }
        if (hipFuncSetAttribute((const void*)mk_fwd, hipFuncAttributeMaxDynamicSharedMemorySize, LDS_BYTES) != hipSuccess) { fprintf(stderr, "kernel_launch: hipFuncSetAttribute failed\n"); grid = -1; return; }
        grid = cus;
    }
    if (grid < 0) return;
    if (hipMemsetAsync((char*)d_ws + WS_CTL, 0, CTL_ZERO_BYTES, stream) != hipSuccess) return;
    Args a{};
    const void** pp = (const void**)&a.in;
    for (int i = 0; i < 18; ++i) pp[i] = d_in[i];
    a.out = (float*)d_out; a.ws = (unsigned char*)d_ws;
    for (int li = 0; li < N_LAUNCHES; ++li) {
        a.ph_lo = (N_LAUNCHES == PER_PHASE) ? li : 0; a.ph_hi = (N_LAUNCHES == PER_PHASE) ? li + 1 : PER_PHASE; a.li = li;
        hipLaunchKernelGGL(mk_fwd, dim3(grid), dim3(NTHR), LDS_BYTES, stream, a);
    }
}
```

```cpp
#include <hip/hip_runtime.h>
#include <cstdio>
#include <cstdint>
#include <cmath>
#define MK_N_LAUNCHES 1
namespace pg8 {
#define PG8_LAS __attribute__((address_space(3)))
typedef unsigned short bf16_t;
typedef short bf16x8 __attribute__((ext_vector_type(8)));
typedef float f32x4 __attribute__((ext_vector_type(4)));
typedef unsigned u32x4 __attribute__((ext_vector_type(4)));
constexpr int BM = 256, BK = 64, HALF = 128, HTB = HALF * BK * 2  , STAGE_BYTES = 8 * HTB, NXCD = 8, WGM = 8;

__host__ __device__ __forceinline__ int lds_byte(int r, int c) { const int st = (r >> 4) * 2 + (c >> 5), rr = r & 15, cc = c & 31, ob = rr * 64 + cc * 2; return st * 1024 + (ob ^ (((ob >> 9) & 1) << 5)); }
__host__ __device__ __forceinline__ void stage_rc(int b, int& R, int& C) { const int st = b / 1024, sb = b % 1024, swz = sb ^ (((sb >> 9) & 1) << 5); R = (st >> 1) * 16 + swz / 64; C = (st & 1) * 32 + (swz % 64) / 2; }
__host__ __device__ __forceinline__ int perm32(int rho) { const int n = rho >> 4, i = rho & 15; return 8 * (i >> 2) + 4 * n + (i & 3); }

struct Unit { int pm, pn; };
struct Gemm { const bf16_t* A; const bf16_t* Bt; int M, N, K; };

struct StaticOrder {
    int nM, nN, nwg, G, c;
    __host__ __device__ void init(int M, int N, int G_, int c_) { nM = M / BM; nN = N / BM; nwg = nM * nN; G = G_; c = c_; }
    __host__ __device__ bool next(int i, Unit& u) const {
        const long L = (long)i * G + c; if (L >= nwg) return false;
        int wgid = (int)L; { const int q = nwg / NXCD, r = nwg % NXCD, xcd = wgid % NXCD, off = wgid / NXCD; wgid = (xcd < r ? xcd * (q + 1) : r * (q + 1) + (xcd - r) * q) + off; }
        const int nig = WGM * nN, gid = wgid / nig, fm = gid * WGM, gsz = (nM - fm) < WGM ? (nM - fm) : WGM;
        u.pm = fm + ((wgid % nig) % gsz); u.pn = (wgid % nig) / gsz; return true;
    }
    __device__ __forceinline__ void a_ready(const Unit&) const {}
    __device__ __forceinline__ void done(const Unit&) const {}
};

__device__ __forceinline__ unsigned cvt_pk_bf16(float lo, float hi) { unsigned r; asm volatile("v_cvt_pk_bf16_f32 %0, %1, %2" : "=v"(r) : "v"(lo), "v"(hi)); return r; }
__device__ __forceinline__ u32x4 pack8(const f32x4 v0, const f32x4 v1) { u32x4 w; w.x = cvt_pk_bf16(v0[0], v0[1]); w.y = cvt_pk_bf16(v0[2], v0[3]); w.z = cvt_pk_bf16(v1[0], v1[1]); w.w = cvt_pk_bf16(v1[2], v1[3]); return w; }
__device__ __forceinline__ float sq8(const f32x4 a, const f32x4 b) { return (a[0] * a[0] + a[1] * a[1]) + (a[2] * a[2] + a[3] * a[3]) + (b[0] * b[0] + b[1] * b[1]) + (b[2] * b[2] + b[3] * b[3]); }
__device__ __forceinline__ float fast_sigmoid(float v) { return __builtin_amdgcn_rcpf(1.0f + __builtin_amdgcn_exp2f(-1.4426950408889634f * v)); }
__device__ __forceinline__ void rope8(f32x4& v0, f32x4& v1, const f32x4 c, const f32x4 s) {
    const float a0 = v0[0] * c[0] - v0[1] * s[0], b0 = v0[1] * c[0] + v0[0] * s[0];
    const float a1 = v0[2] * c[1] - v0[3] * s[1], b1 = v0[3] * c[1] + v0[2] * s[1];
    const float a2 = v1[0] * c[2] - v1[1] * s[2], b2 = v1[1] * c[2] + v1[0] * s[2];
    const float a3 = v1[2] * c[3] - v1[3] * s[3], b3 = v1[3] * c[3] + v1[2] * s[3];
    v0 = (f32x4){a0, b0, a1, b1}; v1 = (f32x4){a2, b2, a3, b3};
}
__device__ __forceinline__ void ssq_add(float* ssq, int row, float s, int fq) { s += __shfl_xor(s, 16); s += __shfl_xor(s, 32); if (fq == 0) atomicAdd(ssq + row, s); }

#define EPI_ROWS_BEGIN _Pragma("unroll") for (int ai = 0; ai < 2; ++ai) _Pragma("unroll") for (int m = 0; m < 4; ++m) { const int row = row0 + ai * HALF + m * 16;
#define EPI_ROWS_END }

struct EpiZ {
    static constexpr bool PERM = true, AFTER_DRAIN = false;
    bf16_t *RQ, *RK, *RV, *RG, *CQ, *CKV, *KPE; const float *RC, *RS, *MC, *MS; float *ssq_cq, *ssq_ckv;
    __device__ __forceinline__ void operator()(const f32x4 (&acc)[2][2][4][2], const Unit& u, int wr, int wc, int fr, int fq) const {
        const int pn = u.pn, row0 = u.pm * BM + wr * 64 + fr, cw = wc * 32 + 8 * fq;
        if (pn < 4) {
            bf16_t* dst = (pn < 2 ? RQ : RK) + (pn & 1) * 256 + cw; const int i0 = 16 * wc + 4 * fq;
            EPI_ROWS_BEGIN
                const f32x4 c = *(const f32x4*)(RC + (size_t)row * 64 + i0), s = *(const f32x4*)(RS + (size_t)row * 64 + i0);
#pragma unroll
                for (int bj = 0; bj < 2; ++bj) { f32x4 v0 = acc[ai][bj][m][0], v1 = acc[ai][bj][m][1]; rope8(v0, v1, c, s); *(u32x4*)(dst + (size_t)row * 512 + bj * HALF) = pack8(v0, v1); }
            EPI_ROWS_END
        } else if (pn < 8) {
            bf16_t* dst = (pn < 6 ? RV : RG) + (pn & 1) * 256 + cw;
            EPI_ROWS_BEGIN
#pragma unroll
                for (int bj = 0; bj < 2; ++bj) *(u32x4*)(dst + (size_t)row * 512 + bj * HALF) = pack8(acc[ai][bj][m][0], acc[ai][bj][m][1]);
            EPI_ROWS_END
        } else if (pn == 8) {
            EPI_ROWS_BEGIN
                float s = 0.f;
#pragma unroll
                for (int bj = 0; bj < 2; ++bj) { *(u32x4*)(CQ + (size_t)row * 256 + bj * HALF + cw) = pack8(acc[ai][bj][m][0], acc[ai][bj][m][1]); s += sq8(acc[ai][bj][m][0], acc[ai][bj][m][1]); }
                ssq_add(ssq_cq, row, s, fq);
            EPI_ROWS_END
        } else {
            const int i0 = 16 * wc + 4 * fq;
            EPI_ROWS_BEGIN
                *(u32x4*)(CKV + (size_t)row * 128 + cw) = pack8(acc[ai][0][m][0], acc[ai][0][m][1]);
                ssq_add(ssq_ckv, row, sq8(acc[ai][0][m][0], acc[ai][0][m][1]), fq);
                if (wc < 2) { const f32x4 c = *(const f32x4*)(MC + (size_t)row * 32 + i0), s = *(const f32x4*)(MS + (size_t)row * 32 + i0);
                    f32x4 v0 = acc[ai][1][m][0], v1 = acc[ai][1][m][1]; rope8(v0, v1, c, s); *(u32x4*)(KPE + (size_t)row * 64 + cw) = pack8(v0, v1); }
            EPI_ROWS_END
        }
    }
};
struct EpiQM {
    static constexpr bool PERM = true, AFTER_DRAIN = false;
    bf16_t* QM; const float *MC, *MS; const float* ssq; float qscale;
    __device__ __forceinline__ void operator()(const f32x4 (&acc)[2][2][4][2], const Unit& u, int wr, int wc, int fr, int fq) const {
        const int pn = u.pn, row0 = u.pm * BM + wr * 64 + fr, cw = wc * 32 + 8 * fq; const int i0 = 16 * (wc & 1) + 4 * fq;
        EPI_ROWS_BEGIN
            const float rs = qscale / sqrtf(ssq[row] * (1.0f / 256.0f) + 1e-6f);
            f32x4 c, s; if (pn == 2) { c = *(const f32x4*)(MC + (size_t)row * 32 + i0); s = *(const f32x4*)(MS + (size_t)row * 32 + i0); }
#pragma unroll
            for (int bj = 0; bj < 2; ++bj) { f32x4 v0 = acc[ai][bj][m][0] * rs, v1 = acc[ai][bj][m][1] * rs; if (pn == 2) rope8(v0, v1, c, s);
                *(u32x4*)(QM + (size_t)row * 768 + pn * 256 + bj * HALF + cw) = pack8(v0, v1); }
        EPI_ROWS_END
    }
};
struct EpiScaleBf16 {
    static constexpr bool PERM = true, AFTER_DRAIN = false;
    bf16_t* O; int ldc; const float* ssq; float inv_n;
    __device__ __forceinline__ void operator()(const f32x4 (&acc)[2][2][4][2], const Unit& u, int wr, int wc, int fr, int fq) const {
        const int row0 = u.pm * BM + wr * 64 + fr, col0 = u.pn * BM + wc * 32 + 8 * fq;
        EPI_ROWS_BEGIN
            const float rs = ssq ? 1.0f / sqrtf(ssq[row] * inv_n + 1e-6f) : 1.0f;
#pragma unroll
            for (int bj = 0; bj < 2; ++bj) *(u32x4*)(O + (size_t)row * ldc + col0 + bj * HALF) = pack8(acc[ai][bj][m][0] * rs, acc[ai][bj][m][1] * rs);
        EPI_ROWS_END
    }
};
struct EpiRes {
    static constexpr bool PERM = true, AFTER_DRAIN = false;
    const float* base; float* X; bf16_t* XB; float* ssq;
    __device__ __forceinline__ void operator()(const f32x4 (&acc)[2][2][4][2], const Unit& u, int wr, int wc, int fr, int fq) const {
        const int row0 = u.pm * BM + wr * 64 + fr, col0 = u.pn * BM + wc * 32 + 8 * fq;
        EPI_ROWS_BEGIN
            float s = 0.f;
#pragma unroll
            for (int bj = 0; bj < 2; ++bj) { const size_t off = (size_t)row * 1024 + col0 + bj * HALF;
                const f32x4 v0 = acc[ai][bj][m][0] + *(const f32x4*)(base + off), v1 = acc[ai][bj][m][1] + *(const f32x4*)(base + off + 4);
                *(f32x4*)(X + off) = v0; *(f32x4*)(X + off + 4) = v1; *(u32x4*)(XB + off) = pack8(v0, v1); s += sq8(v0, v1); }
            ssq_add(ssq, row, s, fq);
        EPI_ROWS_END
    }
};
struct EpiGU {
    static constexpr bool PERM = true, AFTER_DRAIN = false;
    bf16_t* ACT; int ldc; const float* ssq;
    __device__ __forceinline__ void operator()(const f32x4 (&acc)[2][2][4][2], const Unit& u, int wr, int wc, int fr, int fq) const {
        const int row0 = u.pm * BM + wr * 64 + fr, col0 = u.pn * HALF + wc * 32 + 8 * fq;
        EPI_ROWS_BEGIN
            const float rs = 1.0f / sqrtf(ssq[row] * (1.0f / 1024.0f) + 1e-6f);
            f32x4 o[2];
#pragma unroll
            for (int n = 0; n < 2; ++n) { const f32x4 g = acc[ai][0][m][n] * rs, up = acc[ai][1][m][n] * rs;
#pragma unroll
                for (int q = 0; q < 4; ++q) o[n][q] = g[q] * fast_sigmoid(g[q]) * up[q]; }
            *(u32x4*)(ACT + (size_t)row * ldc + col0) = pack8(o[0], o[1]);
        EPI_ROWS_END
    }
};
struct EpiPle {
    static constexpr bool PERM = true, AFTER_DRAIN = false;
    float* X; const bf16_t* PROJ; const float* ssq_in; float* ssq_out;
    __device__ __forceinline__ void operator()(const f32x4 (&acc)[2][2][4][2], const Unit& u, int wr, int wc, int fr, int fq) const {
        const int row0 = u.pm * BM + wr * 64 + fr, col0 = u.pn * BM + wc * 32 + 8 * fq;
        EPI_ROWS_BEGIN
            const float rs = 1.0f / sqrtf(ssq_in[row] * (1.0f / 1024.0f) + 1e-6f);
            float s = 0.f;
#pragma unroll
            for (int bj = 0; bj < 2; ++bj) { const size_t off = (size_t)row * 1024 + col0 + bj * HALF;
                const u32x4 pw = *(const u32x4*)(PROJ + off); const f32x4 x0 = *(const f32x4*)(X + off), x1 = *(const f32x4*)(X + off + 4);
                const f32x4 p0 = {__uint_as_float(pw.x << 16), __uint_as_float(pw.x & 0xffff0000u), __uint_as_float(pw.y << 16), __uint_as_float(pw.y & 0xffff0000u)};
                const f32x4 p1 = {__uint_as_float(pw.z << 16), __uint_as_float(pw.z & 0xffff0000u), __uint_as_float(pw.w << 16), __uint_as_float(pw.w & 0xffff0000u)};
                f32x4 v0, v1;
#pragma unroll
                for (int q = 0; q < 4; ++q) { v0[q] = x0[q] + fast_sigmoid(acc[ai][bj][m][0][q] * rs) * p0[q]; v1[q] = x1[q] + fast_sigmoid(acc[ai][bj][m][1][q] * rs) * p1[q]; }
                *(f32x4*)(X + off) = v0; *(f32x4*)(X + off + 4) = v1; s += sq8(v0, v1); }
            ssq_add(ssq_out, row, s, fq);
        EPI_ROWS_END
    }
};
template <class Epi, class Sched, bool ALIGN_EPI = false, bool SP2 = false>
__device__ __forceinline__ void gemm_phase(PG8_LAS unsigned char* lds, const Gemm g, const Sched& S, const Epi& E) {
    const int tid = threadIdx.x, wid = __builtin_amdgcn_readfirstlane(tid >> 6), lane = tid & 63, wr = wid >> 2, wc = wid & 3, fr = lane & 15, fq = lane >> 4;
    int Kop = g.K; asm volatile("" : "+s"(Kop));
    const int K = Kop, nt = K / BK;
    unsigned voffA[2], voffB[2];
#pragma unroll
    for (int i = 0; i < 2; ++i) { int R, C; stage_rc(tid * 16 + i * 8192, R, C); const int Rb = Epi::PERM ? ((R & ~31) + perm32(R & 31)) : R;
        voffA[i] = (unsigned)(R * K + C) * 2u; voffB[i] = (unsigned)(Rb * K + C) * 2u; }
    const size_t kstep = (size_t)(BK * 2);
    const size_t hstep = (size_t)HALF * K * 2;
    const size_t tstep = 2 * hstep;
    const unsigned ldsw = (unsigned)wid * 1024u;
    const int aoff = lds_byte(wr * 64 + fr, fq * 8), boff = lds_byte(wc * 32 + fr, fq * 8);
#define PG8_SA(b, h) (((b) * 2 + (h)) * HTB)
#define PG8_SB(b, h) ((4 + (b) * 2 + (h)) * HTB)
#define PG8_STAGE(bufoff, gbase, voff) do { _Pragma("unroll") for (int _i = 0; _i < 2; ++_i) \
        __builtin_amdgcn_global_load_lds((const unsigned*)((const char*)(gbase) + (voff)[_i]), (PG8_LAS unsigned*)(lds + (bufoff) + ldsw + _i * 8192), 16, 0, 0); } while (0)
#define PG8_LDA(dst, b, h) do { _Pragma("unroll") for (int m = 0; m < 4; ++m) _Pragma("unroll") for (int k = 0; k < 2; ++k) dst[m][k] = *(const PG8_LAS bf16x8*)(lds + PG8_SA(b, h) + aoff + m * 2048 + k * 1024); } while (0)
#define PG8_LDB(dst, b, h) do { _Pragma("unroll") for (int n = 0; n < 2; ++n) _Pragma("unroll") for (int k = 0; k < 2; ++k) dst[n][k] = *(const PG8_LAS bf16x8*)(lds + PG8_SB(b, h) + boff + n * 2048 + k * 1024); } while (0)
#define PG8_MMA(ai, bj, At, Bt) do { __builtin_amdgcn_s_setprio(1); _Pragma("unroll") for (int m = 0; m < 4; ++m) _Pragma("unroll") for (int n = 0; n < 2; ++n) _Pragma("unroll") for (int k = 0; k < 2; ++k) \
        acc[ai][bj][m][n] = __builtin_amdgcn_mfma_f32_16x16x32_bf16(Bt[n][k], At[m][k], acc[ai][bj][m][n], 0, 0, 0); __builtin_amdgcn_s_setprio(0); } while (0)
#define PG8_WAIT_V(n) asm volatile("s_waitcnt vmcnt(" #n ")" ::: "memory")
#define PG8_WAIT_L(n) asm volatile("s_waitcnt lgkmcnt(" #n ")" ::: "memory")
#define PG8_BAR __builtin_amdgcn_s_barrier()
#define PG8_SCHED __builtin_amdgcn_sched_barrier(0)
    Unit cur, nxt; int ui = 0;
    if (!S.next(0, cur)) return;
    f32x4 acc[2][2][4][2];
#pragma unroll
    for (int a = 0; a < 2; ++a)
#pragma unroll
        for (int b = 0; b < 2; ++b)
#pragma unroll
            for (int m = 0; m < 4; ++m)
#pragma unroll
                for (int n = 0; n < 2; ++n) acc[a][b][m][n] = (f32x4){0.f, 0.f, 0.f, 0.f};
    bf16x8 At[4][2], B0[2][2], B1[2][2];
    const char* cA = (const char*)g.A + (size_t)cur.pm * tstep; const char* cB = (const char*)g.Bt + (size_t)cur.pn * tstep;
    S.a_ready(cur);
    if constexpr (SP2) {
        PG8_STAGE(PG8_SB(0, 0), cB, voffB); PG8_STAGE(PG8_SB(0, 1), cB + hstep, voffB); PG8_STAGE(PG8_SA(0, 0), cA, voffA); PG8_STAGE(PG8_SA(0, 1), cA + hstep, voffA);
        if (wr == 1) PG8_BAR;
        PG8_WAIT_V(2); PG8_BAR;
        PG8_STAGE(PG8_SB(1, 0), cB + kstep, voffB); PG8_STAGE(PG8_SA(1, 0), cA + kstep, voffA); PG8_STAGE(PG8_SB(1, 1), cB + hstep + kstep, voffB);
        PG8_WAIT_V(6); PG8_BAR;
    } else {
        PG8_STAGE(PG8_SB(0, 0), cB, voffB); PG8_STAGE(PG8_SA(0, 0), cA, voffA); PG8_STAGE(PG8_SB(0, 1), cB + hstep, voffB); PG8_STAGE(PG8_SA(0, 1), cA + hstep, voffA);
        if (wr == 1) PG8_BAR;
        PG8_WAIT_V(4); PG8_BAR;
        PG8_STAGE(PG8_SB(1, 0), cB + kstep, voffB); PG8_STAGE(PG8_SA(1, 0), cA + kstep, voffA); PG8_STAGE(PG8_SB(1, 1), cB + hstep + kstep, voffB);
        PG8_WAIT_V(6); PG8_BAR;
    }
    for (;;) {
        const bool has_next = S.next(ui + 1, nxt);
        const char* nA = has_next ? (const char*)g.A + (size_t)nxt.pm * tstep : cA; const char* nB = has_next ? (const char*)g.Bt + (size_t)nxt.pn * tstep : cB;
        for (int t = 0; t < nt; t += 2) {
            const bool last = (t == nt - 2);
            const char* a1 = cA + (size_t)(t + 1) * kstep;
            const char* a2 = last ? nA : cA + (size_t)(t + 2) * kstep; const char* b2 = last ? nB : cB + (size_t)(t + 2) * kstep;
            const char* a3 = a2 + kstep; const char* b3 = b2 + kstep;
            if (last && has_next) S.a_ready(nxt);
            if constexpr (SP2) {
            PG8_LDB(B0, 0, 0); PG8_LDB(B1, 0, 1); PG8_SCHED; PG8_LDA(At, 0, 0); PG8_STAGE(PG8_SA(1, 1), a1 + hstep, voffA);
            PG8_WAIT_V(8); PG8_WAIT_L(0); PG8_BAR; PG8_MMA(0, 0, At, B0); PG8_MMA(0, 1, At, B1); PG8_BAR; PG8_SCHED;
            PG8_LDA(At, 0, 1); PG8_STAGE(PG8_SB(0, 0), b2, voffB); PG8_STAGE(PG8_SB(0, 1), b2 + hstep, voffB); PG8_STAGE(PG8_SA(0, 0), a2, voffA);
            PG8_WAIT_V(8); PG8_WAIT_L(0); PG8_BAR; PG8_MMA(1, 0, At, B0); PG8_MMA(1, 1, At, B1); PG8_BAR; PG8_SCHED;
            PG8_LDB(B0, 1, 0); PG8_LDB(B1, 1, 1); PG8_SCHED; PG8_LDA(At, 1, 0); PG8_STAGE(PG8_SA(0, 1), a2 + hstep, voffA);
            PG8_WAIT_V(8); PG8_WAIT_L(0); PG8_BAR; PG8_MMA(0, 0, At, B0); PG8_MMA(0, 1, At, B1); PG8_BAR; PG8_SCHED;
            PG8_LDA(At, 1, 1); PG8_STAGE(PG8_SB(1, 0), b3, voffB); PG8_STAGE(PG8_SB(1, 1), b3 + hstep, voffB); PG8_STAGE(PG8_SA(1, 0), a3, voffA);
            PG8_WAIT_V(8); PG8_WAIT_L(0); PG8_BAR; PG8_MMA(1, 0, At, B0); PG8_MMA(1, 1, At, B1); PG8_BAR; PG8_SCHED;
            } else {
            PG8_LDB(B0, 0, 0); PG8_SCHED; PG8_LDA(At, 0, 0); PG8_STAGE(PG8_SA(1, 1), a1 + hstep, voffA);
            PG8_WAIT_L(8); PG8_BAR; PG8_WAIT_L(0); PG8_MMA(0, 0, At, B0); PG8_BAR; PG8_SCHED;
            PG8_LDB(B1, 0, 1); PG8_STAGE(PG8_SB(0, 0), b2, voffB);
            PG8_BAR; PG8_WAIT_L(0); PG8_MMA(0, 1, At, B1); PG8_BAR;
            PG8_LDA(At, 0, 1); PG8_STAGE(PG8_SA(0, 0), a2, voffA);
            PG8_BAR; PG8_WAIT_L(0); PG8_MMA(1, 0, At, B0); PG8_BAR; PG8_SCHED;
            PG8_STAGE(PG8_SB(0, 1), b2 + hstep, voffB);
            PG8_WAIT_V(6); PG8_BAR; PG8_MMA(1, 1, At, B1); PG8_BAR;
            PG8_LDB(B0, 1, 0); PG8_SCHED; PG8_LDA(At, 1, 0); PG8_STAGE(PG8_SA(0, 1), a2 + hstep, voffA);
            PG8_WAIT_L(8); PG8_BAR; PG8_WAIT_L(0); PG8_MMA(0, 0, At, B0); PG8_BAR; PG8_SCHED;
            PG8_LDB(B1, 1, 1); PG8_STAGE(PG8_SB(1, 0), b3, voffB);
            PG8_BAR; PG8_WAIT_L(0); PG8_MMA(0, 1, At, B1); PG8_BAR;
            PG8_LDA(At, 1, 1); PG8_STAGE(PG8_SA(1, 0), a3, voffA);
            PG8_BAR; PG8_WAIT_L(0); PG8_MMA(1, 0, At, B0); PG8_BAR; PG8_SCHED;
            PG8_STAGE(PG8_SB(1, 1), b3 + hstep, voffB);
            PG8_WAIT_V(6); PG8_BAR; PG8_MMA(1, 1, At, B1); PG8_BAR;
            }
        }
        if constexpr (ALIGN_EPI) { if (wr == 0) PG8_BAR; }
        if constexpr (!Epi::AFTER_DRAIN) { E(acc, cur, wr, wc, fr, fq); S.done(cur); }
        if (!has_next) break;
#pragma unroll
        for (int a = 0; a < 2; ++a)
#pragma unroll
            for (int b = 0; b < 2; ++b)
#pragma unroll
                for (int m = 0; m < 4; ++m)
#pragma unroll
                    for (int n = 0; n < 2; ++n) acc[a][b][m][n] = (f32x4){0.f, 0.f, 0.f, 0.f};
        cur = nxt; cA = nA; cB = nB; ++ui;
        if constexpr (ALIGN_EPI) { if (wr == 1) PG8_BAR; }
    }
    PG8_WAIT_V(0);
    if constexpr (!ALIGN_EPI) { if (wr == 0) PG8_BAR; }
    PG8_BAR;
    if constexpr (Epi::AFTER_DRAIN) { E.fused(acc, cur, wr, wc, fr, fq, lds, wid, lane); S.done(cur); }
#undef PG8_SA
#undef PG8_SB
#undef PG8_STAGE
#undef PG8_LDA
#undef PG8_LDB
#undef PG8_MMA
#undef PG8_WAIT_V
#undef PG8_WAIT_L
#undef PG8_BAR
#undef PG8_SCHED
}
}

constexpr int NWAVES = 8, NTHR = 512;
constexpr int BATCH = 2, SEQ = 8192, T = BATCH * SEQ, D = 1024, CHUNK = 64, NCH = SEQ / CHUNK;
constexpr int RH = 4, MH = 4, DFF = 2816, INC = 2496, NZ = 2560, NQM = 768, NKV = 1024, NGU = 2 * DFF, DPLE = 256;
constexpr float QSCALE = 0.07216878364870322f * 1.4426950408889634f;
#ifndef MK_N_LAUNCHES
#define MK_N_LAUNCHES 1
#endif
constexpr int PER_PHASE = 10;
constexpr int N_LAUNCHES = MK_N_LAUNCHES;

constexpr size_t MiB = 1u << 20;
constexpr size_t WS_CTL = 0, CTL_ZERO_BYTES = 1 * MiB;
constexpr size_t WS_SSQ = 256 * 1024;
constexpr size_t WS_WIN = 1 * MiB, WS_WUQ = 6 * MiB, WS_WUKV = 6 * MiB + 512 * 1024, WS_WO = 7 * MiB, WS_WGU = 9 * MiB, WS_WD = 20 * MiB, WS_WPG = 26 * MiB, WS_WPP = 28 * MiB;
constexpr size_t WS_RC = 29 * MiB, WS_RS = 33 * MiB, WS_MC = 37 * MiB, WS_MS = 39 * MiB;
constexpr size_t WS_XN = 42 * MiB;
constexpr size_t WS_RQ = 74 * MiB, WS_RK = 90 * MiB, WS_RV = 106 * MiB, WS_RG = 122 * MiB, WS_QM = 138 * MiB;
constexpr size_t WS_ACT = 74 * MiB;
constexpr size_t WS_CQ = 162 * MiB, WS_CKV = 170 * MiB, WS_KPE = 174 * MiB;
constexpr size_t WS_KVB = 176 * MiB;
constexpr size_t WS_CAT = 208 * MiB;
constexpr size_t WS_PB = 240 * MiB;
constexpr size_t WS_END = 248 * MiB;
constexpr int CW_TMO = 0, CW_CODE = 1, CW_BAR = 4096;

constexpr int RING_OFF = 0, RING_BYTES = 131072;
constexpr int LDS_BYTES = 163840;
constexpr int LDSCTL_OFF = LDS_BYTES - 1024, MISC_OFF = LDSCTL_OFF + 320;
#define GAS __attribute__((address_space(1)))
#define LAS __attribute__((address_space(3)))
typedef unsigned short bf16;
typedef unsigned v4u __attribute__((ext_vector_type(4)));
typedef float f32x4 __attribute__((ext_vector_type(4)));
typedef short bf16x8 __attribute__((ext_vector_type(8)));
typedef GAS unsigned gu32;
typedef GAS unsigned long long gu64;
#define RLX_AGENT __ATOMIC_RELAXED, __HIP_MEMORY_SCOPE_AGENT
#define LDS_WAIT() asm volatile("s_waitcnt lgkmcnt(0)" ::: "memory")
#define VM_WAIT() asm volatile("s_waitcnt vmcnt(0)" ::: "memory")
__device__ __forceinline__ unsigned long long rt() { return __builtin_amdgcn_s_memrealtime(); }
__device__ __forceinline__ unsigned f2bf(float f) { unsigned u = __builtin_bit_cast(unsigned, f); return (u + 0x7fffu + ((u >> 16) & 1u)) >> 16; }
__device__ __forceinline__ unsigned pk2(float lo, float hi) { return f2bf(lo) | (f2bf(hi) << 16); }

#define XB_TMO      128
#define XB_XCNT(j)  (256  + 64 * (j))
#define XB_XSUB(j)  (1280 + 64 * (j))
#define XB_XGEN(j)  (2304 + 64 * (j))
#define XB_TOP      3328
#define XB_TOPGEN   3392
#define XCD_BAR_WORDS 3456
#define XB_SPIN_CAP (1u << 18)

__device__ __forceinline__ unsigned xb_ld(unsigned* p)              { return __hip_atomic_load(p, __ATOMIC_RELAXED, __HIP_MEMORY_SCOPE_AGENT); }
__device__ __forceinline__ unsigned xb_add(unsigned* p, unsigned v) { return __hip_atomic_fetch_add(p, v, __ATOMIC_RELAXED, __HIP_MEMORY_SCOPE_AGENT); }
__device__ __forceinline__ unsigned xb_xcc_id() { return (unsigned)__builtin_amdgcn_s_getreg((3 << 11) | 20) & 0xFu; }
#define XB_SPIN(cond, bar) do { unsigned _sp = 0; while (cond) { __builtin_amdgcn_s_sleep(1); \
    if ((++_sp & 255u) == 0u) { if (xb_ld(&(bar)[XB_TMO])) break; if (_sp > XB_SPIN_CAP) { atomicAdd(&(bar)[XB_TMO], 1u); break; } } } } while (0)

struct XcdBarrier {
    unsigned* bar; unsigned x;
    volatile LAS unsigned* st;
};

__device__ __forceinline__ XcdBarrier xcd_barrier_post(unsigned* bar, volatile LAS unsigned* st) {
    XcdBarrier b; b.bar = bar; b.x = xb_xcc_id(); b.st = st;
    if (threadIdx.x == 0) (void)xb_add(&bar[XB_XCNT(b.x)], 1u);
    return b;
}
__device__ __forceinline__ void xcd_barrier_complete(unsigned* bar, unsigned x, unsigned& nloc, unsigned& nx) {
    const unsigned G = gridDim.x * gridDim.y * gridDim.z;
    unsigned sum, cnt, mine, sp = 0u;
    for (;;) {
        sum = 0u; cnt = 0u; mine = 0u;
#pragma unroll
        for (unsigned j = 0; j < 16; ++j) { const unsigned c = xb_ld(&bar[XB_XCNT(j)]); sum += c; cnt += (c > 0u) ? 1u : 0u; mine = (j == x) ? c : mine; }
        if (sum == G) break;
        __builtin_amdgcn_s_sleep(1);
        if ((++sp & 255u) == 0u) { if (xb_ld(&bar[XB_TMO])) break; if (sp > XB_SPIN_CAP) { atomicAdd(&bar[XB_TMO], 1u); break; } }
    }
    nloc = mine > 0u ? mine : 1u; nx = cnt > 0u ? cnt : 1u;
}

__device__ __forceinline__ void xcd_barrier(const XcdBarrier& b) {
    asm volatile("s_waitcnt vmcnt(0)" ::: "memory");
    __syncthreads();
    if (threadIdx.x == 0) {
        unsigned* bar = b.bar;
        __builtin_amdgcn_s_waitcnt(0);
        unsigned nloc = b.st[0], nx = b.st[1];
        if (nloc == 0u) { xcd_barrier_complete(bar, b.x, nloc, nx); b.st[0] = nloc; b.st[1] = nx; }
        const unsigned old = xb_add(&bar[XB_XSUB(b.x)], 1u);
        const unsigned gen = old / nloc;
        if (old + 1u == (gen + 1u) * nloc) {
            __builtin_amdgcn_fence(__ATOMIC_RELEASE, "agent");
            asm volatile("s_waitcnt vmcnt(0)" ::: "memory");
            const unsigned og = xb_add(&bar[XB_TOP], 1u);
            const unsigned tg = og / nx;
            if (og + 1u == (tg + 1u) * nx) xb_add(&bar[XB_TOPGEN], 1u);
            else XB_SPIN(xb_ld(&bar[XB_TOPGEN]) == tg, bar);
            __builtin_amdgcn_fence(__ATOMIC_ACQUIRE, "agent");
            xb_add(&bar[XB_XGEN(b.x)], 1u);
            asm volatile("s_waitcnt vmcnt(0)" ::: "memory");
        } else {
            XB_SPIN(xb_ld(&bar[XB_XGEN(b.x)]) == gen, bar);
            __builtin_amdgcn_fence(__ATOMIC_ACQUIRE, "agent");
            asm volatile("s_waitcnt vmcnt(0)" ::: "memory");
        }
    }
    __syncthreads();
}

struct Frame {
    LAS unsigned char* lds;
    volatile LAS unsigned* MISC;
    gu32* ctl;
    int tid, lane, wave, vcu, G;
};
__device__ __forceinline__ float bf2f(bf16 v) { return __uint_as_float((unsigned)v << 16); }
__device__ __forceinline__ float wave_sum(float v) {
#pragma unroll
    for (int o = 1; o < 64; o <<= 1) v += __shfl_xor(v, o);
    return v;
}
__device__ __forceinline__ float ret_logg(int h) { return log1pf(-exp2f(-5.0f - (float)h)); }

struct PArgs { const float *x, *p; const int* pos; const float *mix_g, *w_in, *qn_g, *w_uq, *kvn_g, *w_ukv, *w_o, *ffn_g, *w_g, *w_u, *w_d, *ple_g, *w_pg, *w_pp, *fin_g; };
__device__ __forceinline__ const float* p0_src(const PArgs& a, int kind, int n, float& cs) {
    cs = 1.0f;
    switch (kind) {
    case 0: {
        if (n < 1024) { const int g = n & 127; if (n >= 512) cs = 0.08838834764831845f; return a.w_in + (n & ~127) + (g >> 1) + 64 * (g & 1); }
        if (n < 2432) return a.w_in + n;
        if (n < 2496) { const int g = n - 2432; return a.w_in + 2432 + (g >> 1) + 32 * (g & 1); }
        return nullptr; }
    case 1: {
        if (n < 512) return a.w_uq + (n >> 7) * 192 + (n & 127);
        const int r = n - 512, g = r & 63; return a.w_uq + (r >> 6) * 192 + 128 + (g >> 1) + 32 * (g & 1); }
    case 2: return a.w_ukv + n;
    case 3: return a.w_o + n;
    case 4: { const int t = n >> 8, r = n & 255; return (r < 128 ? a.w_g : a.w_u) + 128 * t + (r & 127); }
    case 5: return a.w_d + n;
    case 6: return a.w_pg + n;
    default: return a.w_pp + n;
    }
}
__device__ __forceinline__ void p0_item(const PArgs& a, int kind, int ldw, int K, const float* gk, bf16* WT, LAS float* scr, int item, int nblk, int lane) {
    const int kb = item / nblk, nb = item % nblk, k0 = 64 * kb, n0 = 32 * nb;
    float cs; const float* src = p0_src(a, kind, n0 + (lane & 31), cs);
#pragma unroll 8
    for (int i = 0; i < 32; ++i) { const int kk = 2 * i + (lane >> 5); float v = 0.f;
        if (src) { v = src[(size_t)(k0 + kk) * ldw] * cs; if (gk) v *= gk[k0 + kk]; }
        scr[kk * 33 + (lane & 31)] = v; }
    LDS_WAIT(); asm volatile("" ::: "memory");
    const int c = lane & 7;
#pragma unroll
    for (int j = 0; j < 4; ++j) { const int n = (lane >> 3) + 8 * j; const LAS float* s = scr + (8 * c) * 33 + n;
        v4u o; o.x = pk2(s[0 * 33], s[1 * 33]); o.y = pk2(s[2 * 33], s[3 * 33]); o.z = pk2(s[4 * 33], s[5 * 33]); o.w = pk2(s[6 * 33], s[7 * 33]);
        *(GAS v4u*)(WT + (size_t)(n0 + n) * K + k0 + 8 * c) = o; }
    LDS_WAIT(); asm volatile("" ::: "memory");
}
__device__ __forceinline__ void p0_prologue(Frame& F, const PArgs& a, unsigned char* ws) {
    LAS float* scr = (LAS float*)(F.lds + RING_OFF + F.wave * 16384);
    const int gw = F.vcu * NWAVES + F.wave, NGW = F.G * NWAVES;
    constexpr int NMAT = 8;
    const int Ks[NMAT] = {1024, 256, 128, 1024, 1024, 2816, 1024, 256}, Ns[NMAT] = {NZ, NQM, NKV, 1024, NGU, 1024, 1024, 1024}, LDW[NMAT] = {INC, NQM, NKV, 1024, DFF, 1024, 1024, 1024};
    const size_t OFF[NMAT] = {WS_WIN, WS_WUQ, WS_WUKV, WS_WO, WS_WGU, WS_WD, WS_WPG, WS_WPP};
    int base = 0;
#pragma unroll
    for (int k = 0; k < NMAT; ++k) {
        const int nblk = Ns[k] / 32, nit = (Ks[k] / 64) * nblk;
        const float* gk = k == 1 ? a.qn_g : k == 2 ? a.kvn_g : k == 4 ? a.ffn_g : k == 6 ? a.ple_g : nullptr;
        int first = gw - (base % NGW); if (first < 0) first += NGW;
        for (int it = first; it < nit; it += NGW) p0_item(a, k, LDW[k], Ks[k], gk, (bf16*)(ws + OFF[k]), scr, it, nblk, F.lane);
        base += nit;
    }
    bf16* XN = (bf16*)(ws + WS_XN);
    for (int m = gw; m < T; m += NGW) {
        const GAS f32x4* xr = (const GAS f32x4*)(a.x + (size_t)m * D) + F.lane; const GAS f32x4* gr = (const GAS f32x4*)a.mix_g + F.lane;
        f32x4 v[4]; float s = 0.f;
#pragma unroll
        for (int j = 0; j < 4; ++j) { v[j] = xr[64 * j]; s += (v[j].x * v[j].x + v[j].y * v[j].y) + (v[j].z * v[j].z + v[j].w * v[j].w); }
        const float rs = 1.0f / sqrtf(wave_sum(s) * (1.0f / D) + 1e-6f);
        GAS unsigned long long* o8 = (GAS unsigned long long*)(XN + (size_t)m * D) + F.lane;
#pragma unroll
        for (int j = 0; j < 4; ++j) { const f32x4 g = gr[64 * j]; o8[64 * j] = (unsigned long long)pk2(v[j].x * rs * g.x, v[j].y * rs * g.y) | ((unsigned long long)pk2(v[j].z * rs * g.z, v[j].w * rs * g.w) << 32); }
    }
    { const int gt = F.vcu * NTHR + F.tid, NGT = F.G * NTHR; bf16* PB = (bf16*)(ws + WS_PB);
      for (int i = gt; i < T * DPLE / 4; i += NGT) { const f32x4 v = ((const GAS f32x4*)a.p)[i]; ((GAS unsigned long long*)PB)[i] = (unsigned long long)pk2(v.x, v.y) | ((unsigned long long)pk2(v.z, v.w) << 32); } }
    { const int gt = F.vcu * NTHR + F.tid, NGT = F.G * NTHR; float* RC = (float*)(ws + WS_RC); float* RS = (float*)(ws + WS_RS); float* MC = (float*)(ws + WS_MC); float* MS = (float*)(ws + WS_MS);
      for (int i = gt; i < T * 64; i += NGT) { const int t = i >> 6, k = i & 63; const float ang = (float)a.pos[t] * expf(-logf(10000.0f) * (float)k / 64.0f); RC[i] = cosf(ang); RS[i] = sinf(ang); }
      for (int i = gt; i < T * 32; i += NGT) { const int t = i >> 5, k = i & 31; const float ang = (float)a.pos[t] * expf(-logf(10000.0f) * (float)k / 32.0f); MC[i] = cosf(ang); MS[i] = sinf(ang); } }
}

__device__ __forceinline__ void ret_kv_simple(Frame& F, const bf16* RK, const bf16* RV, bf16* KVS) {
    LAS float* ks = (LAS float*)F.lds; LAS float* vs = ks + 64 * 128;
    for (int blk = F.vcu; blk < BATCH * NCH * RH; blk += F.G) {
        const int h = blk % RH, n = (blk / RH) % NCH, b = blk / (RH * NCH);
        const float lg = ret_logg(h); const size_t t0 = (size_t)b * SEQ + (size_t)n * CHUNK;
        for (int idx = F.tid; idx < 64 * 128; idx += NTHR) { const int j = idx >> 7, d = idx & 127;
            ks[idx] = bf2f(RK[(t0 + j) * 512 + h * 128 + d]) * expf(lg * (float)(CHUNK - 1 - j)); vs[idx] = bf2f(RV[(t0 + j) * 512 + h * 128 + d]); }
        __syncthreads();
        const int d = F.tid >> 2, e0 = (F.tid & 3) * 32;
        float acc[32];
#pragma unroll
        for (int e = 0; e < 32; ++e) acc[e] = 0.f;
        for (int j = 0; j < 64; ++j) { const float kd = ks[j * 128 + d];
#pragma unroll
            for (int e = 0; e < 32; ++e) acc[e] += kd * vs[j * 128 + e0 + e]; }
        GAS unsigned* o = (GAS unsigned*)(KVS + (size_t)blk * 16384 + d * 128 + e0);
#pragma unroll
        for (int e = 0; e < 16; ++e) o[e] = pk2(acc[2 * e], acc[2 * e + 1]);
        __syncthreads();
    }
}
__device__ __forceinline__ void ret_scan_simple(Frame& F, bf16* KVS) {
    for (int gid = F.vcu * NTHR + F.tid; gid < BATCH * RH * 16384; gid += F.G * NTHR) {
        const int de = gid & 16383, h = (gid >> 14) % RH, b = gid >> 16;
        const float c = expf(ret_logg(h) * (float)CHUNK); float S = 0.f;
        for (int n = 0; n < NCH; ++n) { bf16* p = KVS + ((size_t)((b * NCH + n) * RH + h)) * 16384 + de; const float kv = bf2f(*p); *p = (bf16)f2bf(S); S = c * S + kv; }
    }
}
__device__ __forceinline__ void ret_out_simple(Frame& F, const bf16* RQ, const bf16* RK, const bf16* RV, const bf16* RG, const bf16* PREV, bf16* CAT) {
    LAS float* qs = (LAS float*)F.lds; LAS float* ks = qs + 64 * 129; LAS float* vs = ks + 64 * 129; LAS float* ss = vs + 64 * 128;
    for (int blk = F.vcu; blk < BATCH * NCH * RH; blk += F.G) {
        const int h = blk % RH, n = (blk / RH) % NCH, b = blk / (RH * NCH);
        const float lg = ret_logg(h); const size_t t0 = (size_t)b * SEQ + (size_t)n * CHUNK;
        for (int idx = F.tid; idx < 64 * 128; idx += NTHR) { const int j = idx >> 7, d = idx & 127; const size_t g = (t0 + j) * 512 + h * 128 + d;
            qs[j * 129 + d] = bf2f(RQ[g]); ks[j * 129 + d] = bf2f(RK[g]); vs[j * 128 + d] = bf2f(RV[g]); }
        __syncthreads();
        { const int i = F.tid >> 3, jq = F.tid & 7;
          for (int jj = 0; jj < 8; ++jj) { const int j = jq * 8 + jj; float dot = 0.f;
              for (int d = 0; d < 128; ++d) dot += qs[i * 129 + d] * ks[j * 129 + d];
              const int dij = i > j ? i - j : j - i; ss[i * 65 + j] = dot * expf(lg * (float)dij); } }
        __syncthreads();
        const int e = F.tid & 127, ih = F.tid >> 7;
        float acc[16], acc2[16];
#pragma unroll
        for (int ii = 0; ii < 16; ++ii) { acc[ii] = 0.f; acc2[ii] = 0.f; }
        for (int j = 0; j < 64; ++j) { const float vv = vs[j * 128 + e];
#pragma unroll
            for (int ii = 0; ii < 16; ++ii) acc[ii] += ss[(ih * 16 + ii) * 65 + j] * vv; }
        const bf16* pv = PREV + (size_t)blk * 16384;
        for (int d = 0; d < 128; ++d) { const float p = bf2f(pv[d * 128 + e]);
#pragma unroll
            for (int ii = 0; ii < 16; ++ii) acc2[ii] += qs[(ih * 16 + ii) * 129 + d] * p; }
        __syncthreads();
        LAS float* os = qs;
#pragma unroll
        for (int ii = 0; ii < 16; ++ii) { const int i = ih * 16 + ii; os[i * 128 + e] = acc[ii] + expf(lg * (float)(i + 1)) * acc2[ii]; }
        __syncthreads();
        for (int r = 0; r < 8; ++r) { const int i = F.wave * 8 + r;
            const float a0 = os[i * 128 + F.lane], a1 = os[i * 128 + F.lane + 64];
            const float mu = wave_sum(a0 + a1) * (1.0f / 128.0f); const float d0 = a0 - mu, d1 = a1 - mu;
            const float rs = 1.0f / sqrtf(wave_sum(d0 * d0 + d1 * d1) * (1.0f / 128.0f) + 1e-5f);
            const float g0 = bf2f(RG[(t0 + i) * 512 + h * 128 + F.lane]), g1 = bf2f(RG[(t0 + i) * 512 + h * 128 + F.lane + 64]);
            bf16* orow = CAT + (t0 + i) * D + h * 128;
            orow[F.lane] = (bf16)f2bf(d0 * rs * (g0 / (1.0f + expf(-g0)))); orow[F.lane + 64] = (bf16)f2bf(d1 * rs * (g1 / (1.0f + expf(-g1)))); }
        __syncthreads();
    }
}
__device__ __forceinline__ void attn_simple(Frame& F, const bf16* QM, const bf16* KVB, const bf16* KPE, bf16* CAT) {
    LAS float* Qs = (LAS float*)F.lds; LAS float* Ks = Qs + 64 * 193; LAS float* Vs = Ks + 64 * 193; LAS float* Ss = Vs + 64 * 128;
    for (int i = 0;; ++i) {
        const int L = i * F.G + F.vcu; if (L >= BATCH * MH * NCH) break;
        const int bh = L & 7, x = (L >> 3) & 31, rnd = L >> 8; const int c = (rnd & 1) ? (rnd * 32 + x) : (rnd * 32 + 31 - x);
        const int h = bh & 3, b = bh >> 2;
        const size_t tq0 = (size_t)b * SEQ + (size_t)c * CHUNK;
        __syncthreads();
        for (int idx = F.tid; idx < 64 * 192; idx += NTHR) { const int r = idx / 192, d = idx % 192;
            Qs[r * 193 + d] = bf2f(d < 128 ? QM[(tq0 + r) * NQM + h * 128 + d] : QM[(tq0 + r) * NQM + 512 + h * 64 + (d - 128)]); }
        const int qi = F.tid >> 3, part = F.tid & 7;
        float m = -INFINITY, l = 0.f; float acc[16];
#pragma unroll
        for (int e = 0; e < 16; ++e) acc[e] = 0.f;
        for (int kt = 0; kt <= c; ++kt) {
            __syncthreads();
            const size_t tk0 = (size_t)b * SEQ + (size_t)kt * CHUNK;
            for (int idx = F.tid; idx < 64 * 192; idx += NTHR) { const int j = idx / 192, d = idx % 192;
                Ks[j * 193 + d] = bf2f(d < 128 ? KVB[(tk0 + j) * NKV + h * 256 + d] : KPE[(tk0 + j) * 64 + (d - 128)]); }
            for (int idx = F.tid; idx < 64 * 128; idx += NTHR) { const int j = idx >> 7, e = idx & 127; Vs[idx] = bf2f(KVB[(tk0 + j) * NKV + h * 256 + 128 + e]); }
            __syncthreads();
            for (int jj = 0; jj < 8; ++jj) { const int j = part * 8 + jj; float dot = 0.f;
                for (int d = 0; d < 192; ++d) dot += Qs[qi * 193 + d] * Ks[j * 193 + d];
                Ss[qi * 65 + j] = dot; }
            __syncthreads();
            float mx = m;
            for (int j = 0; j < 64; ++j) mx = fmaxf(mx, Ss[qi * 65 + j]);
            const float alpha = exp2f(m - mx); l *= alpha;
#pragma unroll
            for (int e = 0; e < 16; ++e) acc[e] *= alpha;
            for (int j = 0; j < 64; ++j) { const float p = exp2f(Ss[qi * 65 + j] - mx); l += p; const LAS float* vr = Vs + j * 128 + part * 16;
#pragma unroll
                for (int e = 0; e < 16; ++e) acc[e] += p * vr[e]; }
            m = mx;
        }
        const float il = 1.0f / l;
        GAS unsigned* o = (GAS unsigned*)(CAT + (tq0 + qi) * D + 512 + h * 128 + part * 16);
#pragma unroll
        for (int e = 0; e < 8; ++e) o[e] = pk2(acc[2 * e] * il, acc[2 * e + 1] * il);
    }
    __syncthreads();
}
__device__ __forceinline__ void final_norm(Frame& F, float* X, const float* ssq, const float* g) {
    const int gw = F.vcu * NWAVES + F.wave, NGW = F.G * NWAVES;
    for (int m = gw; m < T; m += NGW) {
        const float rs = 1.0f / sqrtf(ssq[m] * (1.0f / D) + 1e-6f);
        GAS f32x4* xr = (GAS f32x4*)(X + (size_t)m * D) + F.lane; const GAS f32x4* gr = (const GAS f32x4*)g + F.lane;
#pragma unroll
        for (int j = 0; j < 4; ++j) { const f32x4 v = xr[64 * j], gg = gr[64 * j]; xr[64 * j] = (f32x4){v.x * rs * gg.x, v.y * rs * gg.y, v.z * rs * gg.z, v.w * rs * gg.w}; }
    }
}


namespace att {
typedef float f32x16 __attribute__((ext_vector_type(16)));
typedef short s16x4 __attribute__((ext_vector_type(4)));
typedef short v4i16_t __attribute__((ext_vector_type(4)));
constexpr int KB_OFF = 0, KSLOT = 24576, VB_OFF = 49152, VSLOT = 16384, MERGE_OFF = 0, STAGE_OFF = 65536, WSF_OFF = 122880, ST_OFF = 124928;
constexpr float THR = 8.0f;
__device__ __forceinline__ void glds16(const void* gsrc, unsigned lds_dst) { unsigned keep;
    asm volatile("s_mov_b32 %0, m0\n\ts_mov_b32 m0, %2\n\ts_nop 0\n\tglobal_load_lds_dwordx4 %1, off\n\ts_mov_b32 m0, %0" : "=&s"(keep) : "v"(gsrc), "s"(lds_dst) : "memory"); }
__device__ __forceinline__ int crow(int r, int hi) { return (r & 3) + 8 * (r >> 2) + 4 * hi; }
__device__ __forceinline__ s16x4 vtr(const LAS char* p) { return __builtin_bit_cast(s16x4, __builtin_amdgcn_ds_read_tr16_b64_v4i16((LAS v4i16_t*)p)); }
__device__ __forceinline__ unsigned cvtpk(float lo, float hi) { unsigned r; asm volatile("v_cvt_pk_bf16_f32 %0, %1, %2" : "=v"(r) : "v"(lo), "v"(hi)); return r; }
__device__ __forceinline__ float swap_max(float m) { auto rr = __builtin_amdgcn_permlane32_swap(__float_as_uint(m), __float_as_uint(m), false, false); return fmaxf(__uint_as_float(rr[0]), __uint_as_float(rr[1])); }
__device__ __forceinline__ float swap_sum(float m) { auto rr = __builtin_amdgcn_permlane32_swap(__float_as_uint(m), __float_as_uint(m), false, false); return __uint_as_float(rr[0]) + __uint_as_float(rr[1]); }
#define ATT_WAIT_BAR() asm volatile("s_waitcnt vmcnt(0) lgkmcnt(0)\n\ts_barrier" ::: "memory")

__device__ __forceinline__ void attn_unit(Frame& F, int b, int h, int qb, const bf16* QM, const bf16* KVB, const bf16* KPE, bf16* CAT) {
    const int lane = F.lane, r32 = lane & 31, hi = lane >> 5, w = F.wave, g = w >> 2, wq = w & 3;
    const LAS char* L = (const LAS char*)F.lds;
    const unsigned lds0 = (unsigned)(uintptr_t)F.lds;
    const size_t tb = (size_t)b * SEQ;
    const int NT = 2 * qb + 2;
    const bf16* kp0 = KVB + (tb + lane) * NKV + h * 256 + w * 8;
    const bf16* kp2 = KPE + (tb + lane) * 64 + w * 8;
    const bf16* vp0 = KVB + (tb + 16 * (w & 3) + (lane >> 2)) * NKV + h * 256 + 128 + 32 * (w >> 2) + (lane & 3) * 8;
#define ATT_DMA(hh) do { const int _h = (hh); \
        if (_h + 1 < NT) { const unsigned kd = (unsigned)__builtin_amdgcn_readfirstlane(lds0 + KB_OFF + ((_h + 1) & 1) * KSLOT + w * 1024); const size_t to = (size_t)(_h + 1) * 64; \
            glds16(kp0 + to * NKV, kd); glds16(kp0 + to * NKV + 64, kd + 8192); glds16(kp2 + to * 64, kd + 16384); } \
        if (_h < NT) { const unsigned vd = (unsigned)__builtin_amdgcn_readfirstlane(lds0 + VB_OFF + (_h & 1) * VSLOT + w * 1024); const size_t to = (size_t)_h * 64; \
            glds16(vp0 + to * NKV, vd); glds16(vp0 + to * NKV + 64, vd + 8192); } } while (0)
    { const unsigned kd = (unsigned)__builtin_amdgcn_readfirstlane(lds0 + KB_OFF + w * 1024); glds16(kp0, kd); glds16(kp0 + 64, kd + 8192); glds16(kp2, kd + 16384); }
    bf16x8 qf[12];
    { const bf16* qrow = QM + (tb + (size_t)qb * 128 + wq * 32 + r32) * NQM;
#pragma unroll
      for (int kk = 0; kk < 8; ++kk) qf[kk] = *(const bf16x8*)(qrow + h * 128 + kk * 16 + hi * 8);
#pragma unroll
      for (int kk = 0; kk < 4; ++kk) qf[8 + kk] = *(const bf16x8*)(qrow + 512 + h * 64 + kk * 16 + hi * 8); }
    f32x16 o[4];
#pragma unroll
    for (int d0 = 0; d0 < 4; ++d0) o[d0] = f32x16{};
    f32x16 p0 = f32x16{}, p1 = f32x16{};
    float m_run = -1e30f, l_run = 0.f;
    LAS float* wsf = (LAS float*)(F.lds + WSF_OFF) + w * 64;
    const LAS char* kb = L + KB_OFF + g * KSLOT + hi * 1024 + r32 * 16;
    const LAS char* vb = L + VB_OFF + g * VSLOT + ((lane >> 4) & 1) * 32 + (lane & 3) * 8 + (4 * hi + ((lane & 15) >> 2)) * 64;
    ATT_WAIT_BAR();
    if (g == 1) { ATT_DMA(0); ATT_WAIT_BAR(); }
    for (int t = g; t < NT; t += 2) {
        const bool vis = (t < NT - 1) || (wq >= 2);
        ATT_DMA(t);
        if (vis) {
            p0 = f32x16{}; p1 = f32x16{};
            bf16x8 ka[4], kn[4];
            ka[0] = *(const LAS bf16x8*)(kb); ka[1] = *(const LAS bf16x8*)(kb + 512); ka[2] = *(const LAS bf16x8*)(kb + 2048); ka[3] = *(const LAS bf16x8*)(kb + 2048 + 512);
#pragma unroll
            for (int kg = 0; kg < 6; ++kg) {
                if (kg < 5) { kn[0] = *(const LAS bf16x8*)(kb + (2 * kg + 2) * 2048); kn[1] = *(const LAS bf16x8*)(kb + (2 * kg + 2) * 2048 + 512);
                              kn[2] = *(const LAS bf16x8*)(kb + (2 * kg + 3) * 2048); kn[3] = *(const LAS bf16x8*)(kb + (2 * kg + 3) * 2048 + 512); }
                p0 = __builtin_amdgcn_mfma_f32_32x32x16_bf16(ka[0], qf[2 * kg], p0, 0, 0, 0);
                p1 = __builtin_amdgcn_mfma_f32_32x32x16_bf16(ka[1], qf[2 * kg], p1, 0, 0, 0);
                p0 = __builtin_amdgcn_mfma_f32_32x32x16_bf16(ka[2], qf[2 * kg + 1], p0, 0, 0, 0);
                p1 = __builtin_amdgcn_mfma_f32_32x32x16_bf16(ka[3], qf[2 * kg + 1], p1, 0, 0, 0);
                __builtin_amdgcn_sched_barrier(0);
                if (kg < 5) { ka[0] = kn[0]; ka[1] = kn[1]; ka[2] = kn[2]; ka[3] = kn[3]; }
            }
        }
        ATT_WAIT_BAR();
        ATT_DMA(t + 1);
        if (vis) {
            float rm = fmaxf(p0[0], p1[0]);
#pragma unroll
            for (int r = 1; r < 16; ++r) rm = fmaxf(rm, fmaxf(p0[r], p1[r]));
            rm = swap_max(rm);
            const float mnew = fmaxf(m_run, rm);
            if (__any(mnew > m_run + THR)) {
                const float f = __builtin_amdgcn_exp2f(m_run - mnew); l_run *= f; m_run = mnew;
                if (hi == 0) wsf[r32] = f;
                asm volatile("s_waitcnt lgkmcnt(0)" ::: "memory");
#pragma unroll
                for (int r = 0; r < 16; ++r) { const float fr_ = wsf[crow(r, hi)];
#pragma unroll
                    for (int d0 = 0; d0 < 4; ++d0) o[d0][r] *= fr_; }
            }
            float ls = 0.f;
#pragma unroll
            for (int r = 0; r < 16; ++r) { p0[r] = __builtin_amdgcn_exp2f(p0[r] - m_run); p1[r] = __builtin_amdgcn_exp2f(p1[r] - m_run); ls += p0[r] + p1[r]; }
            l_run += ls;
            bf16x8 pw[4];
            { v4u t0 = {cvtpk(p0[0], p0[1]), cvtpk(p0[2], p0[3]), cvtpk(p0[4], p0[5]), cvtpk(p0[6], p0[7])};
              v4u t1 = {cvtpk(p0[8], p0[9]), cvtpk(p0[10], p0[11]), cvtpk(p0[12], p0[13]), cvtpk(p0[14], p0[15])};
              v4u t2 = {cvtpk(p1[0], p1[1]), cvtpk(p1[2], p1[3]), cvtpk(p1[4], p1[5]), cvtpk(p1[6], p1[7])};
              v4u t3 = {cvtpk(p1[8], p1[9]), cvtpk(p1[10], p1[11]), cvtpk(p1[12], p1[13]), cvtpk(p1[14], p1[15])};
              pw[0] = __builtin_bit_cast(bf16x8, t0); pw[1] = __builtin_bit_cast(bf16x8, t1); pw[2] = __builtin_bit_cast(bf16x8, t2); pw[3] = __builtin_bit_cast(bf16x8, t3); }
#pragma unroll
            for (int d0 = 0; d0 < 4; ++d0) {
                bf16x8 vf[4];
#pragma unroll
                for (int ks = 0; ks < 4; ++ks) { const s16x4 lo = vtr(vb + d0 * 4096 + ks * 1024), hh = vtr(vb + d0 * 4096 + ks * 1024 + 512);
                    vf[ks] = (bf16x8){lo[0], lo[1], lo[2], lo[3], hh[0], hh[1], hh[2], hh[3]}; }
#pragma unroll
                for (int ks = 0; ks < 4; ++ks) o[d0] = __builtin_amdgcn_mfma_f32_32x32x16_bf16(pw[ks], vf[ks], o[d0], 0, 0, 0);
                __builtin_amdgcn_sched_barrier(0);
            }
        }
        ATT_WAIT_BAR();
    }
    if (g == 0) { ATT_DMA(NT); ATT_WAIT_BAR(); }
    l_run = swap_sum(l_run);
    int lane_b = F.tid & 63; asm volatile("" : "+v"(lane_b));
    const int r32b = lane_b & 31, hib = lane_b >> 5;
    LAS float* MG = (LAS float*)(F.lds + MERGE_OFF) + wq * 4096;
    LAS float* ST = (LAS float*)(F.lds + ST_OFF) + wq * 64;
    if (g == 1) {
#pragma unroll
        for (int d0 = 0; d0 < 4; ++d0)
#pragma unroll
            for (int r = 0; r < 16; ++r) MG[(d0 * 16 + r) * 64 + lane_b] = o[d0][r];
        if (hib == 0) { ST[r32b] = m_run; ST[32 + r32b] = l_run; }
    }
    ATT_WAIT_BAR();
    if (g == 0) {
        const float m1 = ST[r32b], l1 = ST[32 + r32b];
        const float m = fmaxf(m_run, m1), f0 = __builtin_amdgcn_exp2f(m_run - m), f1 = __builtin_amdgcn_exp2f(m1 - m);
        const float il = 1.0f / (l_run * f0 + l1 * f1);
        if (hib == 0) { wsf[r32b] = f0 * il; wsf[32 + r32b] = f1 * il; }
        asm volatile("s_waitcnt lgkmcnt(0)" ::: "memory");
        LAS bf16* stg = (LAS bf16*)(F.lds + STAGE_OFF) + wq * 4096;
#pragma unroll
        for (int r = 0; r < 16; ++r) { const int row = crow(r, hib); const float a0 = wsf[row], a1 = wsf[32 + row];
#pragma unroll
            for (int d0 = 0; d0 < 4; ++d0) stg[row * 128 + d0 * 32 + r32b] = (bf16)f2bf(o[d0][r] * a0 + MG[(d0 * 16 + r) * 64 + lane_b] * a1);
            if ((r & 3) == 3) __builtin_amdgcn_sched_barrier(0); }
        asm volatile("s_waitcnt lgkmcnt(0)" ::: "memory");
        bf16* orow = CAT + (tb + (size_t)qb * 128 + wq * 32) * D + 512 + h * 128;
#pragma unroll
        for (int i = 0; i < 8; ++i) { const int id = i * 64 + lane_b, row = id >> 4, ch = id & 15; *(GAS v4u*)(orow + (size_t)row * D + ch * 8) = *(const LAS v4u*)(stg + row * 128 + ch * 8); }
    }
    ATT_WAIT_BAR();
#undef ATT_DMA
}
__device__ __forceinline__ void attn_phase(Frame& F, const bf16* QM, const bf16* KVB, const bf16* KPE, bf16* CAT) {
#pragma unroll 1
    for (int it = 2 * F.vcu; it < 512; it += 2 * F.G) {
#pragma unroll 1
        for (int u = 0; u < 2; ++u) { const int v = it >> 1, bh = v >> 5, s = v & 31;
            attn_unit(F, bh >> 2, bh & 3, u ? s : 63 - s, QM, KVB, KPE, CAT); } }
}
#undef ATT_WAIT_BAR
}

namespace ret {
using att::f32x16; using att::s16x4; using att::glds16; using att::crow; using att::vtr; using att::cvtpk;
#define RET_WAIT_BAR() asm volatile("s_waitcnt vmcnt(0) lgkmcnt(0)\n\ts_barrier" ::: "memory")
__device__ __forceinline__ bf16x8 scale8(const bf16x8 v, const float (&f)[8]) {
    float x[8];
#pragma unroll
    for (int j = 0; j < 8; ++j) x[j] = __uint_as_float((unsigned)(unsigned short)v[j] << 16) * f[j];
    v4u t = {cvtpk(x[0], x[1]), cvtpk(x[2], x[3]), cvtpk(x[4], x[5]), cvtpk(x[6], x[7])};
    return __builtin_bit_cast(bf16x8, t);
}
__device__ __forceinline__ bf16x8 trfrag_kappa(const LAS char* p) { const s16x4 lo = vtr(p), hh = vtr(p + 512); return (bf16x8){lo[0], lo[1], lo[2], lo[3], hh[0], hh[1], hh[2], hh[3]}; }
__device__ __forceinline__ bf16x8 trfrag_nat(const LAS char* p) { const s16x4 lo = vtr(p), hh = vtr(p + 256); return (bf16x8){lo[0], lo[1], lo[2], lo[3], hh[0], hh[1], hh[2], hh[3]}; }

__device__ __forceinline__ void kv_phase(Frame& F, const bf16* RK, const bf16* RV, bf16* KVS) {
    const int lane = F.lane, r32 = lane & 31, hi = lane >> 5, w = F.wave;
    const unsigned lds0 = (unsigned)(uintptr_t)F.lds;
    const LAS char* L = (const LAS char*)F.lds;
    const int trb = ((lane >> 4) & 1) * 32 + (lane & 3) * 8 + (4 * hi + ((lane & 15) >> 2)) * 64;
    const int db = w >> 1, eb0 = 2 * (w & 1);
#pragma unroll 1
    for (int blk = F.vcu; blk < BATCH * NCH * RH; blk += F.G) {
        const int h = blk % RH, n = (blk / RH) % NCH, b = blk / (RH * NCH);
        const size_t t0 = (size_t)b * SEQ + (size_t)n * CHUNK;
        { const size_t so = (t0 + 16 * (w & 3) + (lane >> 2)) * 512 + h * 128 + 32 * (w >> 2) + (lane & 3) * 8;
          const unsigned d0 = (unsigned)__builtin_amdgcn_readfirstlane(lds0 + w * 1024);
          glds16(RK + so, d0); glds16(RK + so + 64, d0 + 8192); glds16(RV + so, d0 + 16384); glds16(RV + so + 64, d0 + 16384 + 8192); }
        const float lg2 = ret_logg(h) * 1.4426950408889634f;
        RET_WAIT_BAR();
        f32x16 acc0 = f32x16{}, acc1 = f32x16{};
#pragma unroll
        for (int ks = 0; ks < 4; ++ks) {
            float f[8];
#pragma unroll
            for (int jj = 0; jj < 8; ++jj) f[jj] = __builtin_amdgcn_exp2f(lg2 * (float)(63 - (16 * ks + 4 * hi + (jj & 3) + 8 * (jj >> 2))));
            const bf16x8 af = scale8(trfrag_kappa(L + trb + (db * 4 + ks) * 1024), f);
            const bf16x8 b0 = trfrag_kappa(L + 16384 + trb + (eb0 * 4 + ks) * 1024), b1 = trfrag_kappa(L + 16384 + trb + ((eb0 + 1) * 4 + ks) * 1024);
            acc0 = __builtin_amdgcn_mfma_f32_32x32x16_bf16(af, b0, acc0, 0, 0, 0);
            acc1 = __builtin_amdgcn_mfma_f32_32x32x16_bf16(af, b1, acc1, 0, 0, 0);
        }
        bf16* o = KVS + (size_t)blk * 16384 + (size_t)(32 * db) * 128 + 32 * eb0 + r32;
#pragma unroll
        for (int r = 0; r < 16; ++r) { const int d = crow(r, hi); o[d * 128] = (bf16)f2bf(acc0[r]); o[d * 128 + 32] = (bf16)f2bf(acc1[r]); }
        RET_WAIT_BAR();
    }
}
__device__ __forceinline__ void scan_phase(Frame& F, bf16* KVS) {
    for (int gid = F.vcu * NTHR + F.tid; gid < BATCH * RH * 16384; gid += F.G * NTHR) {
        const int de = gid & 16383, h = (gid >> 14) % RH, b = gid >> 16;
        const float c = expf(ret_logg(h) * (float)CHUNK); float S = 0.f;
        bf16* p = KVS + ((size_t)(b * NCH * RH + h)) * 16384 + de;
#pragma unroll 1
        for (int n0 = 0; n0 < NCH; n0 += 16) {
            bf16 v[16];
#pragma unroll
            for (int i = 0; i < 16; ++i) v[i] = p[(size_t)(n0 + i) * RH * 16384];
#pragma unroll
            for (int i = 0; i < 16; ++i) { p[(size_t)(n0 + i) * RH * 16384] = (bf16)f2bf(S); S = c * S + bf2f(v[i]); }
        }
    }
}
__device__ __forceinline__ void out_phase(Frame& F, const bf16* RQ, const bf16* RK, const bf16* RV, const bf16* RG, const bf16* PREV, bf16* CAT) {
    const int lane = F.lane, r32 = lane & 31, hi = lane >> 5, w = F.wave, ih = w >> 2, eb = w & 3;
    const unsigned lds0 = (unsigned)(uintptr_t)F.lds;
    const LAS char* L = (const LAS char*)F.lds;
    const int trk = ((lane >> 4) & 1) * 32 + (lane & 3) * 8 + (4 * hi + ((lane & 15) >> 2)) * 64;
    const int trn = ((lane >> 4) & 1) * 32 + (lane & 3) * 8 + (8 * hi + ((lane & 15) >> 2)) * 64;
    LAS float* os = (LAS float*)(F.lds + 65536);
#pragma unroll 1
    for (int blk = F.vcu; blk < BATCH * NCH * RH; blk += F.G) {
        const int h = blk % RH, n = (blk / RH) % NCH, b = blk / (RH * NCH);
        const size_t t0 = (size_t)b * SEQ + (size_t)n * CHUNK;
        { const unsigned d0 = (unsigned)__builtin_amdgcn_readfirstlane(lds0 + w * 1024);
          const size_t ko = (t0 + lane) * 512 + h * 128 + w * 8;
          glds16(RK + ko, d0); glds16(RK + ko + 64, d0 + 8192);
          const size_t so = (t0 + 16 * (w & 3) + (lane >> 2)) * 512 + h * 128 + 32 * (w >> 2) + (lane & 3) * 8;
          glds16(RV + so, d0 + 16384); glds16(RV + so + 64, d0 + 16384 + 8192);
          const bf16* pp = PREV + (size_t)blk * 16384 + (size_t)(16 * w + (lane >> 2)) * 128 + (lane & 3) * 8;
          glds16(pp, d0 + 32768); glds16(pp + 32, d0 + 32768 + 8192); glds16(pp + 64, d0 + 32768 + 16384); glds16(pp + 96, d0 + 32768 + 24576); }
        bf16x8 qf[8];
        { const bf16* qrow = RQ + (t0 + 32 * ih + r32) * 512 + h * 128 + hi * 8;
#pragma unroll
          for (int kk = 0; kk < 8; ++kk) qf[kk] = *(const bf16x8*)(qrow + kk * 16); }
        const float lg2 = ret_logg(h) * 1.4426950408889634f;
        RET_WAIT_BAR();
        f32x16 p0 = f32x16{}, p1 = f32x16{};
        { const LAS char* kb = L + hi * 1024 + r32 * 16;
#pragma unroll
          for (int kk = 0; kk < 8; ++kk) { const bf16x8 a0 = *(const LAS bf16x8*)(kb + kk * 2048), a1 = *(const LAS bf16x8*)(kb + kk * 2048 + 512);
              p0 = __builtin_amdgcn_mfma_f32_32x32x16_bf16(a0, qf[kk], p0, 0, 0, 0); p1 = __builtin_amdgcn_mfma_f32_32x32x16_bf16(a1, qf[kk], p1, 0, 0, 0); } }
        f32x16 oc = f32x16{};
#pragma unroll
        for (int kd = 0; kd < 8; ++kd) oc = __builtin_amdgcn_mfma_f32_32x32x16_bf16(qf[kd], trfrag_nat(L + 32768 + trn + (eb * 8 + kd) * 1024), oc, 0, 0, 0);
        { const int i = 32 * ih + r32;
#pragma unroll
          for (int r = 0; r < 16; ++r) { const int j = crow(r, hi); const int d0 = i > j ? i - j : j - i, d1 = i > j + 32 ? i - j - 32 : j + 32 - i;
              p0[r] *= __builtin_amdgcn_exp2f(lg2 * (float)d0); p1[r] *= __builtin_amdgcn_exp2f(lg2 * (float)d1); } }
        bf16x8 pw[4];
        { v4u t0_ = {cvtpk(p0[0], p0[1]), cvtpk(p0[2], p0[3]), cvtpk(p0[4], p0[5]), cvtpk(p0[6], p0[7])};
          v4u t1_ = {cvtpk(p0[8], p0[9]), cvtpk(p0[10], p0[11]), cvtpk(p0[12], p0[13]), cvtpk(p0[14], p0[15])};
          v4u t2_ = {cvtpk(p1[0], p1[1]), cvtpk(p1[2], p1[3]), cvtpk(p1[4], p1[5]), cvtpk(p1[6], p1[7])};
          v4u t3_ = {cvtpk(p1[8], p1[9]), cvtpk(p1[10], p1[11]), cvtpk(p1[12], p1[13]), cvtpk(p1[14], p1[15])};
          pw[0] = __builtin_bit_cast(bf16x8, t0_); pw[1] = __builtin_bit_cast(bf16x8, t1_); pw[2] = __builtin_bit_cast(bf16x8, t2_); pw[3] = __builtin_bit_cast(bf16x8, t3_); }
        f32x16 oi = f32x16{};
#pragma unroll
        for (int ks = 0; ks < 4; ++ks) oi = __builtin_amdgcn_mfma_f32_32x32x16_bf16(pw[ks], trfrag_kappa(L + 16384 + trk + (eb * 4 + ks) * 1024), oi, 0, 0, 0);
#pragma unroll
        for (int r = 0; r < 16; ++r) { const int i = 32 * ih + crow(r, hi); os[i * 128 + 32 * eb + r32] = oi[r] + __builtin_amdgcn_exp2f(lg2 * (float)(i + 1)) * oc[r]; }
        RET_WAIT_BAR();
#pragma unroll 1
        for (int r = 0; r < 8; ++r) { const int i = w * 8 + r;
            const float a0 = os[i * 128 + lane], a1 = os[i * 128 + lane + 64];
            const float mu = wave_sum(a0 + a1) * (1.0f / 128.0f); const float d0 = a0 - mu, d1 = a1 - mu;
            const float rs = 1.0f / sqrtf(wave_sum(d0 * d0 + d1 * d1) * (1.0f / 128.0f) + 1e-5f);
            const float g0 = bf2f(RG[(t0 + i) * 512 + h * 128 + lane]), g1 = bf2f(RG[(t0 + i) * 512 + h * 128 + lane + 64]);
            bf16* orow = CAT + (t0 + i) * D + h * 128;
            orow[lane] = (bf16)f2bf(d0 * rs * g0 * pg8::fast_sigmoid(g0)); orow[lane + 64] = (bf16)f2bf(d1 * rs * g1 * pg8::fast_sigmoid(g1)); }
        RET_WAIT_BAR();
    }
}
#undef RET_WAIT_BAR
}
struct Args { PArgs in; float* out; unsigned char* ws; int ph_lo, ph_hi, li, pad; };
__global__ void __launch_bounds__(NTHR, 2) mk_fwd(Args args) {
    extern __shared__ __attribute__((aligned(16))) unsigned char lds[];
    Frame F;
    F.lds = (LAS unsigned char*)lds;
    F.MISC = (volatile LAS unsigned*)(F.lds + MISC_OFF);
    F.tid = threadIdx.x; F.lane = F.tid & 63; F.wave = __builtin_amdgcn_readfirstlane(F.tid >> 6);
    F.G = gridDim.x; { const int bx = blockIdx.x; F.vcu = (F.G % 8 == 0) ? (bx % 8) * (F.G / 8) + bx / 8 : bx; }
    unsigned char* ws = args.ws;
    F.ctl = (gu32*)(ws + WS_CTL);
    for (int u = F.tid; u < (LDS_BYTES - LDSCTL_OFF) / 4; u += NTHR) ((LAS unsigned*)(F.lds + LDSCTL_OFF))[u] = 0u;
    __syncthreads();
    XcdBarrier bar; bar.bar = (unsigned*)(F.ctl + CW_BAR); bar.x = 0; bar.st = nullptr;
    if (N_LAUNCHES != PER_PHASE) bar = xcd_barrier_post((unsigned*)(F.ctl + CW_BAR), F.MISC + 8);
#define GRID_BAR() do { if (N_LAUNCHES != PER_PHASE) xcd_barrier(bar); } while (0)
    const int lo = args.ph_lo, hi = args.ph_hi;
#define IN(k) (lo <= (k) && (k) < hi)
#define BOTH(k) (IN(k) && IN((k) + 1))
    bf16* XN = (bf16*)(ws + WS_XN); bf16* RQ = (bf16*)(ws + WS_RQ); bf16* RK = (bf16*)(ws + WS_RK); bf16* RV = (bf16*)(ws + WS_RV); bf16* RG = (bf16*)(ws + WS_RG);
    bf16* QM = (bf16*)(ws + WS_QM); bf16* CQ = (bf16*)(ws + WS_CQ); bf16* CKV = (bf16*)(ws + WS_CKV); bf16* KPE = (bf16*)(ws + WS_KPE); bf16* KVB = (bf16*)(ws + WS_KVB);
    bf16* CAT = (bf16*)(ws + WS_CAT); bf16* PB = (bf16*)(ws + WS_PB); bf16* ACT = (bf16*)(ws + WS_ACT); bf16* KVS = XN; bf16* X1B = XN; bf16* PROJ = KVB;
    float* SSQ = (float*)(ws + WS_SSQ); float* ssq_cq = SSQ; float* ssq_ckv = SSQ + T; float* ssq_x1 = SSQ + 2 * T; float* ssq_x2 = SSQ + 3 * T; float* ssq_x3 = SSQ + 4 * T;
    const float* RC = (const float*)(ws + WS_RC); const float* RS = (const float*)(ws + WS_RS); const float* MC = (const float*)(ws + WS_MC); const float* MS = (const float*)(ws + WS_MS);
    const int cid = (int)blockIdx.x;

    if (IN(0)) { p0_prologue(F, args.in, ws); if (BOTH(0)) GRID_BAR(); }
    if (IN(1)) {
        pg8::Gemm g{XN, (const bf16*)(ws + WS_WIN), T, NZ, D}; pg8::StaticOrder S; S.init(T, NZ, F.G, cid);
        pg8::EpiZ E{RQ, RK, RV, RG, CQ, CKV, KPE, RC, RS, MC, MS, ssq_cq, ssq_ckv};
        pg8::gemm_phase<pg8::EpiZ, pg8::StaticOrder, true, true>(F.lds + RING_OFF, g, S, E);
        if (BOTH(1)) GRID_BAR();
    }
    if (IN(2)) {
        { pg8::Gemm g{CQ, (const bf16*)(ws + WS_WUQ), T, NQM, 256}; pg8::StaticOrder S; S.init(T, NQM, F.G, cid);
          pg8::EpiQM E{QM, MC, MS, ssq_cq, QSCALE};
          pg8::gemm_phase<pg8::EpiQM, pg8::StaticOrder, true, true>(F.lds + RING_OFF, g, S, E); }
        { pg8::Gemm g{CKV, (const bf16*)(ws + WS_WUKV), T, NKV, 128}; pg8::StaticOrder S; S.init(T, NKV, F.G, cid);
          pg8::EpiScaleBf16 E{KVB, NKV, ssq_ckv, 1.0f / 128.0f};
          pg8::gemm_phase<pg8::EpiScaleBf16, pg8::StaticOrder, true, true>(F.lds + RING_OFF, g, S, E); }
        ret::kv_phase(F, RK, RV, KVS);
        if (BOTH(2)) GRID_BAR();
    }
    if (IN(3)) {
        ret::scan_phase(F, KVS);
        att::attn_phase(F, QM, KVB, KPE, CAT);
        if (BOTH(3)) GRID_BAR();
    }
    if (IN(4)) {
        ret::out_phase(F, RQ, RK, RV, RG, KVS, CAT);
        if (BOTH(4)) GRID_BAR();
    }
    if (IN(5)) {
        { pg8::Gemm g{CAT, (const bf16*)(ws + WS_WO), T, D, D}; pg8::StaticOrder S; S.init(T, D, F.G, cid);
          pg8::EpiRes E{args.in.x, args.out, X1B, ssq_x1};
          pg8::gemm_phase<pg8::EpiRes, pg8::StaticOrder, true, true>(F.lds + RING_OFF, g, S, E); }
        { pg8::Gemm g{PB, (const bf16*)(ws + WS_WPP), T, D, DPLE}; pg8::StaticOrder S; S.init(T, D, F.G, cid);
          pg8::EpiScaleBf16 E{PROJ, D, nullptr, 0.f};
          pg8::gemm_phase<pg8::EpiScaleBf16, pg8::StaticOrder, true, true>(F.lds + RING_OFF, g, S, E); }
        if (BOTH(5)) GRID_BAR();
    }
    if (IN(6)) {
        pg8::Gemm g{X1B, (const bf16*)(ws + WS_WGU), T, NGU, D}; pg8::StaticOrder S; S.init(T, NGU, F.G, cid);
        pg8::EpiGU E{ACT, DFF, ssq_x1};
        pg8::gemm_phase<pg8::EpiGU, pg8::StaticOrder, true, true>(F.lds + RING_OFF, g, S, E);
        if (BOTH(6)) GRID_BAR();
    }
    if (IN(7)) {
        pg8::Gemm g{ACT, (const bf16*)(ws + WS_WD), T, D, DFF}; pg8::StaticOrder S; S.init(T, D, F.G, cid);
        pg8::EpiRes E{args.out, args.out, X1B, ssq_x2};
        pg8::gemm_phase<pg8::EpiRes, pg8::StaticOrder, true, true>(F.lds + RING_OFF, g, S, E);
        if (BOTH(7)) GRID_BAR();
    }
    if (IN(8)) {
        pg8::Gemm g{X1B, (const bf16*)(ws + WS_WPG), T, D, D}; pg8::StaticOrder S; S.init(T, D, F.G, cid);
        pg8::EpiPle E{args.out, PROJ, ssq_x2, ssq_x3};
        pg8::gemm_phase<pg8::EpiPle, pg8::StaticOrder, true, true>(F.lds + RING_OFF, g, S, E);
        if (BOTH(8)) GRID_BAR();
    }
    if (IN(9)) final_norm(F, args.out, ssq_x3, args.in.fin_g);
#undef IN
#undef BOTH
}

extern "C" void kernel_launch(void* const* d_in, const int* in_sizes, int n_in, void* d_out, int out_size, void* d_ws, size_t ws_size, hipStream_t stream) {
    static int grid = 0;
    if (grid == 0) {
        if (n_in != 18 || out_size != T * D || ws_size < WS_END) { fprintf(stderr, "kernel_launch: unexpected shapes (n_in %d out %d ws %zu)\n", n_in, out_size, ws_size); grid = -1; return; }
        int dev = 0, cus = 0;
        if (hipGetDevice(&dev) != hipSuccess || hipDeviceGetAttribute(&cus, hipDeviceAttributeMultiprocessorCount, dev) != hipSuccess) { grid = -1; return; }
        if (hipFuncSetAttribute((const void*)mk_fwd, hipFuncAttributeMaxDynamicSharedMemorySize, LDS_BYTES) != hipSuccess) { fprintf(stderr, "kernel_launch: hipFuncSetAttribute failed\n"); grid = -1; return; }
        grid = cus;
    }
    if (grid < 0) return;
    if (hipMemsetAsync((char*)d_ws + WS_CTL, 0, CTL_ZERO_BYTES, stream) != hipSuccess) return;
    Args a{};
    const void** pp = (const void**)&a.in;
    for (int i = 0; i < 18; ++i) pp[i] = d_in[i];
    a.out = (float*)d_out; a.ws = (unsigned char*)d_ws;
    for (int li = 0; li < N_LAUNCHES; ++li) {
        a.ph_lo = (N_LAUNCHES == PER_PHASE) ? li : 0; a.ph_hi = (N_LAUNCHES == PER_PHASE) ? li + 1 : PER_PHASE; a.li = li;
        hipLaunchKernelGGL(mk_fwd, dim3(grid), dim3(NTHR), LDS_BYTES, stream, a);
    }
}
```

```cpp
#include <hip/hip_runtime.h>
#include <cstdio>
#include <cstdint>
#include <cmath>
#include <cstddef>
#define MK_N_LAUNCHES 1
namespace pg8 {
#define PG8_LAS __attribute__((address_space(3)))
typedef unsigned short bf16_t;
typedef short bf16x8 __attribute__((ext_vector_type(8)));
typedef float f32x4 __attribute__((ext_vector_type(4)));
typedef unsigned u32x4 __attribute__((ext_vector_type(4)));
constexpr int BM = 256, BK = 64, HALF = 128, HTB = HALF * BK * 2  , STAGE_BYTES = 8 * HTB, NXCD = 8, WGM = 8;

__host__ __device__ __forceinline__ int lds_byte(int r, int c) { const int st = (r >> 4) * 2 + (c >> 5), rr = r & 15, cc = c & 31, ob = rr * 64 + cc * 2; return st * 1024 + (ob ^ (((ob >> 9) & 1) << 5)); }
__host__ __device__ __forceinline__ void stage_rc(int b, int& R, int& C) { const int st = b / 1024, sb = b % 1024, swz = sb ^ (((sb >> 9) & 1) << 5); R = (st >> 1) * 16 + swz / 64; C = (st & 1) * 32 + (swz % 64) / 2; }
__host__ __device__ __forceinline__ int perm32(int rho) { const int n = rho >> 4, i = rho & 15; return 8 * (i >> 2) + 4 * n + (i & 3); }

struct Unit { int pm, pn; };
struct Gemm { const bf16_t* A; const bf16_t* Bt; int M, N, K; };

struct StaticOrder {
    int nM, nN, nwg, G, c;
    __host__ __device__ void init(int M, int N, int G_, int c_) { nM = M / BM; nN = N / BM; nwg = nM * nN; G = G_; c = c_; }
    __host__ __device__ bool next(int i, Unit& u) const {
        const long L = (long)i * G + c; if (L >= nwg) return false;
        int wgid = (int)L; { const int q = nwg / NXCD, r = nwg % NXCD, xcd = wgid % NXCD, off = wgid / NXCD; wgid = (xcd < r ? xcd * (q + 1) : r * (q + 1) + (xcd - r) * q) + off; }
        const int nig = WGM * nN, gid = wgid / nig, fm = gid * WGM, gsz = (nM - fm) < WGM ? (nM - fm) : WGM;
        u.pm = fm + ((wgid % nig) % gsz); u.pn = (wgid % nig) / gsz; return true;
    }
    __device__ __forceinline__ void a_ready(const Unit&) const {}
    __device__ __forceinline__ void done(const Unit&) const {}
};

__device__ __forceinline__ unsigned cvt_pk_bf16(float lo, float hi) { unsigned r; asm volatile("v_cvt_pk_bf16_f32 %0, %1, %2" : "=v"(r) : "v"(lo), "v"(hi)); return r; }
__device__ __forceinline__ u32x4 pack8(const f32x4 v0, const f32x4 v1) { u32x4 w; w.x = cvt_pk_bf16(v0[0], v0[1]); w.y = cvt_pk_bf16(v0[2], v0[3]); w.z = cvt_pk_bf16(v1[0], v1[1]); w.w = cvt_pk_bf16(v1[2], v1[3]); return w; }
__device__ __forceinline__ float sq8(const f32x4 a, const f32x4 b) { return (a[0] * a[0] + a[1] * a[1]) + (a[2] * a[2] + a[3] * a[3]) + (b[0] * b[0] + b[1] * b[1]) + (b[2] * b[2] + b[3] * b[3]); }
__device__ __forceinline__ float fast_sigmoid(float v) { return __builtin_amdgcn_rcpf(1.0f + __builtin_amdgcn_exp2f(-1.4426950408889634f * v)); }
__device__ __forceinline__ void rope8(f32x4& v0, f32x4& v1, const f32x4 c, const f32x4 s) {
    const float a0 = v0[0] * c[0] - v0[1] * s[0], b0 = v0[1] * c[0] + v0[0] * s[0];
    const float a1 = v0[2] * c[1] - v0[3] * s[1], b1 = v0[3] * c[1] + v0[2] * s[1];
    const float a2 = v1[0] * c[2] - v1[1] * s[2], b2 = v1[1] * c[2] + v1[0] * s[2];
    const float a3 = v1[2] * c[3] - v1[3] * s[3], b3 = v1[3] * c[3] + v1[2] * s[3];
    v0 = (f32x4){a0, b0, a1, b1}; v1 = (f32x4){a2, b2, a3, b3};
}
__device__ __forceinline__ void ssq_add(float* ssq, int row, float s, int fq) { s += __shfl_xor(s, 16); s += __shfl_xor(s, 32); if (fq == 0) atomicAdd(ssq + row, s); }

#define EPI_ROWS_BEGIN _Pragma("unroll") for (int ai = 0; ai < 2; ++ai) _Pragma("unroll") for (int m = 0; m < 4; ++m) { const int row = row0 + ai * HALF + m * 16;
#define EPI_ROWS_END }

struct EpiZ {
    static constexpr bool PERM = true, AFTER_DRAIN = false;
    bf16_t *RQ, *RK, *RV, *RG, *CQ, *CKV, *KPE; const float *RC, *RS, *MC, *MS; float *ssq_cq, *ssq_ckv;
    __device__ __forceinline__ void operator()(const f32x4 (&acc)[2][2][4][2], const Unit& u, int wr, int wc, int fr, int fq) const {
        const int pn = u.pn, row0 = u.pm * BM + wr * 64 + fr, cw = wc * 32 + 8 * fq;
        if (pn < 4) {
            bf16_t* dst = (pn < 2 ? RQ : RK) + (pn & 1) * 256 + cw; const int i0 = 16 * wc + 4 * fq;
            EPI_ROWS_BEGIN
                const f32x4 c = *(const f32x4*)(RC + (size_t)row * 64 + i0), s = *(const f32x4*)(RS + (size_t)row * 64 + i0);
#pragma unroll
                for (int bj = 0; bj < 2; ++bj) { f32x4 v0 = acc[ai][bj][m][0], v1 = acc[ai][bj][m][1]; rope8(v0, v1, c, s); *(u32x4*)(dst + (size_t)row * 512 + bj * HALF) = pack8(v0, v1); }
            EPI_ROWS_END
        } else if (pn < 8) {
            bf16_t* dst = (pn < 6 ? RV : RG) + (pn & 1) * 256 + cw;
            EPI_ROWS_BEGIN
#pragma unroll
                for (int bj = 0; bj < 2; ++bj) *(u32x4*)(dst + (size_t)row * 512 + bj * HALF) = pack8(acc[ai][bj][m][0], acc[ai][bj][m][1]);
            EPI_ROWS_END
        } else if (pn == 8) {
            EPI_ROWS_BEGIN
                float s = 0.f;
#pragma unroll
                for (int bj = 0; bj < 2; ++bj) { *(u32x4*)(CQ + (size_t)row * 256 + bj * HALF + cw) = pack8(acc[ai][bj][m][0], acc[ai][bj][m][1]); s += sq8(acc[ai][bj][m][0], acc[ai][bj][m][1]); }
                ssq_add(ssq_cq, row, s, fq);
            EPI_ROWS_END
        } else {
            const int i0 = 16 * wc + 4 * fq;
            EPI_ROWS_BEGIN
                *(u32x4*)(CKV + (size_t)row * 128 + cw) = pack8(acc[ai][0][m][0], acc[ai][0][m][1]);
                ssq_add(ssq_ckv, row, sq8(acc[ai][0][m][0], acc[ai][0][m][1]), fq);
                if (wc < 2) { const f32x4 c = *(const f32x4*)(MC + (size_t)row * 32 + i0), s = *(const f32x4*)(MS + (size_t)row * 32 + i0);
                    f32x4 v0 = acc[ai][1][m][0], v1 = acc[ai][1][m][1]; rope8(v0, v1, c, s); *(u32x4*)(KPE + (size_t)row * 64 + cw) = pack8(v0, v1); }
            EPI_ROWS_END
        }
    }
};
struct EpiQM {
    static constexpr bool PERM = true, AFTER_DRAIN = false;
    bf16_t* QM; const float *MC, *MS; const float* ssq; float qscale;
    __device__ __forceinline__ void operator()(const f32x4 (&acc)[2][2][4][2], const Unit& u, int wr, int wc, int fr, int fq) const {
        const int pn = u.pn, row0 = u.pm * BM + wr * 64 + fr, cw = wc * 32 + 8 * fq; const int i0 = 16 * (wc & 1) + 4 * fq;
        EPI_ROWS_BEGIN
            const float rs = qscale / sqrtf(ssq[row] * (1.0f / 256.0f) + 1e-6f);
            f32x4 c, s; if (pn == 2) { c = *(const f32x4*)(MC + (size_t)row * 32 + i0); s = *(const f32x4*)(MS + (size_t)row * 32 + i0); }
#pragma unroll
            for (int bj = 0; bj < 2; ++bj) { f32x4 v0 = acc[ai][bj][m][0] * rs, v1 = acc[ai][bj][m][1] * rs; if (pn == 2) rope8(v0, v1, c, s);
                *(u32x4*)(QM + (size_t)row * 768 + pn * 256 + bj * HALF + cw) = pack8(v0, v1); }
        EPI_ROWS_END
    }
};
struct EpiScaleBf16 {
    static constexpr bool PERM = true, AFTER_DRAIN = false;
    bf16_t* O; int ldc; const float* ssq; float inv_n;
    __device__ __forceinline__ void operator()(const f32x4 (&acc)[2][2][4][2], const Unit& u, int wr, int wc, int fr, int fq) const {
        const int row0 = u.pm * BM + wr * 64 + fr, col0 = u.pn * BM + wc * 32 + 8 * fq;
        EPI_ROWS_BEGIN
            const float rs = ssq ? 1.0f / sqrtf(ssq[row] * inv_n + 1e-6f) : 1.0f;
#pragma unroll
            for (int bj = 0; bj < 2; ++bj) *(u32x4*)(O + (size_t)row * ldc + col0 + bj * HALF) = pack8(acc[ai][bj][m][0] * rs, acc[ai][bj][m][1] * rs);
        EPI_ROWS_END
    }
};
struct EpiRes {
    static constexpr bool PERM = true, AFTER_DRAIN = false;
    const float* base; float* X; bf16_t* XB; float* ssq;
    __device__ __forceinline__ void operator()(const f32x4 (&acc)[2][2][4][2], const Unit& u, int wr, int wc, int fr, int fq) const {
        const int row0 = u.pm * BM + wr * 64 + fr, col0 = u.pn * BM + wc * 32 + 8 * fq;
        EPI_ROWS_BEGIN
            float s = 0.f;
#pragma unroll
            for (int bj = 0; bj < 2; ++bj) { const size_t off = (size_t)row * 1024 + col0 + bj * HALF;
                const f32x4 v0 = acc[ai][bj][m][0] + *(const f32x4*)(base + off), v1 = acc[ai][bj][m][1] + *(const f32x4*)(base + off + 4);
                *(f32x4*)(X + off) = v0; *(f32x4*)(X + off + 4) = v1; *(u32x4*)(XB + off) = pack8(v0, v1); s += sq8(v0, v1); }
            ssq_add(ssq, row, s, fq);
        EPI_ROWS_END
    }
};
struct EpiGU {
    static constexpr bool PERM = true, AFTER_DRAIN = false;
    bf16_t* ACT; int ldc; const float* ssq;
    __device__ __forceinline__ void operator()(const f32x4 (&acc)[2][2][4][2], const Unit& u, int wr, int wc, int fr, int fq) const {
        const int row0 = u.pm * BM + wr * 64 + fr, col0 = u.pn * HALF + wc * 32 + 8 * fq;
        EPI_ROWS_BEGIN
            const float rs = 1.0f / sqrtf(ssq[row] * (1.0f / 1024.0f) + 1e-6f);
            f32x4 o[2];
#pragma unroll
            for (int n = 0; n < 2; ++n) { const f32x4 g = acc[ai][0][m][n] * rs, up = acc[ai][1][m][n] * rs;
#pragma unroll
                for (int q = 0; q < 4; ++q) o[n][q] = g[q] * fast_sigmoid(g[q]) * up[q]; }
            *(u32x4*)(ACT + (size_t)row * ldc + col0) = pack8(o[0], o[1]);
        EPI_ROWS_END
    }
};
struct EpiPle {
    static constexpr bool PERM = true, AFTER_DRAIN = false;
    float* X; const bf16_t* PROJ; const float* ssq_in; float* ssq_out;
    __device__ __forceinline__ void operator()(const f32x4 (&acc)[2][2][4][2], const Unit& u, int wr, int wc, int fr, int fq) const {
        const int row0 = u.pm * BM + wr * 64 + fr, col0 = u.pn * BM + wc * 32 + 8 * fq;
        EPI_ROWS_BEGIN
            const float rs = 1.0f / sqrtf(ssq_in[row] * (1.0f / 1024.0f) + 1e-6f);
            float s = 0.f;
#pragma unroll
            for (int bj = 0; bj < 2; ++bj) { const size_t off = (size_t)row * 1024 + col0 + bj * HALF;
                const u32x4 pw = *(const u32x4*)(PROJ + off); const f32x4 x0 = *(const f32x4*)(X + off), x1 = *(const f32x4*)(X + off + 4);
                const f32x4 p0 = {__uint_as_float(pw.x << 16), __uint_as_float(pw.x & 0xffff0000u), __uint_as_float(pw.y << 16), __uint_as_float(pw.y & 0xffff0000u)};
                const f32x4 p1 = {__uint_as_float(pw.z << 16), __uint_as_float(pw.z & 0xffff0000u), __uint_as_float(pw.w << 16), __uint_as_float(pw.w & 0xffff0000u)};
                f32x4 v0, v1;
#pragma unroll
                for (int q = 0; q < 4; ++q) { v0[q] = x0[q] + fast_sigmoid(acc[ai][bj][m][0][q] * rs) * p0[q]; v1[q] = x1[q] + fast_sigmoid(acc[ai][bj][m][1][q] * rs) * p1[q]; }
                *(f32x4*)(X + off) = v0; *(f32x4*)(X + off + 4) = v1; s += sq8(v0, v1); }
            ssq_add(ssq_out, row, s, fq);
        EPI_ROWS_END
    }
};
template <class Epi, class Sched, bool ALIGN_EPI = false, bool SP2 = false>
__device__ __forceinline__ void gemm_phase(PG8_LAS unsigned char* lds, const Gemm g, const Sched& S, const Epi& E, const int tid, const int wid) {
    const int lane = tid & 63, wr = wid >> 2, wc = wid & 3, fr = lane & 15, fq = lane >> 4;
    int Kop = g.K; asm volatile("" : "+s"(Kop));
    const int K = Kop, nt = K / BK;
    unsigned voffA[2], voffB[2];
#pragma unroll
    for (int i = 0; i < 2; ++i) { int R, C; stage_rc(tid * 16 + i * 8192, R, C); const int Rb = Epi::PERM ? ((R & ~31) + perm32(R & 31)) : R;
        voffA[i] = (unsigned)(R * K + C) * 2u; voffB[i] = (unsigned)(Rb * K + C) * 2u; }
    const size_t kstep = (size_t)(BK * 2);
    const size_t hstep = (size_t)HALF * K * 2;
    const size_t tstep = 2 * hstep;
    const unsigned ldsw = (unsigned)wid * 1024u;
    const int aoff = lds_byte(wr * 64 + fr, fq * 8), boff = lds_byte(wc * 32 + fr, fq * 8);
#define PG8_SA(b, h) (((b) * 2 + (h)) * HTB)
#define PG8_SB(b, h) ((4 + (b) * 2 + (h)) * HTB)
#define PG8_STAGE(bufoff, gbase, voff) do { _Pragma("unroll") for (int _i = 0; _i < 2; ++_i) \
        __builtin_amdgcn_global_load_lds((const unsigned*)((const char*)(gbase) + (voff)[_i]), (PG8_LAS unsigned*)(lds + (bufoff) + ldsw + _i * 8192), 16, 0, 0); } while (0)
#define PG8_LDA(dst, b, h) do { _Pragma("unroll") for (int m = 0; m < 4; ++m) _Pragma("unroll") for (int k = 0; k < 2; ++k) dst[m][k] = *(const PG8_LAS bf16x8*)(lds + PG8_SA(b, h) + aoff + m * 2048 + k * 1024); } while (0)
#define PG8_LDB(dst, b, h) do { _Pragma("unroll") for (int n = 0; n < 2; ++n) _Pragma("unroll") for (int k = 0; k < 2; ++k) dst[n][k] = *(const PG8_LAS bf16x8*)(lds + PG8_SB(b, h) + boff + n * 2048 + k * 1024); } while (0)
#define PG8_MMA(ai, bj, At, Bt) do { __builtin_amdgcn_s_setprio(1); _Pragma("unroll") for (int m = 0; m < 4; ++m) _Pragma("unroll") for (int n = 0; n < 2; ++n) _Pragma("unroll") for (int k = 0; k < 2; ++k) \
        acc[ai][bj][m][n] = __builtin_amdgcn_mfma_f32_16x16x32_bf16(Bt[n][k], At[m][k], acc[ai][bj][m][n], 0, 0, 0); __builtin_amdgcn_s_setprio(0); } while (0)
#define PG8_WAIT_V(n) asm volatile("s_waitcnt vmcnt(" #n ")" ::: "memory")
#define PG8_WAIT_L(n) asm volatile("s_waitcnt lgkmcnt(" #n ")" ::: "memory")
#define PG8_BAR __builtin_amdgcn_s_barrier()
#define PG8_SCHED __builtin_amdgcn_sched_barrier(0)
    Unit cur, nxt; int ui = 0;
    if (!S.next(0, cur)) return;
    f32x4 acc[2][2][4][2];
#pragma unroll
    for (int a = 0; a < 2; ++a)
#pragma unroll
        for (int b = 0; b < 2; ++b)
#pragma unroll
            for (int m = 0; m < 4; ++m)
#pragma unroll
                for (int n = 0; n < 2; ++n) acc[a][b][m][n] = (f32x4){0.f, 0.f, 0.f, 0.f};
    bf16x8 At[4][2], B0[2][2], B1[2][2];
    const char* cA = (const char*)g.A + (size_t)cur.pm * tstep; const char* cB = (const char*)g.Bt + (size_t)cur.pn * tstep;
    S.a_ready(cur);
    if constexpr (SP2) {
        PG8_STAGE(PG8_SB(0, 0), cB, voffB); PG8_STAGE(PG8_SB(0, 1), cB + hstep, voffB); PG8_STAGE(PG8_SA(0, 0), cA, voffA); PG8_STAGE(PG8_SA(0, 1), cA + hstep, voffA);
        if (wr == 1) PG8_BAR;
        PG8_WAIT_V(2); PG8_BAR;
        PG8_STAGE(PG8_SB(1, 0), cB + kstep, voffB); PG8_STAGE(PG8_SA(1, 0), cA + kstep, voffA); PG8_STAGE(PG8_SB(1, 1), cB + hstep + kstep, voffB);
        PG8_WAIT_V(6); PG8_BAR;
    } else {
        PG8_STAGE(PG8_SB(0, 0), cB, voffB); PG8_STAGE(PG8_SA(0, 0), cA, voffA); PG8_STAGE(PG8_SB(0, 1), cB + hstep, voffB); PG8_STAGE(PG8_SA(0, 1), cA + hstep, voffA);
        if (wr == 1) PG8_BAR;
        PG8_WAIT_V(4); PG8_BAR;
        PG8_STAGE(PG8_SB(1, 0), cB + kstep, voffB); PG8_STAGE(PG8_SA(1, 0), cA + kstep, voffA); PG8_STAGE(PG8_SB(1, 1), cB + hstep + kstep, voffB);
        PG8_WAIT_V(6); PG8_BAR;
    }
    for (;;) {
        const bool has_next = S.next(ui + 1, nxt);
        const char* nA = has_next ? (const char*)g.A + (size_t)nxt.pm * tstep : cA; const char* nB = has_next ? (const char*)g.Bt + (size_t)nxt.pn * tstep : cB;
        for (int t = 0; t < nt; t += 2) {
            const bool last = (t == nt - 2);
            const char* a1 = cA + (size_t)(t + 1) * kstep;
            const char* a2 = last ? nA : cA + (size_t)(t + 2) * kstep; const char* b2 = last ? nB : cB + (size_t)(t + 2) * kstep;
            const char* a3 = a2 + kstep; const char* b3 = b2 + kstep;
            if (last && has_next) S.a_ready(nxt);
            if constexpr (SP2) {
            PG8_LDB(B0, 0, 0); PG8_LDB(B1, 0, 1); PG8_SCHED; PG8_LDA(At, 0, 0); PG8_STAGE(PG8_SA(1, 1), a1 + hstep, voffA);
            PG8_WAIT_V(8); PG8_WAIT_L(0); PG8_BAR; PG8_MMA(0, 0, At, B0); PG8_MMA(0, 1, At, B1); PG8_BAR; PG8_SCHED;
            PG8_LDA(At, 0, 1); PG8_STAGE(PG8_SB(0, 0), b2, voffB); PG8_STAGE(PG8_SB(0, 1), b2 + hstep, voffB); PG8_STAGE(PG8_SA(0, 0), a2, voffA);
            PG8_WAIT_V(8); PG8_WAIT_L(0); PG8_BAR; PG8_MMA(1, 0, At, B0); PG8_MMA(1, 1, At, B1); PG8_BAR; PG8_SCHED;
            PG8_LDB(B0, 1, 0); PG8_LDB(B1, 1, 1); PG8_SCHED; PG8_LDA(At, 1, 0); PG8_STAGE(PG8_SA(0, 1), a2 + hstep, voffA);
            PG8_WAIT_V(8); PG8_WAIT_L(0); PG8_BAR; PG8_MMA(0, 0, At, B0); PG8_MMA(0, 1, At, B1); PG8_BAR; PG8_SCHED;
            PG8_LDA(At, 1, 1); PG8_STAGE(PG8_SB(1, 0), b3, voffB); PG8_STAGE(PG8_SB(1, 1), b3 + hstep, voffB); PG8_STAGE(PG8_SA(1, 0), a3, voffA);
            PG8_WAIT_V(8); PG8_WAIT_L(0); PG8_BAR; PG8_MMA(1, 0, At, B0); PG8_MMA(1, 1, At, B1); PG8_BAR; PG8_SCHED;
            } else {
            PG8_LDB(B0, 0, 0); PG8_SCHED; PG8_LDA(At, 0, 0); PG8_STAGE(PG8_SA(1, 1), a1 + hstep, voffA);
            PG8_WAIT_L(8); PG8_BAR; PG8_WAIT_L(0); PG8_MMA(0, 0, At, B0); PG8_BAR; PG8_SCHED;
            PG8_LDB(B1, 0, 1); PG8_STAGE(PG8_SB(0, 0), b2, voffB);
            PG8_BAR; PG8_WAIT_L(0); PG8_MMA(0, 1, At, B1); PG8_BAR;
            PG8_LDA(At, 0, 1); PG8_STAGE(PG8_SA(0, 0), a2, voffA);
            PG8_BAR; PG8_WAIT_L(0); PG8_MMA(1, 0, At, B0); PG8_BAR; PG8_SCHED;
            PG8_STAGE(PG8_SB(0, 1), b2 + hstep, voffB);
            PG8_WAIT_V(6); PG8_BAR; PG8_MMA(1, 1, At, B1); PG8_BAR;
            PG8_LDB(B0, 1, 0); PG8_SCHED; PG8_LDA(At, 1, 0); PG8_STAGE(PG8_SA(0, 1), a2 + hstep, voffA);
            PG8_WAIT_L(8); PG8_BAR; PG8_WAIT_L(0); PG8_MMA(0, 0, At, B0); PG8_BAR; PG8_SCHED;
            PG8_LDB(B1, 1, 1); PG8_STAGE(PG8_SB(1, 0), b3, voffB);
            PG8_BAR; PG8_WAIT_L(0); PG8_MMA(0, 1, At, B1); PG8_BAR;
            PG8_LDA(At, 1, 1); PG8_STAGE(PG8_SA(1, 0), a3, voffA);
            PG8_BAR; PG8_WAIT_L(0); PG8_MMA(1, 0, At, B0); PG8_BAR; PG8_SCHED;
            PG8_STAGE(PG8_SB(1, 1), b3 + hstep, voffB);
            PG8_WAIT_V(6); PG8_BAR; PG8_MMA(1, 1, At, B1); PG8_BAR;
            }
        }
        if constexpr (ALIGN_EPI) { if (wr == 0) PG8_BAR; }
        if constexpr (!Epi::AFTER_DRAIN) { E(acc, cur, wr, wc, fr, fq); S.done(cur); }
        if (!has_next) break;
#pragma unroll
        for (int a = 0; a < 2; ++a)
#pragma unroll
            for (int b = 0; b < 2; ++b)
#pragma unroll
                for (int m = 0; m < 4; ++m)
#pragma unroll
                    for (int n = 0; n < 2; ++n) acc[a][b][m][n] = (f32x4){0.f, 0.f, 0.f, 0.f};
        cur = nxt; cA = nA; cB = nB; ++ui;
        if constexpr (ALIGN_EPI) { if (wr == 1) PG8_BAR; }
    }
    PG8_WAIT_V(0);
    if constexpr (!ALIGN_EPI) { if (wr == 0) PG8_BAR; }
    PG8_BAR;
    if constexpr (Epi::AFTER_DRAIN) { E.fused(acc, cur, wr, wc, fr, fq, lds, wid, lane); S.done(cur); }
#undef PG8_SA
#undef PG8_SB
#undef PG8_STAGE
#undef PG8_LDA
#undef PG8_LDB
#undef PG8_MMA
#undef PG8_WAIT_V
#undef PG8_WAIT_L
#undef PG8_BAR
#undef PG8_SCHED
}
}

constexpr int NWAVES = 8, NTHR = 512;
constexpr int BATCH = 2, SEQ = 8192, T = BATCH * SEQ, D = 1024, CHUNK = 64, NCH = SEQ / CHUNK;
constexpr int RH = 4, MH = 4, DFF = 2816, INC = 2496, NZ = 2560, NQM = 768, NKV = 1024, NGU = 2 * DFF, DPLE = 256;
constexpr float QSCALE = 0.07216878364870322f * 1.4426950408889634f;
#ifndef MK_N_LAUNCHES
#define MK_N_LAUNCHES 1
#endif
#ifndef MK_DUP
#define MK_DUP -1
#endif
constexpr int PER_PHASE = 10;
constexpr int N_LAUNCHES = MK_N_LAUNCHES;

constexpr size_t MiB = 1u << 20;
constexpr size_t WS_CTL = 0, CTL_ZERO_BYTES = 1 * MiB;
constexpr size_t WS_SSQ = 256 * 1024;
constexpr size_t WS_WIN = 1 * MiB, WS_WUQ = 6 * MiB, WS_WUKV = 6 * MiB + 512 * 1024, WS_WO = 7 * MiB, WS_WGU = 9 * MiB, WS_WD = 20 * MiB, WS_WPG = 26 * MiB, WS_WPP = 28 * MiB;
constexpr size_t WS_RC = 29 * MiB, WS_RS = 33 * MiB, WS_MC = 37 * MiB, WS_MS = 39 * MiB;
constexpr size_t WS_XN = 42 * MiB;
constexpr size_t WS_RQ = 74 * MiB, WS_RK = 90 * MiB, WS_RV = 106 * MiB, WS_RG = 122 * MiB, WS_QM = 138 * MiB;
constexpr size_t WS_ACT = 74 * MiB;
constexpr size_t WS_CQ = 162 * MiB, WS_CKV = 170 * MiB, WS_KPE = 174 * MiB;
constexpr size_t WS_KVB = 176 * MiB;
constexpr size_t WS_CAT = 208 * MiB;
constexpr size_t WS_PB = 240 * MiB;
constexpr size_t WS_END = 248 * MiB;
constexpr int CW_TMO = 0, CW_CODE = 1, CW_BAR = 4096;

constexpr int RING_OFF = 0, RING_BYTES = 131072;
constexpr int LDS_BYTES = 163840;
constexpr int LDSCTL_OFF = LDS_BYTES - 1024, MISC_OFF = LDSCTL_OFF + 320;
#define GAS __attribute__((address_space(1)))
#define LAS __attribute__((address_space(3)))
typedef unsigned short bf16;
typedef unsigned v4u __attribute__((ext_vector_type(4)));
typedef float f32x4 __attribute__((ext_vector_type(4)));
typedef short bf16x8 __attribute__((ext_vector_type(8)));
typedef GAS unsigned gu32;
typedef GAS unsigned long long gu64;
#define RLX_AGENT __ATOMIC_RELAXED, __HIP_MEMORY_SCOPE_AGENT
#define LDS_WAIT() asm volatile("s_waitcnt lgkmcnt(0)" ::: "memory")
#define VM_WAIT() asm volatile("s_waitcnt vmcnt(0)" ::: "memory")
__device__ __forceinline__ unsigned long long rt() { return __builtin_amdgcn_s_memrealtime(); }
__device__ __forceinline__ unsigned f2bf(float f) { unsigned u = __builtin_bit_cast(unsigned, f); return (u + 0x7fffu + ((u >> 16) & 1u)) >> 16; }
__device__ __forceinline__ unsigned pk2(float lo, float hi) { return f2bf(lo) | (f2bf(hi) << 16); }

#define XB_TMO      128
#define XB_XCNT(j)  (256  + 64 * (j))
#define XB_XSUB(j)  (1280 + 64 * (j))
#define XB_XGEN(j)  (2304 + 64 * (j))
#define XB_TOP      3328
#define XB_TOPGEN   3392
#define XCD_BAR_WORDS 3456
#define XB_SPIN_CAP (1u << 18)

__device__ __forceinline__ unsigned xb_ld(unsigned* p)              { return __hip_atomic_load(p, __ATOMIC_RELAXED, __HIP_MEMORY_SCOPE_AGENT); }
__device__ __forceinline__ unsigned xb_add(unsigned* p, unsigned v) { return __hip_atomic_fetch_add(p, v, __ATOMIC_RELAXED, __HIP_MEMORY_SCOPE_AGENT); }
__device__ __forceinline__ unsigned xb_xcc_id() { return (unsigned)__builtin_amdgcn_s_getreg((3 << 11) | 20) & 0xFu; }
#define XB_SPIN(cond, bar) do { unsigned _sp = 0; while (cond) { __builtin_amdgcn_s_sleep(1); \
    if ((++_sp & 255u) == 0u) { if (xb_ld(&(bar)[XB_TMO])) break; if (_sp > XB_SPIN_CAP) { atomicAdd(&(bar)[XB_TMO], 1u); break; } } } } while (0)

struct XcdBarrier {
    unsigned* bar; unsigned x;
    volatile LAS unsigned* st;
};

__device__ __forceinline__ XcdBarrier xcd_barrier_post(unsigned* bar, volatile LAS unsigned* st, int tid_) {
    XcdBarrier b; b.bar = bar; b.x = xb_xcc_id(); b.st = st;
    if (tid_ == 0) (void)xb_add(&bar[XB_XCNT(b.x)], 1u);
    return b;
}
__device__ __forceinline__ void xcd_barrier_complete(unsigned* bar, unsigned x, unsigned& nloc, unsigned& nx) {
    const unsigned G = gridDim.x * gridDim.y * gridDim.z;
    unsigned sum, cnt, mine, sp = 0u;
    for (;;) {
        sum = 0u; cnt = 0u; mine = 0u;
#pragma unroll
        for (unsigned j = 0; j < 16; ++j) { const unsigned c = xb_ld(&bar[XB_XCNT(j)]); sum += c; cnt += (c > 0u) ? 1u : 0u; mine = (j == x) ? c : mine; }
        if (sum == G) break;
        __builtin_amdgcn_s_sleep(1);
        if ((++sp & 255u) == 0u) { if (xb_ld(&bar[XB_TMO])) break; if (sp > XB_SPIN_CAP) { atomicAdd(&bar[XB_TMO], 1u); break; } }
    }
    nloc = mine > 0u ? mine : 1u; nx = cnt > 0u ? cnt : 1u;
}

__device__ __forceinline__ void xcd_barrier(const XcdBarrier& b, int tid_) {
    asm volatile("s_waitcnt vmcnt(0)" ::: "memory");
    __syncthreads();
    if (tid_ == 0) {
        unsigned* bar = b.bar;
        __builtin_amdgcn_s_waitcnt(0);
        unsigned nloc = b.st[0], nx = b.st[1];
        if (nloc == 0u) { xcd_barrier_complete(bar, b.x, nloc, nx); b.st[0] = nloc; b.st[1] = nx; }
        const unsigned old = xb_add(&bar[XB_XSUB(b.x)], 1u);
        const unsigned gen = old / nloc;
        if (old + 1u == (gen + 1u) * nloc) {
            __builtin_amdgcn_fence(__ATOMIC_RELEASE, "agent");
            asm volatile("s_waitcnt vmcnt(0)" ::: "memory");
            const unsigned og = xb_add(&bar[XB_TOP], 1u);
            const unsigned tg = og / nx;
            if (og + 1u == (tg + 1u) * nx) xb_add(&bar[XB_TOPGEN], 1u);
            else XB_SPIN(xb_ld(&bar[XB_TOPGEN]) == tg, bar);
            __builtin_amdgcn_fence(__ATOMIC_ACQUIRE, "agent");
            xb_add(&bar[XB_XGEN(b.x)], 1u);
            asm volatile("s_waitcnt vmcnt(0)" ::: "memory");
        } else {
            XB_SPIN(xb_ld(&bar[XB_XGEN(b.x)]) == gen, bar);
            __builtin_amdgcn_fence(__ATOMIC_ACQUIRE, "agent");
            asm volatile("s_waitcnt vmcnt(0)" ::: "memory");
        }
    }
    __syncthreads();
}

struct Frame {
    LAS unsigned char* lds;
    volatile LAS unsigned* MISC;
    gu32* ctl;
    int tid, lane, wave, vcu, G;
};
__device__ __forceinline__ float bf2f(bf16 v) { return __uint_as_float((unsigned)v << 16); }
__device__ __forceinline__ float wave_sum(float v) {
#pragma unroll
    for (int o = 1; o < 64; o <<= 1) v += __shfl_xor(v, o);
    return v;
}
__device__ __forceinline__ float ret_logg(int h) { return log1pf(-exp2f(-5.0f - (float)h)); }

struct PArgs { const float *x, *p; const int* pos; const float *mix_g, *w_in, *qn_g, *w_uq, *kvn_g, *w_ukv, *w_o, *ffn_g, *w_g, *w_u, *w_d, *ple_g, *w_pg, *w_pp, *fin_g; };
struct Args { PArgs in; float* out; unsigned char* ws; int ph_lo, ph_hi, li, pad; };
__device__ __forceinline__ unsigned char* fresh_ws() { return *(unsigned char* const volatile __attribute__((address_space(4)))*)((const __attribute__((address_space(4))) char*)__builtin_amdgcn_kernarg_segment_ptr() + offsetof(Args, ws)); }
__device__ __forceinline__ const float* p0_src(const PArgs& a, int kind, int n, float& cs) {
    cs = 1.0f;
    switch (kind) {
    case 0: {
        if (n < 1024) { const int g = n & 127; if (n >= 512) cs = 0.08838834764831845f; return a.w_in + (n & ~127) + (g >> 1) + 64 * (g & 1); }
        if (n < 2432) return a.w_in + n;
        if (n < 2496) { const int g = n - 2432; return a.w_in + 2432 + (g >> 1) + 32 * (g & 1); }
        return nullptr; }
    case 1: {
        if (n < 512) return a.w_uq + (n >> 7) * 192 + (n & 127);
        const int r = n - 512, g = r & 63; return a.w_uq + (r >> 6) * 192 + 128 + (g >> 1) + 32 * (g & 1); }
    case 2: return a.w_ukv + n;
    case 3: return a.w_o + n;
    case 4: { const int t = n >> 8, r = n & 255; return (r < 128 ? a.w_g : a.w_u) + 128 * t + (r & 127); }
    case 5: return a.w_d + n;
    case 6: return a.w_pg + n;
    default: return a.w_pp + n;
    }
}
__device__ __forceinline__ void p0_item(const PArgs& a, int kind, int ldw, int K, const float* gk, bf16* WT, LAS float* scr, int item, int nblk, int lane) {
    const int kb = item / nblk, nb = item % nblk, k0 = 64 * kb, n0 = 32 * nb;
    float cs; const float* src = p0_src(a, kind, n0 + (lane & 31), cs);
#pragma unroll 8
    for (int i = 0; i < 32; ++i) { const int kk = 2 * i + (lane >> 5); float v = 0.f;
        if (src) { v = src[(size_t)(k0 + kk) * ldw] * cs; if (gk) v *= gk[k0 + kk]; }
        scr[kk * 33 + (lane & 31)] = v; }
    LDS_WAIT(); asm volatile("" ::: "memory");
    const int c = lane & 7;
#pragma unroll
    for (int j = 0; j < 4; ++j) { const int n = (lane >> 3) + 8 * j; const LAS float* s = scr + (8 * c) * 33 + n;
        v4u o; o.x = pk2(s[0 * 33], s[1 * 33]); o.y = pk2(s[2 * 33], s[3 * 33]); o.z = pk2(s[4 * 33], s[5 * 33]); o.w = pk2(s[6 * 33], s[7 * 33]);
        *(GAS v4u*)(WT + (size_t)(n0 + n) * K + k0 + 8 * c) = o; }
    LDS_WAIT(); asm volatile("" ::: "memory");
}
__device__ __forceinline__ void p0_prologue(Frame& F, const PArgs& a, unsigned char* ws) {
    LAS float* scr = (LAS float*)(F.lds + RING_OFF + F.wave * 16384);
    const int gw = F.vcu * NWAVES + F.wave, NGW = F.G * NWAVES;
    constexpr int NMAT = 8;
    const int Ks[NMAT] = {1024, 256, 128, 1024, 1024, 2816, 1024, 256}, Ns[NMAT] = {NZ, NQM, NKV, 1024, NGU, 1024, 1024, 1024}, LDW[NMAT] = {INC, NQM, NKV, 1024, DFF, 1024, 1024, 1024};
    const size_t OFF[NMAT] = {WS_WIN, WS_WUQ, WS_WUKV, WS_WO, WS_WGU, WS_WD, WS_WPG, WS_WPP};
    int base = 0;
#pragma unroll
    for (int k = 0; k < NMAT; ++k) {
        const int nblk = Ns[k] / 32, nit = (Ks[k] / 64) * nblk;
        const float* gk = k == 1 ? a.qn_g : k == 2 ? a.kvn_g : k == 4 ? a.ffn_g : k == 6 ? a.ple_g : nullptr;
        int first = gw - (base % NGW); if (first < 0) first += NGW;
        for (int it = first; it < nit; it += NGW) p0_item(a, k, LDW[k], Ks[k], gk, (bf16*)(ws + OFF[k]), scr, it, nblk, F.lane);
        base += nit;
    }
    bf16* XN = (bf16*)(ws + WS_XN);
    for (int m = gw; m < T; m += NGW) {
        const GAS f32x4* xr = (const GAS f32x4*)(a.x + (size_t)m * D) + F.lane; const GAS f32x4* gr = (const GAS f32x4*)a.mix_g + F.lane;
        f32x4 v[4]; float s = 0.f;
#pragma unroll
        for (int j = 0; j < 4; ++j) { v[j] = xr[64 * j]; s += (v[j].x * v[j].x + v[j].y * v[j].y) + (v[j].z * v[j].z + v[j].w * v[j].w); }
        const float rs = 1.0f / sqrtf(wave_sum(s) * (1.0f / D) + 1e-6f);
        GAS unsigned long long* o8 = (GAS unsigned long long*)(XN + (size_t)m * D) + F.lane;
#pragma unroll
        for (int j = 0; j < 4; ++j) { const f32x4 g = gr[64 * j]; o8[64 * j] = (unsigned long long)pk2(v[j].x * rs * g.x, v[j].y * rs * g.y) | ((unsigned long long)pk2(v[j].z * rs * g.z, v[j].w * rs * g.w) << 32); }
    }
    { const int gt = F.vcu * NTHR + F.tid, NGT = F.G * NTHR; bf16* PB = (bf16*)(ws + WS_PB);
      for (int i = gt; i < T * DPLE / 4; i += NGT) { const f32x4 v = ((const GAS f32x4*)a.p)[i]; ((GAS unsigned long long*)PB)[i] = (unsigned long long)pk2(v.x, v.y) | ((unsigned long long)pk2(v.z, v.w) << 32); } }
    { const int gt = F.vcu * NTHR + F.tid, NGT = F.G * NTHR; float* RC = (float*)(ws + WS_RC); float* RS = (float*)(ws + WS_RS); float* MC = (float*)(ws + WS_MC); float* MS = (float*)(ws + WS_MS);
      for (int i = gt; i < T * 64; i += NGT) { const int t = i >> 6, k = i & 63; const float ang = (float)a.pos[t] * expf(-logf(10000.0f) * (float)k / 64.0f); RC[i] = cosf(ang); RS[i] = sinf(ang); }
      for (int i = gt; i < T * 32; i += NGT) { const int t = i >> 5, k = i & 31; const float ang = (float)a.pos[t] * expf(-logf(10000.0f) * (float)k / 32.0f); MC[i] = cosf(ang); MS[i] = sinf(ang); } }
}

__device__ __forceinline__ void ret_kv_simple(Frame& F, const bf16* RK, const bf16* RV, bf16* KVS) {
    LAS float* ks = (LAS float*)F.lds; LAS float* vs = ks + 64 * 128;
    for (int blk = F.vcu; blk < BATCH * NCH * RH; blk += F.G) {
        const int h = blk % RH, n = (blk / RH) % NCH, b = blk / (RH * NCH);
        const float lg = ret_logg(h); const size_t t0 = (size_t)b * SEQ + (size_t)n * CHUNK;
        for (int idx = F.tid; idx < 64 * 128; idx += NTHR) { const int j = idx >> 7, d = idx & 127;
            ks[idx] = bf2f(RK[(t0 + j) * 512 + h * 128 + d]) * expf(lg * (float)(CHUNK - 1 - j)); vs[idx] = bf2f(RV[(t0 + j) * 512 + h * 128 + d]); }
        __syncthreads();
        const int d = F.tid >> 2, e0 = (F.tid & 3) * 32;
        float acc[32];
#pragma unroll
        for (int e = 0; e < 32; ++e) acc[e] = 0.f;
        for (int j = 0; j < 64; ++j) { const float kd = ks[j * 128 + d];
#pragma unroll
            for (int e = 0; e < 32; ++e) acc[e] += kd * vs[j * 128 + e0 + e]; }
        GAS unsigned* o = (GAS unsigned*)(KVS + (size_t)blk * 16384 + d * 128 + e0);
#pragma unroll
        for (int e = 0; e < 16; ++e) o[e] = pk2(acc[2 * e], acc[2 * e + 1]);
        __syncthreads();
    }
}
__device__ __forceinline__ void ret_scan_simple(Frame& F, bf16* KVS) {
    for (int gid = F.vcu * NTHR + F.tid; gid < BATCH * RH * 16384; gid += F.G * NTHR) {
        const int de = gid & 16383, h = (gid >> 14) % RH, b = gid >> 16;
        const float c = expf(ret_logg(h) * (float)CHUNK); float S = 0.f;
        for (int n = 0; n < NCH; ++n) { bf16* p = KVS + ((size_t)((b * NCH + n) * RH + h)) * 16384 + de; const float kv = bf2f(*p); *p = (bf16)f2bf(S); S = c * S + kv; }
    }
}
__device__ __forceinline__ void ret_out_simple(Frame& F, const bf16* RQ, const bf16* RK, const bf16* RV, const bf16* RG, const bf16* PREV, bf16* CAT) {
    LAS float* qs = (LAS float*)F.lds; LAS float* ks = qs + 64 * 129; LAS float* vs = ks + 64 * 129; LAS float* ss = vs + 64 * 128;
    for (int blk = F.vcu; blk < BATCH * NCH * RH; blk += F.G) {
        const int h = blk % RH, n = (blk / RH) % NCH, b = blk / (RH * NCH);
        const float lg = ret_logg(h); const size_t t0 = (size_t)b * SEQ + (size_t)n * CHUNK;
        for (int idx = F.tid; idx < 64 * 128; idx += NTHR) { const int j = idx >> 7, d = idx & 127; const size_t g = (t0 + j) * 512 + h * 128 + d;
            qs[j * 129 + d] = bf2f(RQ[g]); ks[j * 129 + d] = bf2f(RK[g]); vs[j * 128 + d] = bf2f(RV[g]); }
        __syncthreads();
        { const int i = F.tid >> 3, jq = F.tid & 7;
          for (int jj = 0; jj < 8; ++jj) { const int j = jq * 8 + jj; float dot = 0.f;
              for (int d = 0; d < 128; ++d) dot += qs[i * 129 + d] * ks[j * 129 + d];
              const int dij = i > j ? i - j : j - i; ss[i * 65 + j] = dot * expf(lg * (float)dij); } }
        __syncthreads();
        const int e = F.tid & 127, ih = F.tid >> 7;
        float acc[16], acc2[16];
#pragma unroll
        for (int ii = 0; ii < 16; ++ii) { acc[ii] = 0.f; acc2[ii] = 0.f; }
        for (int j = 0; j < 64; ++j) { const float vv = vs[j * 128 + e];
#pragma unroll
            for (int ii = 0; ii < 16; ++ii) acc[ii] += ss[(ih * 16 + ii) * 65 + j] * vv; }
        const bf16* pv = PREV + (size_t)blk * 16384;
        for (int d = 0; d < 128; ++d) { const float p = bf2f(pv[d * 128 + e]);
#pragma unroll
            for (int ii = 0; ii < 16; ++ii) acc2[ii] += qs[(ih * 16 + ii) * 129 + d] * p; }
        __syncthreads();
        LAS float* os = qs;
#pragma unroll
        for (int ii = 0; ii < 16; ++ii) { const int i = ih * 16 + ii; os[i * 128 + e] = acc[ii] + expf(lg * (float)(i + 1)) * acc2[ii]; }
        __syncthreads();
        for (int r = 0; r < 8; ++r) { const int i = F.wave * 8 + r;
            const float a0 = os[i * 128 + F.lane], a1 = os[i * 128 + F.lane + 64];
            const float mu = wave_sum(a0 + a1) * (1.0f / 128.0f); const float d0 = a0 - mu, d1 = a1 - mu;
            const float rs = 1.0f / sqrtf(wave_sum(d0 * d0 + d1 * d1) * (1.0f / 128.0f) + 1e-5f);
            const float g0 = bf2f(RG[(t0 + i) * 512 + h * 128 + F.lane]), g1 = bf2f(RG[(t0 + i) * 512 + h * 128 + F.lane + 64]);
            bf16* orow = CAT + (t0 + i) * D + h * 128;
            orow[F.lane] = (bf16)f2bf(d0 * rs * (g0 / (1.0f + expf(-g0)))); orow[F.lane + 64] = (bf16)f2bf(d1 * rs * (g1 / (1.0f + expf(-g1)))); }
        __syncthreads();
    }
}
__device__ __forceinline__ void attn_simple(Frame& F, const bf16* QM, const bf16* KVB, const bf16* KPE, bf16* CAT) {
    LAS float* Qs = (LAS float*)F.lds; LAS float* Ks = Qs + 64 * 193; LAS float* Vs = Ks + 64 * 193; LAS float* Ss = Vs + 64 * 128;
    for (int i = 0;; ++i) {
        const int L = i * F.G + F.vcu; if (L >= BATCH * MH * NCH) break;
        const int bh = L & 7, x = (L >> 3) & 31, rnd = L >> 8; const int c = (rnd & 1) ? (rnd * 32 + x) : (rnd * 32 + 31 - x);
        const int h = bh & 3, b = bh >> 2;
        const size_t tq0 = (size_t)b * SEQ + (size_t)c * CHUNK;
        __syncthreads();
        for (int idx = F.tid; idx < 64 * 192; idx += NTHR) { const int r = idx / 192, d = idx % 192;
            Qs[r * 193 + d] = bf2f(d < 128 ? QM[(tq0 + r) * NQM + h * 128 + d] : QM[(tq0 + r) * NQM + 512 + h * 64 + (d - 128)]); }
        const int qi = F.tid >> 3, part = F.tid & 7;
        float m = -INFINITY, l = 0.f; float acc[16];
#pragma unroll
        for (int e = 0; e < 16; ++e) acc[e] = 0.f;
        for (int kt = 0; kt <= c; ++kt) {
            __syncthreads();
            const size_t tk0 = (size_t)b * SEQ + (size_t)kt * CHUNK;
            for (int idx = F.tid; idx < 64 * 192; idx += NTHR) { const int j = idx / 192, d = idx % 192;
                Ks[j * 193 + d] = bf2f(d < 128 ? KVB[(tk0 + j) * NKV + h * 256 + d] : KPE[(tk0 + j) * 64 + (d - 128)]); }
            for (int idx = F.tid; idx < 64 * 128; idx += NTHR) { const int j = idx >> 7, e = idx & 127; Vs[idx] = bf2f(KVB[(tk0 + j) * NKV + h * 256 + 128 + e]); }
            __syncthreads();
            for (int jj = 0; jj < 8; ++jj) { const int j = part * 8 + jj; float dot = 0.f;
                for (int d = 0; d < 192; ++d) dot += Qs[qi * 193 + d] * Ks[j * 193 + d];
                Ss[qi * 65 + j] = dot; }
            __syncthreads();
            float mx = m;
            for (int j = 0; j < 64; ++j) mx = fmaxf(mx, Ss[qi * 65 + j]);
            const float alpha = exp2f(m - mx); l *= alpha;
#pragma unroll
            for (int e = 0; e < 16; ++e) acc[e] *= alpha;
            for (int j = 0; j < 64; ++j) { const float p = exp2f(Ss[qi * 65 + j] - mx); l += p; const LAS float* vr = Vs + j * 128 + part * 16;
#pragma unroll
                for (int e = 0; e < 16; ++e) acc[e] += p * vr[e]; }
            m = mx;
        }
        const float il = 1.0f / l;
        GAS unsigned* o = (GAS unsigned*)(CAT + (tq0 + qi) * D + 512 + h * 128 + part * 16);
#pragma unroll
        for (int e = 0; e < 8; ++e) o[e] = pk2(acc[2 * e] * il, acc[2 * e + 1] * il);
    }
    __syncthreads();
}
__device__ __forceinline__ void final_norm(Frame& F, float* X, const float* ssq, const float* g) {
    const int gw = F.vcu * NWAVES + F.wave, NGW = F.G * NWAVES;
    for (int m = gw; m < T; m += NGW) {
        const float rs = 1.0f / sqrtf(ssq[m] * (1.0f / D) + 1e-6f);
        GAS f32x4* xr = (GAS f32x4*)(X + (size_t)m * D) + F.lane; const GAS f32x4* gr = (const GAS f32x4*)g + F.lane;
#pragma unroll
        for (int j = 0; j < 4; ++j) { const f32x4 v = xr[64 * j], gg = gr[64 * j]; xr[64 * j] = (f32x4){v.x * rs * gg.x, v.y * rs * gg.y, v.z * rs * gg.z, v.w * rs * gg.w}; }
    }
}


namespace att {
typedef float f32x16 __attribute__((ext_vector_type(16)));
typedef short s16x4 __attribute__((ext_vector_type(4)));
typedef short v4i16_t __attribute__((ext_vector_type(4)));
constexpr int KB_OFF = 0, KSLOT = 24576, VB_OFF = 73728, VSLOT = 16384, QB_OFF = 122880, QSLOT = 8192, MERGE_OFF = 0, STAGE_OFF = 65536, WSF_OFF = 155648, ST_OFF = 157696;
constexpr float THR = 8.0f;
__device__ __forceinline__ void glds16(const void* gsrc, unsigned lds_dst) { unsigned keep;
    asm volatile("s_mov_b32 %0, m0\n\ts_mov_b32 m0, %2\n\ts_nop 0\n\tglobal_load_lds_dwordx4 %1, off\n\ts_mov_b32 m0, %0" : "=&s"(keep) : "v"(gsrc), "s"(lds_dst) : "memory"); }
template <int IMM> __device__ __forceinline__ void glds16s(unsigned voff, const void* sbase, unsigned lds_dst) { unsigned keep;
    asm volatile("s_mov_b32 %0, m0\n\ts_mov_b32 m0, %3\n\ts_nop 0\n\tglobal_load_lds_dwordx4 %1, %2 offset:%c4\n\ts_mov_b32 m0, %0" : "=&s"(keep) : "v"(voff), "s"(sbase), "s"(lds_dst), "i"(IMM) : "memory"); }
__device__ __forceinline__ int crow(int r, int hi) { return (r & 3) + 8 * (r >> 2) + 4 * hi; }
__device__ __forceinline__ s16x4 vtr(const LAS char* p) { return __builtin_bit_cast(s16x4, __builtin_amdgcn_ds_read_tr16_b64_v4i16((LAS v4i16_t*)p)); }
__device__ __forceinline__ unsigned cvtpk(float lo, float hi) { unsigned r; asm volatile("v_cvt_pk_bf16_f32 %0, %1, %2" : "=v"(r) : "v"(lo), "v"(hi)); return r; }
__device__ __forceinline__ float swap_max(float m) { auto rr = __builtin_amdgcn_permlane32_swap(__float_as_uint(m), __float_as_uint(m), false, false); return fmaxf(__uint_as_float(rr[0]), __uint_as_float(rr[1])); }
__device__ __forceinline__ float swap_sum(float m) { auto rr = __builtin_amdgcn_permlane32_swap(__float_as_uint(m), __float_as_uint(m), false, false); return __uint_as_float(rr[0]) + __uint_as_float(rr[1]); }
#define ATT_WAIT_BAR() asm volatile("s_waitcnt vmcnt(0) lgkmcnt(0)\n\ts_barrier" ::: "memory")

__device__ __forceinline__ void attn_unit(Frame& F, int b, int h, int qb_, const bf16* QM, const bf16* KVB, const bf16* KPE, bf16* CAT) {
    int lane; asm volatile("v_mbcnt_lo_u32_b32 %0, -1, 0\n\tv_mbcnt_hi_u32_b32 %0, -1, %0" : "=v"(lane));
    const int r32 = lane & 31, hi = lane >> 5, w = F.wave, g = w >> 2, wq = w & 3;
    const LAS char* L = (const LAS char*)F.lds;
    const unsigned lds0 = (unsigned)(uintptr_t)F.lds;
    const size_t tb = (size_t)b * SEQ;
    const int NT = 2 * qb_ + 2;
    const bf16* kbase0 = KVB + tb * NKV + h * 256;
    const bf16* rbase0 = KPE + tb * 64;
    const int krow = 8 * w + (lane >> 3);
    const unsigned voffK = (unsigned)(krow * NKV + (((lane & 7) ^ (lane >> 4) ^ (4 * (w & 1))) * 8)) * 2u;
    const unsigned voffR = (unsigned)(krow * 64 + (((lane & 7) ^ (lane >> 4) ^ (4 * (w & 1))) * 8)) * 2u;
    const unsigned voffV = (unsigned)(krow * NKV + 128 + (((lane & 7) ^ (4 * ((lane >> 4) & 1))) * 8)) * 2u;
#define ATT_KBASE(tt, slot) const unsigned kd = (unsigned)__builtin_amdgcn_readfirstlane(lds0 + KB_OFF + (slot) * KSLOT + w * 1024); const bf16* kbs = kbase0 + (size_t)(tt) * 64 * NKV
#define ATT_K(tt, slot) do { ATT_KBASE(tt, slot); glds16s<0>(voffK, kbs, kd); glds16s<0>(voffK, kbs + 64, kd + 8192); glds16s<0>(voffR, rbase0 + (size_t)(tt) * 64 * 64, kd + 16384); } while (0)
#define ATT_KP(i, hh) do { const int _t = (hh) + 2; if (_t < NT) { ATT_KBASE(_t, (unsigned)_t % 3u); \
        if ((i) == 0) glds16s<0>(voffK, kbs, kd); else if ((i) == 1) glds16s<0>(voffK, kbs + 64, kd + 8192); else glds16s<0>(voffR, rbase0 + (size_t)_t * 64 * 64, kd + 16384); } } while (0)
#define ATT_VP(i, hh) do { const int _t = (hh) + 1; if (_t < NT) { const unsigned vd = (unsigned)__builtin_amdgcn_readfirstlane(lds0 + VB_OFF + ((unsigned)_t % 3u) * VSLOT + w * 1024); const bf16* vbs = kbase0 + (size_t)_t * 64 * NKV; \
        if ((i) == 0) glds16s<0>(voffV, vbs, vd); else glds16s<0>(voffV, vbs + 64, vd + 8192); } } while (0)
#define ATT_ALLP(hh) do { ATT_KP(0, hh); ATT_KP(1, hh); ATT_KP(2, hh); ATT_VP(0, hh); ATT_VP(1, hh); } while (0)
#define ATT_CLOSE(hh) do { if ((hh) + 2 < NT) asm volatile("s_waitcnt vmcnt(5) lgkmcnt(0)\n\ts_barrier" ::: "memory"); \
        else if ((hh) + 1 < NT) asm volatile("s_waitcnt vmcnt(2) lgkmcnt(0)\n\ts_barrier" ::: "memory"); \
        else asm volatile("s_waitcnt vmcnt(0) lgkmcnt(0)\n\ts_barrier" ::: "memory"); } while (0)
    ATT_K(0, 0); ATT_K(1, 1); ATT_VP(0, -1); ATT_VP(1, -1);
    const LAS char* qb = L + QB_OFF + wq * QSLOT + hi * 512 + r32 * 16;
    bf16x8 qr[4];
    { const bf16* qrow = QM + (tb + (size_t)qb_ * 128 + wq * 32 + r32) * NQM;
      bf16x8 qt[4];
#pragma unroll
      for (int i = 0; i < 4; ++i) qt[i] = *(const bf16x8*)(qrow + h * 128 + (4 * g + i) * 16 + hi * 8);
#pragma unroll
      for (int i = 0; i < 4; ++i) qr[i] = *(const bf16x8*)(qrow + 512 + h * 64 + i * 16 + hi * 8);
#pragma unroll
      for (int i = 0; i < 4; ++i) *(LAS bf16x8*)((LAS char*)qb + (4 * g + i) * 1024) = qt[i]; }
    f32x16 o[4];
#pragma unroll
    for (int d0 = 0; d0 < 4; ++d0) o[d0] = f32x16{};
    f32x16 p0 = f32x16{}, p1 = f32x16{};
    float m_run = -1e30f, l_run = 0.f;
    LAS float* wsf = (LAS float*)(F.lds + WSF_OFF) + w * 64;
    const int xk = (r32 >> 1) & 7;
    const LAS char* kb0 = L + KB_OFF + r32 * 128;
    const int ko0 = (hi ^ xk) * 16;
    const int vq = (lane & 15) >> 2, vbase_ = (4 * hi + vq) * 128 + 8 * (lane & 1);
    const int voA = vbase_ + ((2 * ((lane >> 4) & 1) + ((lane & 3) >> 1)) + 4 * ((vq >> 1) & 1)) * 16;
    const LAS char* vb0 = L + VB_OFF;
    ATT_WAIT_BAR();
    if (g == 1) { ATT_ALLP(0); ATT_CLOSE(0); }
    for (int t = g; t < NT; t += 2) {
        const bool vis = (t < NT - 1) || (wq >= 2);
        const int s3 = (int)((unsigned)t % 3u); const LAS char* kb = kb0 + s3 * KSLOT; const LAS char* vb = vb0 + s3 * VSLOT;
        if (!vis) ATT_ALLP(t);
        if (vis) {
            p0 = f32x16{}; p1 = f32x16{};
#define ATT_KO(kk) (ko0 ^ (32 * ((kk) & 3)))
#define ATT_LDF(i, kk) do { kf0[i] = *(const LAS bf16x8*)(kb + ATT_KO(kk) + ((kk) >> 2) * 8192); kf1[i] = *(const LAS bf16x8*)(kb + ATT_KO(kk) + ((kk) >> 2) * 8192 + 4096); \
                if ((kk) < 8) qfr[i] = *(const LAS bf16x8*)(qb + (kk) * 1024); else qfr[i] = qr[(kk) & 3]; } while (0)
            bf16x8 kf0[3], kf1[3], qfr[3];
            ATT_LDF(0, 0); ATT_LDF(1, 1);
#pragma unroll
            for (int kk = 0; kk < 12; ++kk) {
                if (kk + 2 < 12) ATT_LDF((kk + 2) % 3, kk + 2);
                p0 = __builtin_amdgcn_mfma_f32_32x32x16_bf16(kf0[kk % 3], qfr[kk % 3], p0, 0, 0, 0);
                p1 = __builtin_amdgcn_mfma_f32_32x32x16_bf16(kf1[kk % 3], qfr[kk % 3], p1, 0, 0, 0);
                if (kk == 1) ATT_KP(0, t); if (kk == 3) ATT_KP(1, t); if (kk == 5) ATT_KP(2, t); if (kk == 7) ATT_VP(0, t); if (kk == 9) ATT_VP(1, t);
                __builtin_amdgcn_sched_barrier(0);
            }
#undef ATT_LDF
#undef ATT_KO
        }
        ATT_CLOSE(t);
        if (!vis) ATT_ALLP(t + 1);
        if (vis) {
            float rm = fmaxf(p0[0], p1[0]);
#pragma unroll
            for (int r = 1; r < 16; ++r) rm = fmaxf(rm, fmaxf(p0[r], p1[r]));
            rm = swap_max(rm);
            const float mnew = fmaxf(m_run, rm);
            if (__any(mnew > m_run + THR)) {
                const float f = __builtin_amdgcn_exp2f(m_run - mnew); l_run *= f; m_run = mnew;
                if (hi == 0) wsf[r32] = f;
                asm volatile("s_waitcnt lgkmcnt(0)" ::: "memory");
#pragma unroll
                for (int r = 0; r < 16; ++r) { const float fr_ = wsf[crow(r, hi)];
#pragma unroll
                    for (int d0 = 0; d0 < 4; ++d0) o[d0][r] *= fr_; }
            }
#define ATT_VF(dst, ks_) do { _Pragma("unroll") for (int d0 = 0; d0 < 4; ++d0) { const LAS char* vp_ = vb + ((d0 & 1) ? (voA ^ 64) : voA) + (d0 >> 1) * 8192 + (ks_) * 2048; \
                const s16x4 lo = vtr(vp_), hh = vtr(vp_ + 1024); dst[d0] = (bf16x8){lo[0], lo[1], lo[2], lo[3], hh[0], hh[1], hh[2], hh[3]}; } } while (0)
            bf16x8 vfa[4], vfb[4];
            ATT_VF(vfa, 0);
            float ls = 0.f;
#pragma unroll
            for (int ks = 0; ks < 4; ++ks) {
                if (ks < 3) { if (ks & 1) ATT_VF(vfa, ks + 1); else ATT_VF(vfb, ks + 1); }
                float e[8];
#pragma unroll
                for (int j = 0; j < 8; ++j) { e[j] = __builtin_amdgcn_exp2f(((ks < 2) ? p0[8 * (ks & 1) + j] : p1[8 * (ks & 1) + j]) - m_run); ls += e[j]; }
                const v4u tw = {cvtpk(e[0], e[1]), cvtpk(e[2], e[3]), cvtpk(e[4], e[5]), cvtpk(e[6], e[7])};
                const bf16x8 pw = __builtin_bit_cast(bf16x8, tw);
#pragma unroll
                for (int d0 = 0; d0 < 4; ++d0) o[d0] = __builtin_amdgcn_mfma_f32_32x32x16_bf16(pw, (ks & 1) ? vfb[d0] : vfa[d0], o[d0], 0, 0, 0);
                if (ks < 3) ATT_KP(ks, t + 1); else { ATT_VP(0, t + 1); ATT_VP(1, t + 1); }
                __builtin_amdgcn_sched_barrier(0);
            }
            l_run += ls;
#undef ATT_VF
        }
        ATT_CLOSE(t + 1);
    }
    if (g == 0) { ATT_CLOSE(NT); }
    l_run = swap_sum(l_run);
    int lane_b; asm volatile("v_mbcnt_lo_u32_b32 %0, -1, 0\n\tv_mbcnt_hi_u32_b32 %0, -1, %0" : "=v"(lane_b));
    const int r32b = lane_b & 31, hib = lane_b >> 5;
    LAS float* MG = (LAS float*)(F.lds + MERGE_OFF) + wq * 4096;
    LAS float* ST = (LAS float*)(F.lds + ST_OFF) + wq * 64;
    if (g == 1) {
#pragma unroll
        for (int d0 = 0; d0 < 4; ++d0)
#pragma unroll
            for (int r = 0; r < 16; ++r) MG[(d0 * 16 + r) * 64 + lane_b] = o[d0][r];
        if (hib == 0) { ST[r32b] = m_run; ST[32 + r32b] = l_run; }
    }
    ATT_WAIT_BAR();
    if (g == 0) {
        const float m1 = ST[r32b], l1 = ST[32 + r32b];
        const float m = fmaxf(m_run, m1), f0 = __builtin_amdgcn_exp2f(m_run - m), f1 = __builtin_amdgcn_exp2f(m1 - m);
        const float il = 1.0f / (l_run * f0 + l1 * f1);
        if (hib == 0) { wsf[r32b] = f0 * il; wsf[32 + r32b] = f1 * il; }
        asm volatile("s_waitcnt lgkmcnt(0)" ::: "memory");
        LAS bf16* stg = (LAS bf16*)(F.lds + STAGE_OFF) + wq * 4096;
#pragma unroll
        for (int r = 0; r < 16; ++r) { const int row = crow(r, hib); const float a0 = wsf[row], a1 = wsf[32 + row];
#pragma unroll
            for (int d0 = 0; d0 < 4; ++d0) stg[row * 128 + d0 * 32 + r32b] = (bf16)f2bf(o[d0][r] * a0 + MG[(d0 * 16 + r) * 64 + lane_b] * a1);
            if ((r & 3) == 3) __builtin_amdgcn_sched_barrier(0); }
        asm volatile("s_waitcnt lgkmcnt(0)" ::: "memory");
        bf16* orow = CAT + (tb + (size_t)qb_ * 128 + wq * 32) * D + 512 + h * 128;
#pragma unroll
        for (int i = 0; i < 8; ++i) { const int id = i * 64 + lane_b, row = id >> 4, ch = id & 15; *(GAS v4u*)(orow + (size_t)row * D + ch * 8) = *(const LAS v4u*)(stg + row * 128 + ch * 8); }
    }
    ATT_WAIT_BAR();
#undef ATT_KP
#undef ATT_VP
#undef ATT_ALLP
#undef ATT_KBASE
#undef ATT_K
#undef ATT_V
#undef ATT_CLOSE
}
__device__ __forceinline__ void attn_phase(Frame& F, const bf16* QM, const bf16* KVB, const bf16* KPE, bf16* CAT) {
#pragma unroll 1
    for (int it = 2 * F.vcu; it < 512; it += 2 * F.G) {
#pragma unroll 1
        for (int u = 0; u < 2; ++u) { const int v = it >> 1, bh = v >> 5, s = v & 31;
            attn_unit(F, bh >> 2, bh & 3, u ? s : 63 - s, QM, KVB, KPE, CAT); } }
}
#undef ATT_WAIT_BAR
}

namespace ret {
using att::f32x16; using att::s16x4; using att::glds16; using att::crow; using att::vtr; using att::cvtpk;
#define RET_WAIT_BAR() asm volatile("s_waitcnt vmcnt(0) lgkmcnt(0)\n\ts_barrier" ::: "memory")
__device__ __forceinline__ bf16x8 scale8(const bf16x8 v, const float (&f)[8]) {
    float x[8];
#pragma unroll
    for (int j = 0; j < 8; ++j) x[j] = __uint_as_float((unsigned)(unsigned short)v[j] << 16) * f[j];
    v4u t = {cvtpk(x[0], x[1]), cvtpk(x[2], x[3]), cvtpk(x[4], x[5]), cvtpk(x[6], x[7])};
    return __builtin_bit_cast(bf16x8, t);
}
__device__ __forceinline__ bf16x8 trfrag_kappa(const LAS char* p) { const s16x4 lo = vtr(p), hh = vtr(p + 512); return (bf16x8){lo[0], lo[1], lo[2], lo[3], hh[0], hh[1], hh[2], hh[3]}; }
__device__ __forceinline__ bf16x8 trfrag_nat(const LAS char* p) { const s16x4 lo = vtr(p), hh = vtr(p + 256); return (bf16x8){lo[0], lo[1], lo[2], lo[3], hh[0], hh[1], hh[2], hh[3]}; }

__device__ __forceinline__ void kv_phase(Frame& F, const bf16* RK, const bf16* RV, bf16* KVS) {
    const int lane = F.lane, r32 = lane & 31, hi = lane >> 5, w = F.wave;
    const unsigned lds0 = (unsigned)(uintptr_t)F.lds;
    const LAS char* L = (const LAS char*)F.lds;
    const int trb = ((lane >> 4) & 1) * 32 + (lane & 3) * 8 + (4 * hi + ((lane & 15) >> 2)) * 64;
    const int db = w >> 1, eb0 = 2 * (w & 1);
#pragma unroll 1
    for (int blk = F.vcu; blk < BATCH * NCH * RH; blk += F.G) {
        const int h = blk % RH, n = (blk / RH) % NCH, b = blk / (RH * NCH);
        const size_t t0 = (size_t)b * SEQ + (size_t)n * CHUNK;
        { const size_t so = (t0 + 16 * (w & 3) + (lane >> 2)) * 512 + h * 128 + 32 * (w >> 2) + (lane & 3) * 8;
          const unsigned d0 = (unsigned)__builtin_amdgcn_readfirstlane(lds0 + w * 1024);
          glds16(RK + so, d0); glds16(RK + so + 64, d0 + 8192); glds16(RV + so, d0 + 16384); glds16(RV + so + 64, d0 + 16384 + 8192); }
        const float lg2 = ret_logg(h) * 1.4426950408889634f;
        RET_WAIT_BAR();
        f32x16 acc0 = f32x16{}, acc1 = f32x16{};
#pragma unroll
        for (int ks = 0; ks < 4; ++ks) {
            float f[8];
#pragma unroll
            for (int jj = 0; jj < 8; ++jj) f[jj] = __builtin_amdgcn_exp2f(lg2 * (float)(63 - (16 * ks + 4 * hi + (jj & 3) + 8 * (jj >> 2))));
            const bf16x8 af = scale8(trfrag_kappa(L + trb + (db * 4 + ks) * 1024), f);
            const bf16x8 b0 = trfrag_kappa(L + 16384 + trb + (eb0 * 4 + ks) * 1024), b1 = trfrag_kappa(L + 16384 + trb + ((eb0 + 1) * 4 + ks) * 1024);
            acc0 = __builtin_amdgcn_mfma_f32_32x32x16_bf16(af, b0, acc0, 0, 0, 0);
            acc1 = __builtin_amdgcn_mfma_f32_32x32x16_bf16(af, b1, acc1, 0, 0, 0);
        }
        bf16* o = KVS + (size_t)blk * 16384 + (size_t)(32 * db) * 128 + 32 * eb0 + r32;
#pragma unroll
        for (int r = 0; r < 16; ++r) { const int d = crow(r, hi); o[d * 128] = (bf16)f2bf(acc0[r]); o[d * 128 + 32] = (bf16)f2bf(acc1[r]); }
        RET_WAIT_BAR();
    }
}
__device__ __forceinline__ void scan_phase(Frame& F, bf16* KVS) {
    for (int gid = F.vcu * NTHR + F.tid; gid < BATCH * RH * 16384; gid += F.G * NTHR) {
        const int de = gid & 16383, h = (gid >> 14) % RH, b = gid >> 16;
        const float c = expf(ret_logg(h) * (float)CHUNK); float S = 0.f;
        bf16* p = KVS + ((size_t)(b * NCH * RH + h)) * 16384 + de;
#pragma unroll 1
        for (int n0 = 0; n0 < NCH; n0 += 16) {
            bf16 v[16];
#pragma unroll
            for (int i = 0; i < 16; ++i) v[i] = p[(size_t)(n0 + i) * RH * 16384];
#pragma unroll
            for (int i = 0; i < 16; ++i) { p[(size_t)(n0 + i) * RH * 16384] = (bf16)f2bf(S); S = c * S + bf2f(v[i]); }
        }
    }
}
__device__ __forceinline__ void out_phase(Frame& F, const bf16* RQ, const bf16* RK, const bf16* RV, const bf16* RG, const bf16* PREV, bf16* CAT) {
    const int lane = F.lane, r32 = lane & 31, hi = lane >> 5, w = F.wave, ih = w >> 2, eb = w & 3;
    const unsigned lds0 = (unsigned)(uintptr_t)F.lds;
    const LAS char* L = (const LAS char*)F.lds;
    const int trk = ((lane >> 4) & 1) * 32 + (lane & 3) * 8 + (4 * hi + ((lane & 15) >> 2)) * 64;
    const int trn = ((lane >> 4) & 1) * 32 + (lane & 3) * 8 + (8 * hi + ((lane & 15) >> 2)) * 64;
    LAS float* os = (LAS float*)(F.lds + 65536);
#pragma unroll 1
    for (int blk = F.vcu; blk < BATCH * NCH * RH; blk += F.G) {
        const int h = blk % RH, n = (blk / RH) % NCH, b = blk / (RH * NCH);
        const size_t t0 = (size_t)b * SEQ + (size_t)n * CHUNK;
        { const unsigned d0 = (unsigned)__builtin_amdgcn_readfirstlane(lds0 + w * 1024);
          const size_t ko = (t0 + lane) * 512 + h * 128 + w * 8;
          glds16(RK + ko, d0); glds16(RK + ko + 64, d0 + 8192);
          const size_t so = (t0 + 16 * (w & 3) + (lane >> 2)) * 512 + h * 128 + 32 * (w >> 2) + (lane & 3) * 8;
          glds16(RV + so, d0 + 16384); glds16(RV + so + 64, d0 + 16384 + 8192);
          const bf16* pp = PREV + (size_t)blk * 16384 + (size_t)(16 * w + (lane >> 2)) * 128 + (lane & 3) * 8;
          glds16(pp, d0 + 32768); glds16(pp + 32, d0 + 32768 + 8192); glds16(pp + 64, d0 + 32768 + 16384); glds16(pp + 96, d0 + 32768 + 24576); }
        bf16x8 qf[8];
        { const bf16* qrow = RQ + (t0 + 32 * ih + r32) * 512 + h * 128 + hi * 8;
#pragma unroll
          for (int kk = 0; kk < 8; ++kk) qf[kk] = *(const bf16x8*)(qrow + kk * 16); }
        const float lg2 = ret_logg(h) * 1.4426950408889634f;
        RET_WAIT_BAR();
        f32x16 p0 = f32x16{}, p1 = f32x16{};
        { const LAS char* kb = L + hi * 1024 + r32 * 16;
#pragma unroll
          for (int kk = 0; kk < 8; ++kk) { const bf16x8 a0 = *(const LAS bf16x8*)(kb + kk * 2048), a1 = *(const LAS bf16x8*)(kb + kk * 2048 + 512);
              p0 = __builtin_amdgcn_mfma_f32_32x32x16_bf16(a0, qf[kk], p0, 0, 0, 0); p1 = __builtin_amdgcn_mfma_f32_32x32x16_bf16(a1, qf[kk], p1, 0, 0, 0); } }
        f32x16 oc = f32x16{};
#pragma unroll
        for (int kd = 0; kd < 8; ++kd) oc = __builtin_amdgcn_mfma_f32_32x32x16_bf16(qf[kd], trfrag_nat(L + 32768 + trn + (eb * 8 + kd) * 1024), oc, 0, 0, 0);
        { const int i = 32 * ih + r32;
#pragma unroll
          for (int r = 0; r < 16; ++r) { const int j = crow(r, hi); const int d0 = i > j ? i - j : j - i, d1 = i > j + 32 ? i - j - 32 : j + 32 - i;
              p0[r] *= __builtin_amdgcn_exp2f(lg2 * (float)d0); p1[r] *= __builtin_amdgcn_exp2f(lg2 * (float)d1); } }
        bf16x8 pw[4];
        { v4u t0_ = {cvtpk(p0[0], p0[1]), cvtpk(p0[2], p0[3]), cvtpk(p0[4], p0[5]), cvtpk(p0[6], p0[7])};
          v4u t1_ = {cvtpk(p0[8], p0[9]), cvtpk(p0[10], p0[11]), cvtpk(p0[12], p0[13]), cvtpk(p0[14], p0[15])};
          v4u t2_ = {cvtpk(p1[0], p1[1]), cvtpk(p1[2], p1[3]), cvtpk(p1[4], p1[5]), cvtpk(p1[6], p1[7])};
          v4u t3_ = {cvtpk(p1[8], p1[9]), cvtpk(p1[10], p1[11]), cvtpk(p1[12], p1[13]), cvtpk(p1[14], p1[15])};
          pw[0] = __builtin_bit_cast(bf16x8, t0_); pw[1] = __builtin_bit_cast(bf16x8, t1_); pw[2] = __builtin_bit_cast(bf16x8, t2_); pw[3] = __builtin_bit_cast(bf16x8, t3_); }
        f32x16 oi = f32x16{};
#pragma unroll
        for (int ks = 0; ks < 4; ++ks) oi = __builtin_amdgcn_mfma_f32_32x32x16_bf16(pw[ks], trfrag_kappa(L + 16384 + trk + (eb * 4 + ks) * 1024), oi, 0, 0, 0);
#pragma unroll
        for (int r = 0; r < 16; ++r) { const int i = 32 * ih + crow(r, hi); os[i * 128 + 32 * eb + r32] = oi[r] + __builtin_amdgcn_exp2f(lg2 * (float)(i + 1)) * oc[r]; }
        RET_WAIT_BAR();
#pragma unroll 1
        for (int r = 0; r < 8; ++r) { const int i = w * 8 + r;
            const float a0 = os[i * 128 + lane], a1 = os[i * 128 + lane + 64];
            const float mu = wave_sum(a0 + a1) * (1.0f / 128.0f); const float d0 = a0 - mu, d1 = a1 - mu;
            const float rs = 1.0f / sqrtf(wave_sum(d0 * d0 + d1 * d1) * (1.0f / 128.0f) + 1e-5f);
            const float g0 = bf2f(RG[(t0 + i) * 512 + h * 128 + lane]), g1 = bf2f(RG[(t0 + i) * 512 + h * 128 + lane + 64]);
            bf16* orow = CAT + (t0 + i) * D + h * 128;
            orow[lane] = (bf16)f2bf(d0 * rs * g0 * pg8::fast_sigmoid(g0)); orow[lane + 64] = (bf16)f2bf(d1 * rs * g1 * pg8::fast_sigmoid(g1)); }
        RET_WAIT_BAR();
    }
}
#undef RET_WAIT_BAR
}
__global__ void __launch_bounds__(NTHR, 2) mk_fwd(Args args) {
    extern __shared__ __attribute__((aligned(16))) unsigned char lds[];
    Frame F;
    F.lds = (LAS unsigned char*)lds;
    F.MISC = (volatile LAS unsigned*)(F.lds + MISC_OFF);
    F.wave = __builtin_amdgcn_readfirstlane((int)threadIdx.x >> 6);
#define REFRESH() do { int l_; asm volatile("v_mbcnt_lo_u32_b32 %0, -1, 0\n\tv_mbcnt_hi_u32_b32 %0, -1, %0" : "=v"(l_)); F.lane = l_; F.tid = F.wave * 64 + l_; } while (0)
    REFRESH();
    F.G = gridDim.x; { const int bx = blockIdx.x; F.vcu = (F.G % 8 == 0) ? (bx % 8) * (F.G / 8) + bx / 8 : bx; }
    unsigned char* ws = args.ws;
    F.ctl = (gu32*)(ws + WS_CTL);
    for (int u = F.tid; u < (LDS_BYTES - LDSCTL_OFF) / 4; u += NTHR) ((LAS unsigned*)(F.lds + LDSCTL_OFF))[u] = 0u;
    __syncthreads();
    XcdBarrier bar; bar.bar = (unsigned*)(F.ctl + CW_BAR); bar.x = 0; bar.st = nullptr;
    if (N_LAUNCHES != PER_PHASE) bar = xcd_barrier_post((unsigned*)(F.ctl + CW_BAR), F.MISC + 8, F.tid);
#define GRID_BAR() do { if (N_LAUNCHES != PER_PHASE) { REFRESH(); xcd_barrier(bar, F.tid); } REFRESH(); } while (0)
    const int lo = args.ph_lo, hi = args.ph_hi;
#define IN(k) (lo <= (k) && (k) < hi)
#define BOTH(k) (IN(k) && IN((k) + 1))
    bf16* XN = (bf16*)(ws + WS_XN); bf16* RQ = (bf16*)(ws + WS_RQ); bf16* RK = (bf16*)(ws + WS_RK); bf16* RV = (bf16*)(ws + WS_RV); bf16* RG = (bf16*)(ws + WS_RG);
    bf16* QM = (bf16*)(ws + WS_QM); bf16* CQ = (bf16*)(ws + WS_CQ); bf16* CKV = (bf16*)(ws + WS_CKV); bf16* KPE = (bf16*)(ws + WS_KPE); bf16* KVB = (bf16*)(ws + WS_KVB);
    bf16* CAT = (bf16*)(ws + WS_CAT); bf16* PB = (bf16*)(ws + WS_PB); bf16* ACT = (bf16*)(ws + WS_ACT); bf16* KVS = XN; bf16* X1B = XN; bf16* PROJ = KVB;
    float* SSQ = (float*)(ws + WS_SSQ); float* ssq_cq = SSQ; float* ssq_ckv = SSQ + T; float* ssq_x1 = SSQ + 2 * T; float* ssq_x2 = SSQ + 3 * T; float* ssq_x3 = SSQ + 4 * T;
    const float* RC = (const float*)(ws + WS_RC); const float* RS = (const float*)(ws + WS_RS); const float* MC = (const float*)(ws + WS_MC); const float* MS = (const float*)(ws + WS_MS);
    const int cid = (int)blockIdx.x;
    float* ssq_dummy = SSQ + 5 * T;
#define REPS(k) for (int rep = 0; rep < ((MK_DUP) == (k) ? 2 : 1); ++rep)

    if (IN(0)) { REFRESH(); REPS(0) p0_prologue(F, args.in, ws); if (BOTH(0)) GRID_BAR(); }
    if (IN(1)) { REFRESH();
        pg8::Gemm g{XN, (const bf16*)(ws + WS_WIN), T, NZ, D}; pg8::StaticOrder S; S.init(T, NZ, F.G, cid);
        REPS(1) { pg8::EpiZ E{RQ, RK, RV, RG, CQ, CKV, KPE, RC, RS, MC, MS, rep ? ssq_dummy : ssq_cq, rep ? ssq_dummy : ssq_ckv};
        pg8::gemm_phase<pg8::EpiZ, pg8::StaticOrder, true, true>(F.lds + RING_OFF, g, S, E, F.tid, F.wave); }
        if (BOTH(1)) GRID_BAR();
    }
    if (IN(2)) { REFRESH(); REPS(2) {
        { pg8::Gemm g{CQ, (const bf16*)(ws + WS_WUQ), T, NQM, 256}; pg8::StaticOrder S; S.init(T, NQM, F.G, cid);
          pg8::EpiQM E{QM, MC, MS, ssq_cq, QSCALE};
          pg8::gemm_phase<pg8::EpiQM, pg8::StaticOrder, true, true>(F.lds + RING_OFF, g, S, E, F.tid, F.wave); }
        { pg8::Gemm g{CKV, (const bf16*)(ws + WS_WUKV), T, NKV, 128}; pg8::StaticOrder S; S.init(T, NKV, F.G, cid);
          pg8::EpiScaleBf16 E{KVB, NKV, ssq_ckv, 1.0f / 128.0f};
          pg8::gemm_phase<pg8::EpiScaleBf16, pg8::StaticOrder, true, true>(F.lds + RING_OFF, g, S, E, F.tid, F.wave); }
        ret::kv_phase(F, RK, RV, KVS); }
        if (BOTH(2)) GRID_BAR();
    }
    if (IN(3)) { REFRESH();
        ret::scan_phase(F, KVS);
        REPS(3) att::attn_phase(F, QM, KVB, KPE, CAT);
        if (BOTH(3)) GRID_BAR();
    }
    if (IN(4)) { REFRESH();
        REPS(4) ret::out_phase(F, RQ, RK, RV, RG, KVS, CAT);
        if (BOTH(4)) GRID_BAR();
    }
    if (IN(5)) { REFRESH(); REPS(5) {
        { pg8::Gemm g{CAT, (const bf16*)(ws + WS_WO), T, D, D}; pg8::StaticOrder S; S.init(T, D, F.G, cid);
          pg8::EpiRes E{args.in.x, args.out, X1B, rep ? ssq_dummy : ssq_x1};
          pg8::gemm_phase<pg8::EpiRes, pg8::StaticOrder, true, true>(F.lds + RING_OFF, g, S, E, F.tid, F.wave); }
        { pg8::Gemm g{PB, (const bf16*)(ws + WS_WPP), T, D, DPLE}; pg8::StaticOrder S; S.init(T, D, F.G, cid);
          pg8::EpiScaleBf16 E{PROJ, D, nullptr, 0.f};
          pg8::gemm_phase<pg8::EpiScaleBf16, pg8::StaticOrder, true, true>(F.lds + RING_OFF, g, S, E, F.tid, F.wave); } }
        if (BOTH(5)) GRID_BAR();
    }
    if (IN(6)) { REFRESH();
        pg8::Gemm g{X1B, (const bf16*)(ws + WS_WGU), T, NGU, D}; pg8::StaticOrder S; S.init(T, NGU, F.G, cid);
        pg8::EpiGU E{ACT, DFF, ssq_x1};
        REPS(6) pg8::gemm_phase<pg8::EpiGU, pg8::StaticOrder, true, true>(F.lds + RING_OFF, g, S, E, F.tid, F.wave);
        if (BOTH(6)) GRID_BAR();
    }
    if (IN(7)) { REFRESH();
        pg8::Gemm g{ACT, (const bf16*)(ws + WS_WD), T, D, DFF}; pg8::StaticOrder S; S.init(T, D, F.G, cid);
        pg8::EpiRes E{args.out, args.out, X1B, ssq_x2};
        pg8::gemm_phase<pg8::EpiRes, pg8::StaticOrder, true, true>(F.lds + RING_OFF, g, S, E, F.tid, F.wave);
        if (BOTH(7)) GRID_BAR();
    }
    if (IN(8)) { REFRESH();
        pg8::Gemm g{X1B, (const bf16*)(ws + WS_WPG), T, D, D}; pg8::StaticOrder S; S.init(T, D, F.G, cid);
        pg8::EpiPle E{args.out, PROJ, ssq_x2, ssq_x3};
        pg8::gemm_phase<pg8::EpiPle, pg8::StaticOrder, true, true>(F.lds + RING_OFF, g, S, E, F.tid, F.wave);
        if (BOTH(8)) GRID_BAR();
    }
    if (IN(9)) { REFRESH(); final_norm(F, args.out, ssq_x3, args.in.fin_g); }
#undef IN
#undef BOTH
}

extern "C" void kernel_launch(void* const* d_in, const int* in_sizes, int n_in, void* d_out, int out_size, void* d_ws, size_t ws_size, hipStream_t stream) {
    static int grid = 0;
    if (grid == 0) {
        if (n_in != 18 || out_size != T * D || ws_size < WS_END) { fprintf(stderr, "kernel_launch: unexpected shapes (n_in %d out %d ws %zu)\n", n_in, out_size, ws_size); grid = -1; return; }
        int dev = 0, cus = 0;
        if (hipGetDevice(&dev) != hipSuccess || hipDeviceGetAttribute(&cus, hipDeviceAttributeMultiprocessorCount, dev) != hipSuccess) { grid = -1; return; }
        if (hipFuncSetAttribute((const void*)mk_fwd, hipFuncAttributeMaxDynamicSharedMemorySize, LDS_BYTES) != hipSuccess) { fprintf(stderr, "kernel_launch: hipFuncSetAttribute failed\n"); grid = -1; return; }
        grid = cus;
    }
    if (grid < 0) return;
    if (hipMemsetAsync((char*)d_ws + WS_CTL, 0, CTL_ZERO_BYTES, stream) != hipSuccess) return;
    Args a{};
    const void** pp = (const void**)&a.in;
    for (int i = 0; i < 18; ++i) pp[i] = d_in[i];
    a.out = (float*)d_out; a.ws = (unsigned char*)d_ws;
    for (int li = 0; li < N_LAUNCHES; ++li) {
        a.ph_lo = (N_LAUNCHES == PER_PHASE) ? li : 0; a.ph_hi = (N_LAUNCHES == PER_PHASE) ? li + 1 : PER_PHASE; a.li = li;
        hipLaunchKernelGGL(mk_fwd, dim3(grid), dim3(NTHR), LDS_BYTES, stream, a);
    }
}
```

```cpp
#include <hip/hip_runtime.h>
#include <cstdio>
#include <cstdint>
#include <cmath>
#include <cstddef>
#define OPT_W1 1
#define MK_N_LAUNCHES 1
namespace pg8 {
#define PG8_LAS __attribute__((address_space(3)))
typedef unsigned short bf16_t;
typedef short bf16x8 __attribute__((ext_vector_type(8)));
typedef float f32x4 __attribute__((ext_vector_type(4)));
typedef unsigned u32x4 __attribute__((ext_vector_type(4)));
constexpr int BM = 256, BK = 64, HALF = 128, HTB = HALF * BK * 2  , STAGE_BYTES = 8 * HTB, NXCD = 8, WGM = 8;

__host__ __device__ __forceinline__ int lds_byte(int r, int c) { const int st = (r >> 4) * 2 + (c >> 5), rr = r & 15, cc = c & 31, ob = rr * 64 + cc * 2; return st * 1024 + (ob ^ (((ob >> 9) & 1) << 5)); }
__host__ __device__ __forceinline__ void stage_rc(int b, int& R, int& C) { const int st = b / 1024, sb = b % 1024, swz = sb ^ (((sb >> 9) & 1) << 5); R = (st >> 1) * 16 + swz / 64; C = (st & 1) * 32 + (swz % 64) / 2; }
__host__ __device__ __forceinline__ int perm32(int rho) { const int n = rho >> 4, i = rho & 15; return 8 * (i >> 2) + 4 * n + (i & 3); }

struct Unit { int pm, pn; };
struct Gemm { const bf16_t* A; const bf16_t* Bt; int M, N, K; };

struct StaticOrder {
    int nM, nN, nwg, G, c;
    __host__ __device__ void init(int M, int N, int G_, int c_) { nM = M / BM; nN = N / BM; nwg = nM * nN; G = G_; c = c_; }
    __host__ __device__ bool next(int i, Unit& u) const {
        const long L = (long)i * G + c; if (L >= nwg) return false;
        int wgid = (int)L; { const int q = nwg / NXCD, r = nwg % NXCD, xcd = wgid % NXCD, off = wgid / NXCD; wgid = (xcd < r ? xcd * (q + 1) : r * (q + 1) + (xcd - r) * q) + off; }
        const int nig = WGM * nN, gid = wgid / nig, fm = gid * WGM, gsz = (nM - fm) < WGM ? (nM - fm) : WGM;
        u.pm = fm + ((wgid % nig) % gsz); u.pn = (wgid % nig) / gsz; return true;
    }
    __device__ __forceinline__ void a_ready(const Unit&) const {}
    __device__ __forceinline__ void done(const Unit&) const {}
};
struct SubsetOrder {
    int nN, first, count;
    __host__ __device__ bool next(int i, Unit& u) const { if (i >= count) return false; const int L = first + i; u.pm = L / nN; u.pn = L % nN; return true; }
    __device__ __forceinline__ void a_ready(const Unit&) const {}
    __device__ __forceinline__ void done(const Unit&) const {}
};
__device__ __forceinline__ unsigned cvt_pk_bf16(float lo, float hi) { unsigned r; asm volatile("v_cvt_pk_bf16_f32 %0, %1, %2" : "=v"(r) : "v"(lo), "v"(hi)); return r; }
__device__ __forceinline__ u32x4 pack8(const f32x4 v0, const f32x4 v1) { u32x4 w; w.x = cvt_pk_bf16(v0[0], v0[1]); w.y = cvt_pk_bf16(v0[2], v0[3]); w.z = cvt_pk_bf16(v1[0], v1[1]); w.w = cvt_pk_bf16(v1[2], v1[3]); return w; }
__device__ __forceinline__ float sq8(const f32x4 a, const f32x4 b) { return (a[0] * a[0] + a[1] * a[1]) + (a[2] * a[2] + a[3] * a[3]) + (b[0] * b[0] + b[1] * b[1]) + (b[2] * b[2] + b[3] * b[3]); }
__device__ __forceinline__ float fast_sigmoid(float v) { return __builtin_amdgcn_rcpf(1.0f + __builtin_amdgcn_exp2f(-1.4426950408889634f * v)); }
__device__ __forceinline__ void rope8(f32x4& v0, f32x4& v1, const f32x4 c, const f32x4 s) {
    const float a0 = v0[0] * c[0] - v0[1] * s[0], b0 = v0[1] * c[0] + v0[0] * s[0];
    const float a1 = v0[2] * c[1] - v0[3] * s[1], b1 = v0[3] * c[1] + v0[2] * s[1];
    const float a2 = v1[0] * c[2] - v1[1] * s[2], b2 = v1[1] * c[2] + v1[0] * s[2];
    const float a3 = v1[2] * c[3] - v1[3] * s[3], b3 = v1[3] * c[3] + v1[2] * s[3];
    v0 = (f32x4){a0, b0, a1, b1}; v1 = (f32x4){a2, b2, a3, b3};
}
__device__ __forceinline__ void ssq_add(float* ssq, int row, float s, int fq) { s += __shfl_xor(s, 16); s += __shfl_xor(s, 32); if (fq == 0) atomicAdd(ssq + row, s); }

#define EPI_ROWS_BEGIN _Pragma("unroll") for (int ai = 0; ai < 2; ++ai) _Pragma("unroll") for (int m = 0; m < 4; ++m) { const int row = row0 + ai * HALF + m * 16;
#define EPI_ROWS_END }

struct EpiZ {
    static constexpr bool PERM = true, AFTER_DRAIN = false;
    bf16_t *RQ, *RK, *RV, *RG, *CQ, *CKV, *KPE; const float *RC, *RS, *MC, *MS; float *ssq_cq, *ssq_ckv;
    __device__ __forceinline__ void operator()(const f32x4 (&acc)[2][2][4][2], const Unit& u, int wr, int wc, int fr, int fq) const {
        const int pn = u.pn, row0 = u.pm * BM + wr * 64 + fr, cw = wc * 32 + 8 * fq;
        if (pn < 4) {
            bf16_t* dst = (pn < 2 ? RQ : RK) + (pn & 1) * 256 + cw; const int i0 = 16 * wc + 4 * fq;
            EPI_ROWS_BEGIN
                const f32x4 c = *(const f32x4*)(RC + (size_t)row * 64 + i0), s = *(const f32x4*)(RS + (size_t)row * 64 + i0);
#pragma unroll
                for (int bj = 0; bj < 2; ++bj) { f32x4 v0 = acc[ai][bj][m][0], v1 = acc[ai][bj][m][1]; rope8(v0, v1, c, s); *(u32x4*)(dst + (size_t)row * 512 + bj * HALF) = pack8(v0, v1); }
            EPI_ROWS_END
        } else if (pn < 8) {
            bf16_t* dst = (pn < 6 ? RV : RG) + (pn & 1) * 256 + cw;
            EPI_ROWS_BEGIN
#pragma unroll
                for (int bj = 0; bj < 2; ++bj) *(u32x4*)(dst + (size_t)row * 512 + bj * HALF) = pack8(acc[ai][bj][m][0], acc[ai][bj][m][1]);
            EPI_ROWS_END
        } else if (pn == 8) {
            EPI_ROWS_BEGIN
                float s = 0.f;
#pragma unroll
                for (int bj = 0; bj < 2; ++bj) { *(u32x4*)(CQ + (size_t)row * 256 + bj * HALF + cw) = pack8(acc[ai][bj][m][0], acc[ai][bj][m][1]); s += sq8(acc[ai][bj][m][0], acc[ai][bj][m][1]); }
                ssq_add(ssq_cq, row, s, fq);
            EPI_ROWS_END
        } else {
            const int i0 = 16 * wc + 4 * fq;
            EPI_ROWS_BEGIN
                *(u32x4*)(CKV + (size_t)row * 128 + cw) = pack8(acc[ai][0][m][0], acc[ai][0][m][1]);
                ssq_add(ssq_ckv, row, sq8(acc[ai][0][m][0], acc[ai][0][m][1]), fq);
                if (wc < 2) { const f32x4 c = *(const f32x4*)(MC + (size_t)row * 32 + i0), s = *(const f32x4*)(MS + (size_t)row * 32 + i0);
                    f32x4 v0 = acc[ai][1][m][0], v1 = acc[ai][1][m][1]; rope8(v0, v1, c, s); *(u32x4*)(KPE + (size_t)row * 64 + cw) = pack8(v0, v1); }
            EPI_ROWS_END
        }
    }
};
struct EpiQM {
    static constexpr bool PERM = true, AFTER_DRAIN = false;
    bf16_t* QM; const float *MC, *MS; const float* ssq; float qscale;
    __device__ __forceinline__ void operator()(const f32x4 (&acc)[2][2][4][2], const Unit& u, int wr, int wc, int fr, int fq) const {
        const int pn = u.pn, row0 = u.pm * BM + wr * 64 + fr, cw = wc * 32 + 8 * fq; const int i0 = 16 * (wc & 1) + 4 * fq;
        EPI_ROWS_BEGIN
            const float rs = qscale / sqrtf(ssq[row] * (1.0f / 256.0f) + 1e-6f);
            f32x4 c, s; if (pn == 2) { c = *(const f32x4*)(MC + (size_t)row * 32 + i0); s = *(const f32x4*)(MS + (size_t)row * 32 + i0); }
#pragma unroll
            for (int bj = 0; bj < 2; ++bj) { f32x4 v0 = acc[ai][bj][m][0] * rs, v1 = acc[ai][bj][m][1] * rs; if (pn == 2) rope8(v0, v1, c, s);
                *(u32x4*)(QM + (size_t)row * 768 + pn * 256 + bj * HALF + cw) = pack8(v0, v1); }
        EPI_ROWS_END
    }
};
struct EpiScaleBf16 {
    static constexpr bool PERM = true, AFTER_DRAIN = false;
    bf16_t* O; int ldc; const float* ssq; float inv_n; size_t tile_stride;
    __device__ __forceinline__ void operator()(const f32x4 (&acc)[2][2][4][2], const Unit& u, int wr, int wc, int fr, int fq) const {
        const int row0 = u.pm * BM + wr * 64 + fr, col0 = (tile_stride ? 0 : u.pn * BM) + wc * 32 + 8 * fq; bf16_t* O = this->O + (size_t)u.pn * tile_stride;
        EPI_ROWS_BEGIN
            const float rs = ssq ? 1.0f / sqrtf(ssq[row] * inv_n + 1e-6f) : 1.0f;
#pragma unroll
            for (int bj = 0; bj < 2; ++bj) *(u32x4*)(O + (size_t)row * ldc + col0 + bj * HALF) = pack8(acc[ai][bj][m][0] * rs, acc[ai][bj][m][1] * rs);
        EPI_ROWS_END
    }
};
struct EpiRes {
    static constexpr bool PERM = true, AFTER_DRAIN = false;
    const float* base; float* X; bf16_t* XB; float* ssq;
    __device__ __forceinline__ void operator()(const f32x4 (&acc)[2][2][4][2], const Unit& u, int wr, int wc, int fr, int fq) const {
        const int row0 = u.pm * BM + wr * 64 + fr, col0 = u.pn * BM + wc * 32 + 8 * fq;
        EPI_ROWS_BEGIN
            float s = 0.f;
#pragma unroll
            for (int bj = 0; bj < 2; ++bj) { const size_t off = (size_t)row * 1024 + col0 + bj * HALF;
                const f32x4 v0 = acc[ai][bj][m][0] + *(const f32x4*)(base + off), v1 = acc[ai][bj][m][1] + *(const f32x4*)(base + off + 4);
                *(f32x4*)(X + off) = v0; *(f32x4*)(X + off + 4) = v1; *(u32x4*)(XB + off) = pack8(v0, v1); s += sq8(v0, v1); }
            ssq_add(ssq, row, s, fq);
        EPI_ROWS_END
    }
};
struct EpiGU {
    static constexpr bool PERM = true, AFTER_DRAIN = false;
    bf16_t* ACT; int ldc; const float* ssq;
    __device__ __forceinline__ void operator()(const f32x4 (&acc)[2][2][4][2], const Unit& u, int wr, int wc, int fr, int fq) const {
        const int row0 = u.pm * BM + wr * 64 + fr, col0 = u.pn * HALF + wc * 32 + 8 * fq;
        EPI_ROWS_BEGIN
            const float rs = 1.0f / sqrtf(ssq[row] * (1.0f / 1024.0f) + 1e-6f);
            f32x4 o[2];
#pragma unroll
            for (int n = 0; n < 2; ++n) { const f32x4 g = acc[ai][0][m][n] * rs, up = acc[ai][1][m][n] * rs;
#pragma unroll
                for (int q = 0; q < 4; ++q) o[n][q] = g[q] * fast_sigmoid(g[q]) * up[q]; }
            *(u32x4*)(ACT + (size_t)row * ldc + col0) = pack8(o[0], o[1]);
        EPI_ROWS_END
    }
};
struct EpiPle {
    static constexpr bool PERM = true, AFTER_DRAIN = false;
    float* X; const bf16_t* PROJ; const float* ssq_in; float* ssq_out;
    __device__ __forceinline__ void operator()(const f32x4 (&acc)[2][2][4][2], const Unit& u, int wr, int wc, int fr, int fq) const {
        const int row0 = u.pm * BM + wr * 64 + fr, col0 = u.pn * BM + wc * 32 + 8 * fq;
        EPI_ROWS_BEGIN
            const float rs = 1.0f / sqrtf(ssq_in[row] * (1.0f / 1024.0f) + 1e-6f);
            float s = 0.f;
#pragma unroll
            for (int bj = 0; bj < 2; ++bj) { const size_t off = (size_t)row * 1024 + col0 + bj * HALF;
                const u32x4 pw = *(const u32x4*)(PROJ + off); const f32x4 x0 = *(const f32x4*)(X + off), x1 = *(const f32x4*)(X + off + 4);
                const f32x4 p0 = {__uint_as_float(pw.x << 16), __uint_as_float(pw.x & 0xffff0000u), __uint_as_float(pw.y << 16), __uint_as_float(pw.y & 0xffff0000u)};
                const f32x4 p1 = {__uint_as_float(pw.z << 16), __uint_as_float(pw.z & 0xffff0000u), __uint_as_float(pw.w << 16), __uint_as_float(pw.w & 0xffff0000u)};
                f32x4 v0, v1;
#pragma unroll
                for (int q = 0; q < 4; ++q) { v0[q] = x0[q] + fast_sigmoid(acc[ai][bj][m][0][q] * rs) * p0[q]; v1[q] = x1[q] + fast_sigmoid(acc[ai][bj][m][1][q] * rs) * p1[q]; }
                *(f32x4*)(X + off) = v0; *(f32x4*)(X + off + 4) = v1; s += sq8(v0, v1); }
            ssq_add(ssq_out, row, s, fq);
        EPI_ROWS_END
    }
};
template <class Epi, class Sched, bool ALIGN_EPI = false, bool SP2 = false>
__device__ __forceinline__ void gemm_phase(PG8_LAS unsigned char* lds, const Gemm g, const Sched& S, const Epi& E, const int tid, const int wid) {
    const int lane = tid & 63, wr = wid >> 2, wc = wid & 3, fr = lane & 15, fq = lane >> 4;
    int Kop = g.K; asm volatile("" : "+s"(Kop));
    const int K = Kop, nt = K / BK;
    unsigned voffA[2], voffB[2];
#pragma unroll
    for (int i = 0; i < 2; ++i) { int R, C; stage_rc(tid * 16 + i * 8192, R, C); const int Rb = Epi::PERM ? ((R & ~31) + perm32(R & 31)) : R;
        voffA[i] = (unsigned)(R * K + C) * 2u; voffB[i] = (unsigned)(Rb * K + C) * 2u; }
    const size_t kstep = (size_t)(BK * 2);
    const size_t hstep = (size_t)HALF * K * 2;
    const size_t tstep = 2 * hstep;
    const unsigned ldsw = (unsigned)wid * 1024u;
    const int aoff = lds_byte(wr * 64 + fr, fq * 8), boff = lds_byte(wc * 32 + fr, fq * 8);
#define PG8_SA(b, h) (((b) * 2 + (h)) * HTB)
#define PG8_SB(b, h) ((4 + (b) * 2 + (h)) * HTB)
#define PG8_STAGE(bufoff, gbase, voff) do { _Pragma("unroll") for (int _i = 0; _i < 2; ++_i) \
        __builtin_amdgcn_global_load_lds((const unsigned*)((const char*)(gbase) + (voff)[_i]), (PG8_LAS unsigned*)(lds + (bufoff) + ldsw + _i * 8192), 16, 0, 0); } while (0)
#define PG8_LDA(dst, b, h) do { _Pragma("unroll") for (int m = 0; m < 4; ++m) _Pragma("unroll") for (int k = 0; k < 2; ++k) dst[m][k] = *(const PG8_LAS bf16x8*)(lds + PG8_SA(b, h) + aoff + m * 2048 + k * 1024); } while (0)
#define PG8_LDB(dst, b, h) do { _Pragma("unroll") for (int n = 0; n < 2; ++n) _Pragma("unroll") for (int k = 0; k < 2; ++k) dst[n][k] = *(const PG8_LAS bf16x8*)(lds + PG8_SB(b, h) + boff + n * 2048 + k * 1024); } while (0)
#define PG8_MMA(ai, bj, At, Bt) do { __builtin_amdgcn_s_setprio(1); _Pragma("unroll") for (int m = 0; m < 4; ++m) _Pragma("unroll") for (int n = 0; n < 2; ++n) _Pragma("unroll") for (int k = 0; k < 2; ++k) \
        acc[ai][bj][m][n] = __builtin_amdgcn_mfma_f32_16x16x32_bf16(Bt[n][k], At[m][k], acc[ai][bj][m][n], 0, 0, 0); __builtin_amdgcn_s_setprio(0); } while (0)
#define PG8_WAIT_V(n) asm volatile("s_waitcnt vmcnt(" #n ")" ::: "memory")
#define PG8_WAIT_L(n) asm volatile("s_waitcnt lgkmcnt(" #n ")" ::: "memory")
#define PG8_BAR __builtin_amdgcn_s_barrier()
#define PG8_SCHED __builtin_amdgcn_sched_barrier(0)
    Unit cur, nxt; int ui = 0;
    if (!S.next(0, cur)) return;
    f32x4 acc[2][2][4][2];
#pragma unroll
    for (int a = 0; a < 2; ++a)
#pragma unroll
        for (int b = 0; b < 2; ++b)
#pragma unroll
            for (int m = 0; m < 4; ++m)
#pragma unroll
                for (int n = 0; n < 2; ++n) acc[a][b][m][n] = (f32x4){0.f, 0.f, 0.f, 0.f};
    bf16x8 At[4][2], B0[2][2], B1[2][2];
    const char* cA = (const char*)g.A + (size_t)cur.pm * tstep; const char* cB = (const char*)g.Bt + (size_t)cur.pn * tstep;
    S.a_ready(cur);
    if constexpr (SP2) {
        PG8_STAGE(PG8_SB(0, 0), cB, voffB); PG8_STAGE(PG8_SB(0, 1), cB + hstep, voffB); PG8_STAGE(PG8_SA(0, 0), cA, voffA); PG8_STAGE(PG8_SA(0, 1), cA + hstep, voffA);
        if (wr == 1) PG8_BAR;
        PG8_WAIT_V(2); PG8_BAR;
        PG8_STAGE(PG8_SB(1, 0), cB + kstep, voffB); PG8_STAGE(PG8_SA(1, 0), cA + kstep, voffA); PG8_STAGE(PG8_SB(1, 1), cB + hstep + kstep, voffB);
        PG8_WAIT_V(6); PG8_BAR;
    } else {
        PG8_STAGE(PG8_SB(0, 0), cB, voffB); PG8_STAGE(PG8_SA(0, 0), cA, voffA); PG8_STAGE(PG8_SB(0, 1), cB + hstep, voffB); PG8_STAGE(PG8_SA(0, 1), cA + hstep, voffA);
        if (wr == 1) PG8_BAR;
        PG8_WAIT_V(4); PG8_BAR;
        PG8_STAGE(PG8_SB(1, 0), cB + kstep, voffB); PG8_STAGE(PG8_SA(1, 0), cA + kstep, voffA); PG8_STAGE(PG8_SB(1, 1), cB + hstep + kstep, voffB);
        PG8_WAIT_V(6); PG8_BAR;
    }
    for (;;) {
        const bool has_next = S.next(ui + 1, nxt);
        const char* nA = has_next ? (const char*)g.A + (size_t)nxt.pm * tstep : cA; const char* nB = has_next ? (const char*)g.Bt + (size_t)nxt.pn * tstep : cB;
        for (int t = 0; t < nt; t += 2) {
            const bool last = (t == nt - 2);
            const char* a1 = cA + (size_t)(t + 1) * kstep;
            const char* a2 = last ? nA : cA + (size_t)(t + 2) * kstep; const char* b2 = last ? nB : cB + (size_t)(t + 2) * kstep;
            const char* a3 = a2 + kstep; const char* b3 = b2 + kstep;
            if (last && has_next) S.a_ready(nxt);
            if constexpr (SP2) {
            PG8_LDB(B0, 0, 0); PG8_LDB(B1, 0, 1); PG8_SCHED; PG8_LDA(At, 0, 0); PG8_STAGE(PG8_SA(1, 1), a1 + hstep, voffA);
            PG8_WAIT_V(8); PG8_WAIT_L(0); PG8_BAR; PG8_MMA(0, 0, At, B0); PG8_MMA(0, 1, At, B1); PG8_BAR; PG8_SCHED;
            PG8_LDA(At, 0, 1); PG8_STAGE(PG8_SB(0, 0), b2, voffB); PG8_STAGE(PG8_SB(0, 1), b2 + hstep, voffB); PG8_STAGE(PG8_SA(0, 0), a2, voffA);
            PG8_WAIT_V(8); PG8_WAIT_L(0); PG8_BAR; PG8_MMA(1, 0, At, B0); PG8_MMA(1, 1, At, B1); PG8_BAR; PG8_SCHED;
            PG8_LDB(B0, 1, 0); PG8_LDB(B1, 1, 1); PG8_SCHED; PG8_LDA(At, 1, 0); PG8_STAGE(PG8_SA(0, 1), a2 + hstep, voffA);
            PG8_WAIT_V(8); PG8_WAIT_L(0); PG8_BAR; PG8_MMA(0, 0, At, B0); PG8_MMA(0, 1, At, B1); PG8_BAR; PG8_SCHED;
            PG8_LDA(At, 1, 1); PG8_STAGE(PG8_SB(1, 0), b3, voffB); PG8_STAGE(PG8_SB(1, 1), b3 + hstep, voffB); PG8_STAGE(PG8_SA(1, 0), a3, voffA);
            PG8_WAIT_V(8); PG8_WAIT_L(0); PG8_BAR; PG8_MMA(1, 0, At, B0); PG8_MMA(1, 1, At, B1); PG8_BAR; PG8_SCHED;
            } else {
            PG8_LDB(B0, 0, 0); PG8_SCHED; PG8_LDA(At, 0, 0); PG8_STAGE(PG8_SA(1, 1), a1 + hstep, voffA);
            PG8_WAIT_L(8); PG8_BAR; PG8_WAIT_L(0); PG8_MMA(0, 0, At, B0); PG8_BAR; PG8_SCHED;
            PG8_LDB(B1, 0, 1); PG8_STAGE(PG8_SB(0, 0), b2, voffB);
            PG8_BAR; PG8_WAIT_L(0); PG8_MMA(0, 1, At, B1); PG8_BAR;
            PG8_LDA(At, 0, 1); PG8_STAGE(PG8_SA(0, 0), a2, voffA);
            PG8_BAR; PG8_WAIT_L(0); PG8_MMA(1, 0, At, B0); PG8_BAR; PG8_SCHED;
            PG8_STAGE(PG8_SB(0, 1), b2 + hstep, voffB);
            PG8_WAIT_V(6); PG8_BAR; PG8_MMA(1, 1, At, B1); PG8_BAR;
            PG8_LDB(B0, 1, 0); PG8_SCHED; PG8_LDA(At, 1, 0); PG8_STAGE(PG8_SA(0, 1), a2 + hstep, voffA);
            PG8_WAIT_L(8); PG8_BAR; PG8_WAIT_L(0); PG8_MMA(0, 0, At, B0); PG8_BAR; PG8_SCHED;
            PG8_LDB(B1, 1, 1); PG8_STAGE(PG8_SB(1, 0), b3, voffB);
            PG8_BAR; PG8_WAIT_L(0); PG8_MMA(0, 1, At, B1); PG8_BAR;
            PG8_LDA(At, 1, 1); PG8_STAGE(PG8_SA(1, 0), a3, voffA);
            PG8_BAR; PG8_WAIT_L(0); PG8_MMA(1, 0, At, B0); PG8_BAR; PG8_SCHED;
            PG8_STAGE(PG8_SB(1, 1), b3 + hstep, voffB);
            PG8_WAIT_V(6); PG8_BAR; PG8_MMA(1, 1, At, B1); PG8_BAR;
            }
        }
        if constexpr (ALIGN_EPI) { if (wr == 0) PG8_BAR; }
        if constexpr (!Epi::AFTER_DRAIN) { E(acc, cur, wr, wc, fr, fq); S.done(cur); }
        if (!has_next) break;
#pragma unroll
        for (int a = 0; a < 2; ++a)
#pragma unroll
            for (int b = 0; b < 2; ++b)
#pragma unroll
                for (int m = 0; m < 4; ++m)
#pragma unroll
                    for (int n = 0; n < 2; ++n) acc[a][b][m][n] = (f32x4){0.f, 0.f, 0.f, 0.f};
        cur = nxt; cA = nA; cB = nB; ++ui;
        if constexpr (ALIGN_EPI) { if (wr == 1) PG8_BAR; }
    }
    PG8_WAIT_V(0);
    if constexpr (!ALIGN_EPI) { if (wr == 0) PG8_BAR; }
    PG8_BAR;
    if constexpr (Epi::AFTER_DRAIN) { E.fused(acc, cur, wr, wc, fr, fq, lds, wid, lane); S.done(cur); }
#undef PG8_SA
#undef PG8_SB
#undef PG8_STAGE
#undef PG8_LDA
#undef PG8_LDB
#undef PG8_MMA
#undef PG8_WAIT_V
#undef PG8_WAIT_L
#undef PG8_BAR
#undef PG8_SCHED
}
}

constexpr int NWAVES = 8, NTHR = 512;
constexpr int BATCH = 2, SEQ = 8192, T = BATCH * SEQ, D = 1024, CHUNK = 64, NCH = SEQ / CHUNK;
constexpr int RH = 4, MH = 4, DFF = 2816, INC = 2496, NZ = 2560, NQM = 768, NKV = 1024, NGU = 2 * DFF, DPLE = 256;
constexpr float QSCALE = 0.07216878364870322f * 1.4426950408889634f;
#ifndef MK_N_LAUNCHES
#define MK_N_LAUNCHES 1
#endif
#ifndef MK_DUP
#define MK_DUP -1
#endif
#ifndef OPT_W1
#define OPT_W1 1
#endif
#ifndef OPT_PROJ6
#define OPT_PROJ6 1
#endif
constexpr int PER_PHASE = 10;
constexpr int N_LAUNCHES = MK_N_LAUNCHES;

constexpr size_t MiB = 1u << 20;
constexpr size_t WS_CTL = 0, CTL_ZERO_BYTES = 1 * MiB;
constexpr size_t WS_SSQ = 256 * 1024;
constexpr size_t WS_WIN = 1 * MiB, WS_WUQ = 6 * MiB, WS_WUKV = 6 * MiB + 512 * 1024, WS_WO = 7 * MiB, WS_WGU = 9 * MiB, WS_WD = 20 * MiB, WS_WPG = 26 * MiB, WS_WPP = 28 * MiB;
constexpr size_t WS_RC = 29 * MiB, WS_RS = 33 * MiB, WS_MC = 37 * MiB, WS_MS = 39 * MiB;
constexpr size_t WS_XN = 42 * MiB;
constexpr size_t WS_RQ = 74 * MiB, WS_RK = 90 * MiB, WS_RV = 106 * MiB, WS_RG = 122 * MiB, WS_QM = 138 * MiB;
constexpr size_t WS_ACT = 74 * MiB;
constexpr size_t WS_CQ = 162 * MiB, WS_CKV = 170 * MiB, WS_KPE = 174 * MiB;
constexpr size_t WS_KVB = 176 * MiB;
constexpr size_t WS_CAT = 208 * MiB;
constexpr size_t WS_PB = 240 * MiB;
constexpr size_t WS_END = 248 * MiB;
constexpr int CW_TMO = 0, CW_CODE = 1, CW_BAR = 4096;

constexpr int RING_OFF = 0, RING_BYTES = 131072;
constexpr int LDS_BYTES = 163840;
constexpr int LDSCTL_OFF = LDS_BYTES - 1024, MISC_OFF = LDSCTL_OFF + 320;
#define GAS __attribute__((address_space(1)))
#define LAS __attribute__((address_space(3)))
typedef unsigned short bf16;
typedef unsigned v4u __attribute__((ext_vector_type(4)));
typedef float f32x4 __attribute__((ext_vector_type(4)));
typedef short bf16x8 __attribute__((ext_vector_type(8)));
typedef GAS unsigned gu32;
typedef GAS unsigned long long gu64;
#define RLX_AGENT __ATOMIC_RELAXED, __HIP_MEMORY_SCOPE_AGENT
#define LDS_WAIT() asm volatile("s_waitcnt lgkmcnt(0)" ::: "memory")
#define VM_WAIT() asm volatile("s_waitcnt vmcnt(0)" ::: "memory")
__device__ __forceinline__ unsigned long long rt() { return __builtin_amdgcn_s_memrealtime(); }
__device__ __forceinline__ unsigned f2bf(float f) { unsigned u = __builtin_bit_cast(unsigned, f); return (u + 0x7fffu + ((u >> 16) & 1u)) >> 16; }
__device__ __forceinline__ unsigned pk2(float lo, float hi) { return f2bf(lo) | (f2bf(hi) << 16); }

#define XB_TMO      128
#define XB_XCNT(j)  (256  + 64 * (j))
#define XB_XSUB(j)  (1280 + 64 * (j))
#define XB_XGEN(j)  (2304 + 64 * (j))
#define XB_TOP      3328
#define XB_TOPGEN   3392
#define XCD_BAR_WORDS 3456
#define XB_SPIN_CAP (1u << 18)

__device__ __forceinline__ unsigned xb_ld(unsigned* p)              { return __hip_atomic_load(p, __ATOMIC_RELAXED, __HIP_MEMORY_SCOPE_AGENT); }
__device__ __forceinline__ unsigned xb_add(unsigned* p, unsigned v) { return __hip_atomic_fetch_add(p, v, __ATOMIC_RELAXED, __HIP_MEMORY_SCOPE_AGENT); }
__device__ __forceinline__ unsigned xb_xcc_id() { return (unsigned)__builtin_amdgcn_s_getreg((3 << 11) | 20) & 0xFu; }
#define XB_SPIN(cond, bar) do { unsigned _sp = 0; while (cond) { __builtin_amdgcn_s_sleep(1); \
    if ((++_sp & 255u) == 0u) { if (xb_ld(&(bar)[XB_TMO])) break; if (_sp > XB_SPIN_CAP) { atomicAdd(&(bar)[XB_TMO], 1u); break; } } } } while (0)

struct XcdBarrier {
    unsigned* bar; unsigned x;
    volatile LAS unsigned* st;
};

__device__ __forceinline__ XcdBarrier xcd_barrier_post(unsigned* bar, volatile LAS unsigned* st, int tid_) {
    XcdBarrier b; b.bar = bar; b.x = xb_xcc_id(); b.st = st;
    if (tid_ == 0) (void)xb_add(&bar[XB_XCNT(b.x)], 1u);
    return b;
}
__device__ __forceinline__ void xcd_barrier_complete(unsigned* bar, unsigned x, unsigned& nloc, unsigned& nx) {
    const unsigned G = gridDim.x * gridDim.y * gridDim.z;
    unsigned sum, cnt, mine, sp = 0u;
    for (;;) {
        sum = 0u; cnt = 0u; mine = 0u;
#pragma unroll
        for (unsigned j = 0; j < 16; ++j) { const unsigned c = xb_ld(&bar[XB_XCNT(j)]); sum += c; cnt += (c > 0u) ? 1u : 0u; mine = (j == x) ? c : mine; }
        if (sum == G) break;
        __builtin_amdgcn_s_sleep(1);
        if ((++sp & 255u) == 0u) { if (xb_ld(&bar[XB_TMO])) break; if (sp > XB_SPIN_CAP) { atomicAdd(&bar[XB_TMO], 1u); break; } }
    }
    nloc = mine > 0u ? mine : 1u; nx = cnt > 0u ? cnt : 1u;
}

__device__ __forceinline__ void xcd_barrier(const XcdBarrier& b, int tid_) {
    asm volatile("s_waitcnt vmcnt(0)" ::: "memory");
    __syncthreads();
    if (tid_ == 0) {
        unsigned* bar = b.bar;
        __builtin_amdgcn_s_waitcnt(0);
        unsigned nloc = b.st[0], nx = b.st[1];
        if (nloc == 0u) { xcd_barrier_complete(bar, b.x, nloc, nx); b.st[0] = nloc; b.st[1] = nx; }
        const unsigned old = xb_add(&bar[XB_XSUB(b.x)], 1u);
        const unsigned gen = old / nloc;
        if (old + 1u == (gen + 1u) * nloc) {
            __builtin_amdgcn_fence(__ATOMIC_RELEASE, "agent");
            asm volatile("s_waitcnt vmcnt(0)" ::: "memory");
            const unsigned og = xb_add(&bar[XB_TOP], 1u);
            const unsigned tg = og / nx;
            if (og + 1u == (tg + 1u) * nx) xb_add(&bar[XB_TOPGEN], 1u);
            else XB_SPIN(xb_ld(&bar[XB_TOPGEN]) == tg, bar);
            __builtin_amdgcn_fence(__ATOMIC_ACQUIRE, "agent");
            xb_add(&bar[XB_XGEN(b.x)], 1u);
            asm volatile("s_waitcnt vmcnt(0)" ::: "memory");
        } else {
            XB_SPIN(xb_ld(&bar[XB_XGEN(b.x)]) == gen, bar);
            __builtin_amdgcn_fence(__ATOMIC_ACQUIRE, "agent");
            asm volatile("s_waitcnt vmcnt(0)" ::: "memory");
        }
    }
    __syncthreads();
}

struct Frame {
    LAS unsigned char* lds;
    volatile LAS unsigned* MISC;
    gu32* ctl;
    int tid, lane, wave, vcu, G;
};
__device__ __forceinline__ float bf2f(bf16 v) { return __uint_as_float((unsigned)v << 16); }
__device__ __forceinline__ float wave_sum(float v) {
#pragma unroll
    for (int o = 1; o < 64; o <<= 1) v += __shfl_xor(v, o);
    return v;
}
__device__ __forceinline__ float ret_logg(int h) { return log1pf(-exp2f(-5.0f - (float)h)); }

struct PArgs { const float *x, *p; const int* pos; const float *mix_g, *w_in, *qn_g, *w_uq, *kvn_g, *w_ukv, *w_o, *ffn_g, *w_g, *w_u, *w_d, *ple_g, *w_pg, *w_pp, *fin_g; };
struct Args { PArgs in; float* out; unsigned char* ws; int ph_lo, ph_hi, li, pad; };
__device__ __forceinline__ unsigned char* fresh_ws() { return *(unsigned char* const volatile __attribute__((address_space(4)))*)((const __attribute__((address_space(4))) char*)__builtin_amdgcn_kernarg_segment_ptr() + offsetof(Args, ws)); }
__device__ __forceinline__ const float* p0_src(const PArgs& a, int kind, int n, float& cs) {
    cs = 1.0f;
    switch (kind) {
    case 0: {
        if (n < 1024) { const int g = n & 127; if (n >= 512) cs = 0.08838834764831845f; return a.w_in + (n & ~127) + (g >> 1) + 64 * (g & 1); }
        if (n < 2432) return a.w_in + n;
        if (n < 2496) { const int g = n - 2432; return a.w_in + 2432 + (g >> 1) + 32 * (g & 1); }
        return nullptr; }
    case 1: {
        if (n < 512) return a.w_uq + (n >> 7) * 192 + (n & 127);
        const int r = n - 512, g = r & 63; return a.w_uq + (r >> 6) * 192 + 128 + (g >> 1) + 32 * (g & 1); }
    case 2: return a.w_ukv + n;
    case 3: return a.w_o + n;
    case 4: { const int t = n >> 8, r = n & 255; return (r < 128 ? a.w_g : a.w_u) + 128 * t + (r & 127); }
    case 5: return a.w_d + n;
    case 6: return a.w_pg + n;
    default: return a.w_pp + n;
    }
}
__device__ __forceinline__ void p0_item(const PArgs& a, int kind, int ldw, int K, const float* gk, bf16* WT, LAS float* scr, int item, int nblk, int lane) {
    const int kb = item / nblk, nb = item % nblk, k0 = 64 * kb, n0 = 32 * nb;
    float cs; const float* src = p0_src(a, kind, n0 + (lane & 31), cs);
    float vv[32];
#pragma unroll
    for (int i = 0; i < 32; ++i) vv[i] = src ? src[(size_t)(k0 + 2 * i + (lane >> 5)) * ldw] : 0.f;
    if (gk) {
#pragma unroll
        for (int i = 0; i < 32; ++i) vv[i] *= gk[k0 + 2 * i + (lane >> 5)]; }
#pragma unroll
    for (int i = 0; i < 32; ++i) scr[(2 * i + (lane >> 5)) * 33 + (lane & 31)] = vv[i] * cs;
    LDS_WAIT(); asm volatile("" ::: "memory");
    const int c = lane & 7;
#pragma unroll
    for (int j = 0; j < 4; ++j) { const int n = (lane >> 3) + 8 * j; const LAS float* s = scr + (8 * c) * 33 + n;
        v4u o; o.x = pk2(s[0 * 33], s[1 * 33]); o.y = pk2(s[2 * 33], s[3 * 33]); o.z = pk2(s[4 * 33], s[5 * 33]); o.w = pk2(s[6 * 33], s[7 * 33]);
        *(GAS v4u*)(WT + (size_t)(n0 + n) * K + k0 + 8 * c) = o; }
    LDS_WAIT(); asm volatile("" ::: "memory");
}
__device__ __forceinline__ void p0_weights(Frame& F, const PArgs& a, unsigned char* ws, int m_lo, int m_hi, int gw, int NGW) {
    LAS float* scr = (LAS float*)(F.lds + RING_OFF + F.wave * 16384);
    constexpr int NMAT = 8;
    const int Ks[NMAT] = {1024, 256, 128, 1024, 1024, 2816, 1024, 256}, Ns[NMAT] = {NZ, NQM, NKV, 1024, NGU, 1024, 1024, 1024}, LDW[NMAT] = {INC, NQM, NKV, 1024, DFF, 1024, 1024, 1024};
    const size_t OFF[NMAT] = {WS_WIN, WS_WUQ, WS_WUKV, WS_WO, WS_WGU, WS_WD, WS_WPG, WS_WPP};
    int base = 0;
#pragma unroll
    for (int k = 0; k < NMAT; ++k) {
        if (k < m_lo || k >= m_hi) continue;
        const int nblk = Ns[k] / 32, nit = (Ks[k] / 64) * nblk;
        const float* gk = k == 1 ? a.qn_g : k == 2 ? a.kvn_g : k == 4 ? a.ffn_g : k == 6 ? a.ple_g : nullptr;
        int first = gw - (base % NGW); if (first < 0) first += NGW;
        for (int it = first; it < nit; it += NGW) p0_item(a, k, LDW[k], Ks[k], gk, (bf16*)(ws + OFF[k]), scr, it, nblk, F.lane);
        base += nit;
    }
}
__device__ __forceinline__ void p0_prologue(Frame& F, const PArgs& a, unsigned char* ws) {
    const int gw = F.vcu * NWAVES + F.wave, NGW = F.G * NWAVES;
    p0_weights(F, a, ws, 0, (OPT_W1 && F.G == 256) ? 3 : 8, gw, NGW);
    bf16* XN = (bf16*)(ws + WS_XN);
    { const GAS f32x4* gr = (const GAS f32x4*)a.mix_g + F.lane; f32x4 gg[4];
#pragma unroll
      for (int j = 0; j < 4; ++j) gg[j] = gr[64 * j];
      for (int m0 = gw * 2; m0 < T; m0 += NGW * 2) {
        f32x4 v[2][4]; float s[2] = {0.f, 0.f};
#pragma unroll
        for (int q = 0; q < 2; ++q)
#pragma unroll
            for (int j = 0; j < 4; ++j) v[q][j] = ((const GAS f32x4*)(a.x + (size_t)(m0 + q) * D) + F.lane)[64 * j];
#pragma unroll
        for (int q = 0; q < 2; ++q) {
#pragma unroll
            for (int j = 0; j < 4; ++j) s[q] += (v[q][j].x * v[q][j].x + v[q][j].y * v[q][j].y) + (v[q][j].z * v[q][j].z + v[q][j].w * v[q][j].w);
            const float rs = 1.0f / sqrtf(wave_sum(s[q]) * (1.0f / D) + 1e-6f);
            GAS unsigned long long* o8 = (GAS unsigned long long*)(XN + (size_t)(m0 + q) * D) + F.lane;
#pragma unroll
            for (int j = 0; j < 4; ++j) o8[64 * j] = (unsigned long long)pk2(v[q][j].x * rs * gg[j].x, v[q][j].y * rs * gg[j].y) | ((unsigned long long)pk2(v[q][j].z * rs * gg[j].z, v[q][j].w * rs * gg[j].w) << 32); } } }
    { const int gt = F.vcu * NTHR + F.tid, NGT = F.G * NTHR; bf16* PB = (bf16*)(ws + WS_PB);
      for (int i = gt; i < T * DPLE / 4; i += 4 * NGT) { f32x4 v[4];
#pragma unroll
          for (int q = 0; q < 4; ++q) v[q] = ((const GAS f32x4*)a.p)[i + q * NGT];
#pragma unroll
          for (int q = 0; q < 4; ++q) ((GAS unsigned long long*)PB)[i + q * NGT] = (unsigned long long)pk2(v[q].x, v[q].y) | ((unsigned long long)pk2(v[q].z, v[q].w) << 32); } }
    { const int gt = F.vcu * NTHR + F.tid, NGT = F.G * NTHR; float* RC = (float*)(ws + WS_RC); float* RS = (float*)(ws + WS_RS); float* MC = (float*)(ws + WS_MC); float* MS = (float*)(ws + WS_MS);
      for (int i = gt; i < T * 64; i += NGT) { const int t = i >> 6, k = i & 63; const double rev = (double)a.pos[t] * (double)expf(-logf(10000.0f) * (float)k / 64.0f) * 0.15915494309189535; const float r = (float)(rev - rint(rev));
          RC[i] = __builtin_amdgcn_cosf(r); RS[i] = __builtin_amdgcn_sinf(r); }
      for (int i = gt; i < T * 32; i += NGT) { const int t = i >> 5, k = i & 31; const double rev = (double)a.pos[t] * (double)expf(-logf(10000.0f) * (float)k / 32.0f) * 0.15915494309189535; const float r = (float)(rev - rint(rev));
          MC[i] = __builtin_amdgcn_cosf(r); MS[i] = __builtin_amdgcn_sinf(r); } }
}

__device__ __forceinline__ void ret_kv_simple(Frame& F, const bf16* RK, const bf16* RV, bf16* KVS) {
    LAS float* ks = (LAS float*)F.lds; LAS float* vs = ks + 64 * 128;
    for (int blk = F.vcu; blk < BATCH * NCH * RH; blk += F.G) {
        const int h = blk % RH, n = (blk / RH) % NCH, b = blk / (RH * NCH);
        const float lg = ret_logg(h); const size_t t0 = (size_t)b * SEQ + (size_t)n * CHUNK;
        for (int idx = F.tid; idx < 64 * 128; idx += NTHR) { const int j = idx >> 7, d = idx & 127;
            ks[idx] = bf2f(RK[(t0 + j) * 512 + h * 128 + d]) * expf(lg * (float)(CHUNK - 1 - j)); vs[idx] = bf2f(RV[(t0 + j) * 512 + h * 128 + d]); }
        __syncthreads();
        const int d = F.tid >> 2, e0 = (F.tid & 3) * 32;
        float acc[32];
#pragma unroll
        for (int e = 0; e < 32; ++e) acc[e] = 0.f;
        for (int j = 0; j < 64; ++j) { const float kd = ks[j * 128 + d];
#pragma unroll
            for (int e = 0; e < 32; ++e) acc[e] += kd * vs[j * 128 + e0 + e]; }
        GAS unsigned* o = (GAS unsigned*)(KVS + (size_t)blk * 16384 + d * 128 + e0);
#pragma unroll
        for (int e = 0; e < 16; ++e) o[e] = pk2(acc[2 * e], acc[2 * e + 1]);
        __syncthreads();
    }
}
__device__ __forceinline__ void ret_scan_simple(Frame& F, bf16* KVS) {
    for (int gid = F.vcu * NTHR + F.tid; gid < BATCH * RH * 16384; gid += F.G * NTHR) {
        const int de = gid & 16383, h = (gid >> 14) % RH, b = gid >> 16;
        const float c = expf(ret_logg(h) * (float)CHUNK); float S = 0.f;
        for (int n = 0; n < NCH; ++n) { bf16* p = KVS + ((size_t)((b * NCH + n) * RH + h)) * 16384 + de; const float kv = bf2f(*p); *p = (bf16)f2bf(S); S = c * S + kv; }
    }
}
__device__ __forceinline__ void ret_out_simple(Frame& F, const bf16* RQ, const bf16* RK, const bf16* RV, const bf16* RG, const bf16* PREV, bf16* CAT) {
    LAS float* qs = (LAS float*)F.lds; LAS float* ks = qs + 64 * 129; LAS float* vs = ks + 64 * 129; LAS float* ss = vs + 64 * 128;
    for (int blk = F.vcu; blk < BATCH * NCH * RH; blk += F.G) {
        const int h = blk % RH, n = (blk / RH) % NCH, b = blk / (RH * NCH);
        const float lg = ret_logg(h); const size_t t0 = (size_t)b * SEQ + (size_t)n * CHUNK;
        for (int idx = F.tid; idx < 64 * 128; idx += NTHR) { const int j = idx >> 7, d = idx & 127; const size_t g = (t0 + j) * 512 + h * 128 + d;
            qs[j * 129 + d] = bf2f(RQ[g]); ks[j * 129 + d] = bf2f(RK[g]); vs[j * 128 + d] = bf2f(RV[g]); }
        __syncthreads();
        { const int i = F.tid >> 3, jq = F.tid & 7;
          for (int jj = 0; jj < 8; ++jj) { const int j = jq * 8 + jj; float dot = 0.f;
              for (int d = 0; d < 128; ++d) dot += qs[i * 129 + d] * ks[j * 129 + d];
              const int dij = i > j ? i - j : j - i; ss[i * 65 + j] = dot * expf(lg * (float)dij); } }
        __syncthreads();
        const int e = F.tid & 127, ih = F.tid >> 7;
        float acc[16], acc2[16];
#pragma unroll
        for (int ii = 0; ii < 16; ++ii) { acc[ii] = 0.f; acc2[ii] = 0.f; }
        for (int j = 0; j < 64; ++j) { const float vv = vs[j * 128 + e];
#pragma unroll
            for (int ii = 0; ii < 16; ++ii) acc[ii] += ss[(ih * 16 + ii) * 65 + j] * vv; }
        const bf16* pv = PREV + (size_t)blk * 16384;
        for (int d = 0; d < 128; ++d) { const float p = bf2f(pv[d * 128 + e]);
#pragma unroll
            for (int ii = 0; ii < 16; ++ii) acc2[ii] += qs[(ih * 16 + ii) * 129 + d] * p; }
        __syncthreads();
        LAS float* os = qs;
#pragma unroll
        for (int ii = 0; ii < 16; ++ii) { const int i = ih * 16 + ii; os[i * 128 + e] = acc[ii] + expf(lg * (float)(i + 1)) * acc2[ii]; }
        __syncthreads();
        for (int r = 0; r < 8; ++r) { const int i = F.wave * 8 + r;
            const float a0 = os[i * 128 + F.lane], a1 = os[i * 128 + F.lane + 64];
            const float mu = wave_sum(a0 + a1) * (1.0f / 128.0f); const float d0 = a0 - mu, d1 = a1 - mu;
            const float rs = 1.0f / sqrtf(wave_sum(d0 * d0 + d1 * d1) * (1.0f / 128.0f) + 1e-5f);
            const float g0 = bf2f(RG[(t0 + i) * 512 + h * 128 + F.lane]), g1 = bf2f(RG[(t0 + i) * 512 + h * 128 + F.lane + 64]);
            bf16* orow = CAT + (t0 + i) * D + h * 128;
            orow[F.lane] = (bf16)f2bf(d0 * rs * (g0 / (1.0f + expf(-g0)))); orow[F.lane + 64] = (bf16)f2bf(d1 * rs * (g1 / (1.0f + expf(-g1)))); }
        __syncthreads();
    }
}
__device__ __forceinline__ void attn_simple(Frame& F, const bf16* QM, const bf16* KVB, const bf16* KPE, bf16* CAT) {
    LAS float* Qs = (LAS float*)F.lds; LAS float* Ks = Qs + 64 * 193; LAS float* Vs = Ks + 64 * 193; LAS float* Ss = Vs + 64 * 128;
    for (int i = 0;; ++i) {
        const int L = i * F.G + F.vcu; if (L >= BATCH * MH * NCH) break;
        const int bh = L & 7, x = (L >> 3) & 31, rnd = L >> 8; const int c = (rnd & 1) ? (rnd * 32 + x) : (rnd * 32 + 31 - x);
        const int h = bh & 3, b = bh >> 2;
        const size_t tq0 = (size_t)b * SEQ + (size_t)c * CHUNK;
        __syncthreads();
        for (int idx = F.tid; idx < 64 * 192; idx += NTHR) { const int r = idx / 192, d = idx % 192;
            Qs[r * 193 + d] = bf2f(d < 128 ? QM[(tq0 + r) * NQM + h * 128 + d] : QM[(tq0 + r) * NQM + 512 + h * 64 + (d - 128)]); }
        const int qi = F.tid >> 3, part = F.tid & 7;
        float m = -INFINITY, l = 0.f; float acc[16];
#pragma unroll
        for (int e = 0; e < 16; ++e) acc[e] = 0.f;
        for (int kt = 0; kt <= c; ++kt) {
            __syncthreads();
            const size_t tk0 = (size_t)b * SEQ + (size_t)kt * CHUNK;
            for (int idx = F.tid; idx < 64 * 192; idx += NTHR) { const int j = idx / 192, d = idx % 192;
                Ks[j * 193 + d] = bf2f(d < 128 ? KVB[(tk0 + j) * NKV + h * 256 + d] : KPE[(tk0 + j) * 64 + (d - 128)]); }
            for (int idx = F.tid; idx < 64 * 128; idx += NTHR) { const int j = idx >> 7, e = idx & 127; Vs[idx] = bf2f(KVB[(tk0 + j) * NKV + h * 256 + 128 + e]); }
            __syncthreads();
            for (int jj = 0; jj < 8; ++jj) { const int j = part * 8 + jj; float dot = 0.f;
                for (int d = 0; d < 192; ++d) dot += Qs[qi * 193 + d] * Ks[j * 193 + d];
                Ss[qi * 65 + j] = dot; }
            __syncthreads();
            float mx = m;
            for (int j = 0; j < 64; ++j) mx = fmaxf(mx, Ss[qi * 65 + j]);
            const float alpha = exp2f(m - mx); l *= alpha;
#pragma unroll
            for (int e = 0; e < 16; ++e) acc[e] *= alpha;
            for (int j = 0; j < 64; ++j) { const float p = exp2f(Ss[qi * 65 + j] - mx); l += p; const LAS float* vr = Vs + j * 128 + part * 16;
#pragma unroll
                for (int e = 0; e < 16; ++e) acc[e] += p * vr[e]; }
            m = mx;
        }
        const float il = 1.0f / l;
        GAS unsigned* o = (GAS unsigned*)(CAT + (tq0 + qi) * D + 512 + h * 128 + part * 16);
#pragma unroll
        for (int e = 0; e < 8; ++e) o[e] = pk2(acc[2 * e] * il, acc[2 * e + 1] * il);
    }
    __syncthreads();
}
__device__ __forceinline__ void final_norm(Frame& F, float* X, const float* ssq, const float* g) {
    const int gw = F.vcu * NWAVES + F.wave, NGW = F.G * NWAVES;
    for (int m = gw; m < T; m += NGW) {
        const float rs = 1.0f / sqrtf(ssq[m] * (1.0f / D) + 1e-6f);
        GAS f32x4* xr = (GAS f32x4*)(X + (size_t)m * D) + F.lane; const GAS f32x4* gr = (const GAS f32x4*)g + F.lane;
#pragma unroll
        for (int j = 0; j < 4; ++j) { const f32x4 v = xr[64 * j], gg = gr[64 * j]; xr[64 * j] = (f32x4){v.x * rs * gg.x, v.y * rs * gg.y, v.z * rs * gg.z, v.w * rs * gg.w}; }
    }
}


namespace att {
typedef float f32x16 __attribute__((ext_vector_type(16)));
typedef short s16x4 __attribute__((ext_vector_type(4)));
typedef short v4i16_t __attribute__((ext_vector_type(4)));
constexpr int KB_OFF = 0, KSLOT = 24576, VB_OFF = 73728, VSLOT = 16384, QB_OFF = 122880, QSLOT = 8192, MERGE_OFF = 0, STAGE_OFF = 65536, WSF_OFF = 155648, ST_OFF = 157696;
constexpr float THR = 8.0f;
__device__ __forceinline__ void glds16(const void* gsrc, unsigned lds_dst) { unsigned keep;
    asm volatile("s_mov_b32 %0, m0\n\ts_mov_b32 m0, %2\n\ts_nop 0\n\tglobal_load_lds_dwordx4 %1, off\n\ts_mov_b32 m0, %0" : "=&s"(keep) : "v"(gsrc), "s"(lds_dst) : "memory"); }
template <int IMM> __device__ __forceinline__ void glds16s(unsigned voff, const void* sbase, unsigned lds_dst) { unsigned keep;
    asm volatile("s_mov_b32 %0, m0\n\ts_mov_b32 m0, %3\n\ts_nop 0\n\tglobal_load_lds_dwordx4 %1, %2 offset:%c4\n\ts_mov_b32 m0, %0" : "=&s"(keep) : "v"(voff), "s"(sbase), "s"(lds_dst), "i"(IMM) : "memory"); }
__device__ __forceinline__ int crow(int r, int hi) { return (r & 3) + 8 * (r >> 2) + 4 * hi; }
__device__ __forceinline__ s16x4 vtr(const LAS char* p) { return __builtin_bit_cast(s16x4, __builtin_amdgcn_ds_read_tr16_b64_v4i16((LAS v4i16_t*)p)); }
__device__ __forceinline__ unsigned cvtpk(float lo, float hi) { unsigned r; asm volatile("v_cvt_pk_bf16_f32 %0, %1, %2" : "=v"(r) : "v"(lo), "v"(hi)); return r; }
__device__ __forceinline__ float swap_max(float m) { auto rr = __builtin_amdgcn_permlane32_swap(__float_as_uint(m), __float_as_uint(m), false, false); return fmaxf(__uint_as_float(rr[0]), __uint_as_float(rr[1])); }
__device__ __forceinline__ float swap_sum(float m) { auto rr = __builtin_amdgcn_permlane32_swap(__float_as_uint(m), __float_as_uint(m), false, false); return __uint_as_float(rr[0]) + __uint_as_float(rr[1]); }
#define ATT_WAIT_BAR() asm volatile("s_waitcnt vmcnt(0) lgkmcnt(0)\n\ts_barrier" ::: "memory")

__device__ __forceinline__ void attn_unit(Frame& F, int b, int h, int qb_, const bf16* QM, const bf16* KVB, const bf16* KPE, bf16* CAT) {
    int lane; asm volatile("v_mbcnt_lo_u32_b32 %0, -1, 0\n\tv_mbcnt_hi_u32_b32 %0, -1, %0" : "=v"(lane));
    const int r32 = lane & 31, hi = lane >> 5, w = F.wave, g = w >> 2, wq = w & 3;
    const LAS char* L = (const LAS char*)F.lds;
    const unsigned lds0 = (unsigned)(uintptr_t)F.lds;
    const size_t tb = (size_t)b * SEQ;
    const int NT = 2 * qb_ + 2;
    const bf16* kbase0 = KVB + ((size_t)h * T + tb) * 256;
    const bf16* rbase0 = KPE + tb * 64;
    const int krow = 8 * w + (lane >> 3);
    const unsigned voffK = (unsigned)(krow * 256 + (((lane & 7) ^ (lane >> 4) ^ (4 * (w & 1))) * 8)) * 2u;
    const unsigned voffR = (unsigned)(krow * 64 + (((lane & 7) ^ (lane >> 4) ^ (4 * (w & 1))) * 8)) * 2u;
    const unsigned voffV = (unsigned)(krow * 256 + 128 + (((lane & 7) ^ (4 * ((lane >> 4) & 1))) * 8)) * 2u;
#define ATT_KBASE(tt, slot) const unsigned kd = (unsigned)__builtin_amdgcn_readfirstlane(lds0 + KB_OFF + (slot) * KSLOT + w * 1024); const bf16* kbs = kbase0 + (size_t)(tt) * 64 * 256
#define ATT_K(tt, slot) do { ATT_KBASE(tt, slot); glds16s<0>(voffK, kbs, kd); glds16s<0>(voffK, kbs + 64, kd + 8192); glds16s<0>(voffR, rbase0 + (size_t)(tt) * 64 * 64, kd + 16384); } while (0)
#define ATT_KP(i, hh) do { const int _t = (hh) + 2; if (_t < NT) { ATT_KBASE(_t, (unsigned)_t % 3u); \
        if ((i) == 0) glds16s<0>(voffK, kbs, kd); else if ((i) == 1) glds16s<0>(voffK, kbs + 64, kd + 8192); else glds16s<0>(voffR, rbase0 + (size_t)_t * 64 * 64, kd + 16384); } } while (0)
#define ATT_VP(i, hh) do { const int _t = (hh) + 1; if (_t < NT) { const unsigned vd = (unsigned)__builtin_amdgcn_readfirstlane(lds0 + VB_OFF + ((unsigned)_t % 3u) * VSLOT + w * 1024); const bf16* vbs = kbase0 + (size_t)_t * 64 * 256; \
        if ((i) == 0) glds16s<0>(voffV, vbs, vd); else glds16s<0>(voffV, vbs + 64, vd + 8192); } } while (0)
#define ATT_ALLP(hh) do { ATT_VP(0, hh); ATT_VP(1, hh); ATT_KP(0, hh); ATT_KP(1, hh); ATT_KP(2, hh); } while (0)
#define ATT_CLOSE(hh) do { if ((hh) + 2 < NT) asm volatile("s_waitcnt vmcnt(5) lgkmcnt(0)\n\ts_barrier" ::: "memory"); \
        else if ((hh) + 1 < NT) asm volatile("s_waitcnt vmcnt(2) lgkmcnt(0)\n\ts_barrier" ::: "memory"); \
        else asm volatile("s_waitcnt vmcnt(0) lgkmcnt(0)\n\ts_barrier" ::: "memory"); } while (0)
    ATT_K(0, 0); ATT_K(1, 1); ATT_VP(0, -1); ATT_VP(1, -1);
    const LAS char* qb = L + QB_OFF + wq * QSLOT + hi * 512 + r32 * 16;
    bf16x8 qr[4];
    { const bf16* qrow = QM + (tb + (size_t)qb_ * 128 + wq * 32 + r32) * NQM;
      bf16x8 qt[4];
#pragma unroll
      for (int i = 0; i < 4; ++i) qt[i] = *(const bf16x8*)(qrow + h * 128 + (4 * g + i) * 16 + hi * 8);
#pragma unroll
      for (int i = 0; i < 4; ++i) qr[i] = *(const bf16x8*)(qrow + 512 + h * 64 + i * 16 + hi * 8);
#pragma unroll
      for (int i = 0; i < 4; ++i) *(LAS bf16x8*)((LAS char*)qb + (4 * g + i) * 1024) = qt[i]; }
    f32x16 o[4];
#pragma unroll
    for (int d0 = 0; d0 < 4; ++d0) o[d0] = f32x16{};
    f32x16 p0 = f32x16{}, p1 = f32x16{};
    float m_run = -1e30f, l_run = 0.f;
    LAS float* wsf = (LAS float*)(F.lds + WSF_OFF) + w * 64;
    const int xk = (r32 >> 1) & 7;
    const LAS char* kb0 = L + KB_OFF + r32 * 128;
    const int ko0 = (hi ^ xk) * 16;
    const int vq = (lane & 15) >> 2, vbase_ = (4 * hi + vq) * 128 + 8 * (lane & 1);
    const int voA = vbase_ + ((2 * ((lane >> 4) & 1) + ((lane & 3) >> 1)) + 4 * ((vq >> 1) & 1)) * 16;
    const LAS char* vb0 = L + VB_OFF;
    ATT_WAIT_BAR();
    if (g == 1) { ATT_ALLP(0); ATT_CLOSE(0); }
    for (int t = g; t < NT; t += 2) {
        const bool vis = (t < NT - 1) || (wq >= 2);
        const int s3 = (int)((unsigned)t % 3u); const LAS char* kb = kb0 + s3 * KSLOT; const LAS char* vb = vb0 + s3 * VSLOT;
        ATT_ALLP(t);
        if (vis) {
            p0 = f32x16{}; p1 = f32x16{};
#define ATT_KO(kk) (ko0 ^ (32 * ((kk) & 3)))
#define ATT_LDF(i, kk) do { kf0[i] = *(const LAS bf16x8*)(kb + ATT_KO(kk) + ((kk) >> 2) * 8192); kf1[i] = *(const LAS bf16x8*)(kb + ATT_KO(kk) + ((kk) >> 2) * 8192 + 4096); \
                if ((kk) < 8) qfr[i] = *(const LAS bf16x8*)(qb + (kk) * 1024); else qfr[i] = qr[(kk) & 3]; } while (0)
            bf16x8 kf0[3], kf1[3], qfr[3];
            ATT_LDF(0, 0); ATT_LDF(1, 1);
#pragma unroll
            for (int kk = 0; kk < 12; ++kk) {
                if (kk + 2 < 12) ATT_LDF((kk + 2) % 3, kk + 2);
                p0 = __builtin_amdgcn_mfma_f32_32x32x16_bf16(kf0[kk % 3], qfr[kk % 3], p0, 0, 0, 0);
                p1 = __builtin_amdgcn_mfma_f32_32x32x16_bf16(kf1[kk % 3], qfr[kk % 3], p1, 0, 0, 0);
                __builtin_amdgcn_sched_barrier(0);
            }
#undef ATT_LDF
#undef ATT_KO
        }
        ATT_CLOSE(t);
        ATT_ALLP(t + 1);
        if (vis) {
            float rm = fmaxf(p0[0], p1[0]);
#pragma unroll
            for (int r = 1; r < 16; ++r) rm = fmaxf(rm, fmaxf(p0[r], p1[r]));
            rm = swap_max(rm);
            const float mnew = fmaxf(m_run, rm);
            if (__any(mnew > m_run + THR)) {
                const float f = __builtin_amdgcn_exp2f(m_run - mnew); l_run *= f; m_run = mnew;
                if (hi == 0) wsf[r32] = f;
                asm volatile("s_waitcnt lgkmcnt(0)" ::: "memory");
#pragma unroll
                for (int r = 0; r < 16; ++r) { const float fr_ = wsf[crow(r, hi)];
#pragma unroll
                    for (int d0 = 0; d0 < 4; ++d0) o[d0][r] *= fr_; }
            }
#define ATT_VF(dst, ks_) do { _Pragma("unroll") for (int d0 = 0; d0 < 4; ++d0) { const LAS char* vp_ = vb + ((d0 & 1) ? (voA ^ 64) : voA) + (d0 >> 1) * 8192 + (ks_) * 2048; \
                const s16x4 lo = vtr(vp_), hh = vtr(vp_ + 1024); dst[d0] = (bf16x8){lo[0], lo[1], lo[2], lo[3], hh[0], hh[1], hh[2], hh[3]}; } } while (0)
            bf16x8 vfa[4], vfb[4], pwa, pwb;
            float ls = 0.f;
#define ATT_EXPG(PW, ks_) do { float e_[8]; _Pragma("unroll") for (int j = 0; j < 8; ++j) { e_[j] = __builtin_amdgcn_exp2f((((ks_) < 2) ? p0[8 * ((ks_) & 1) + j] : p1[8 * ((ks_) & 1) + j]) - m_run); ls += e_[j]; } \
                const v4u tw_ = {cvtpk(e_[0], e_[1]), cvtpk(e_[2], e_[3]), cvtpk(e_[4], e_[5]), cvtpk(e_[6], e_[7])}; PW = __builtin_bit_cast(bf16x8, tw_); } while (0)
            ATT_VF(vfa, 0); ATT_EXPG(pwa, 0);
            __builtin_amdgcn_sched_barrier(0);
#pragma unroll
            for (int ks = 0; ks < 4; ++ks) {
                if (ks < 3) { if (ks & 1) { ATT_VF(vfa, ks + 1); ATT_EXPG(pwa, ks + 1); } else { ATT_VF(vfb, ks + 1); ATT_EXPG(pwb, ks + 1); } }
#pragma unroll
                for (int d0 = 0; d0 < 4; ++d0) o[d0] = __builtin_amdgcn_mfma_f32_32x32x16_bf16((ks & 1) ? pwb : pwa, (ks & 1) ? vfb[d0] : vfa[d0], o[d0], 0, 0, 0);
                if (ks < 3) {
#pragma unroll
                    for (int i = 0; i < 4; ++i) { __builtin_amdgcn_sched_group_barrier(0x008, 1, 0); __builtin_amdgcn_sched_group_barrier(0x100, 2, 0); __builtin_amdgcn_sched_group_barrier(0x002, 12, 0); }
                }
                __builtin_amdgcn_sched_barrier(0);
            }
#undef ATT_EXPG
            l_run += ls;
#undef ATT_VF
        }
        ATT_CLOSE(t + 1);
    }
    if (g == 0) { ATT_CLOSE(NT); }
    l_run = swap_sum(l_run);
    int lane_b; asm volatile("v_mbcnt_lo_u32_b32 %0, -1, 0\n\tv_mbcnt_hi_u32_b32 %0, -1, %0" : "=v"(lane_b));
    const int r32b = lane_b & 31, hib = lane_b >> 5;
    LAS float* MG = (LAS float*)(F.lds + MERGE_OFF) + wq * 4096;
    LAS float* ST = (LAS float*)(F.lds + ST_OFF) + wq * 64;
    if (g == 1) {
#pragma unroll
        for (int d0 = 0; d0 < 4; ++d0)
#pragma unroll
            for (int r = 0; r < 16; ++r) MG[(d0 * 16 + r) * 64 + lane_b] = o[d0][r];
        if (hib == 0) { ST[r32b] = m_run; ST[32 + r32b] = l_run; }
    }
    ATT_WAIT_BAR();
    if (g == 0) {
        const float m1 = ST[r32b], l1 = ST[32 + r32b];
        const float m = fmaxf(m_run, m1), f0 = __builtin_amdgcn_exp2f(m_run - m), f1 = __builtin_amdgcn_exp2f(m1 - m);
        const float il = 1.0f / (l_run * f0 + l1 * f1);
        if (hib == 0) { wsf[r32b] = f0 * il; wsf[32 + r32b] = f1 * il; }
        asm volatile("s_waitcnt lgkmcnt(0)" ::: "memory");
        LAS bf16* stg = (LAS bf16*)(F.lds + STAGE_OFF) + wq * 4096;
#pragma unroll
        for (int r = 0; r < 16; ++r) { const int row = crow(r, hib); const float a0 = wsf[row], a1 = wsf[32 + row];
#pragma unroll
            for (int d0 = 0; d0 < 4; ++d0) stg[row * 128 + d0 * 32 + r32b] = (bf16)f2bf(o[d0][r] * a0 + MG[(d0 * 16 + r) * 64 + lane_b] * a1);
            if ((r & 3) == 3) __builtin_amdgcn_sched_barrier(0); }
        asm volatile("s_waitcnt lgkmcnt(0)" ::: "memory");
        bf16* orow = CAT + (tb + (size_t)qb_ * 128 + wq * 32) * D + 512 + h * 128;
#pragma unroll
        for (int i = 0; i < 8; ++i) { const int id = i * 64 + lane_b, row = id >> 4, ch = id & 15; *(GAS v4u*)(orow + (size_t)row * D + ch * 8) = *(const LAS v4u*)(stg + row * 128 + ch * 8); }
    }
    ATT_WAIT_BAR();
#undef ATT_KP
#undef ATT_VP
#undef ATT_ALLP
#undef ATT_KBASE
#undef ATT_K
#undef ATT_V
#undef ATT_CLOSE
}
__device__ __forceinline__ void attn_phase(Frame& F, const bf16* QM, const bf16* KVB, const bf16* KPE, bf16* CAT) {
#pragma unroll 1
    for (int it = 2 * F.vcu; it < 512; it += 2 * F.G) {
#pragma unroll 1
        for (int u = 0; u < 2; ++u) { const int v = it >> 1, bh = v >> 5, s = v & 31;
            attn_unit(F, bh >> 2, bh & 3, u ? s : 63 - s, QM, KVB, KPE, CAT); } }
}
#undef ATT_WAIT_BAR
}

namespace ret {
using att::f32x16; using att::s16x4; using att::glds16; using att::crow; using att::vtr; using att::cvtpk;
#define RET_WAIT_BAR() asm volatile("s_waitcnt vmcnt(0) lgkmcnt(0)\n\ts_barrier" ::: "memory")
__device__ __forceinline__ bf16x8 scale8(const bf16x8 v, const float (&f)[8]) {
    float x[8];
#pragma unroll
    for (int j = 0; j < 8; ++j) x[j] = __uint_as_float((unsigned)(unsigned short)v[j] << 16) * f[j];
    v4u t = {cvtpk(x[0], x[1]), cvtpk(x[2], x[3]), cvtpk(x[4], x[5]), cvtpk(x[6], x[7])};
    return __builtin_bit_cast(bf16x8, t);
}
__device__ __forceinline__ bf16x8 trfrag_kappa(const LAS char* p) { const s16x4 lo = vtr(p), hh = vtr(p + 512); return (bf16x8){lo[0], lo[1], lo[2], lo[3], hh[0], hh[1], hh[2], hh[3]}; }
__device__ __forceinline__ bf16x8 trfrag_nat(const LAS char* p) { const s16x4 lo = vtr(p), hh = vtr(p + 256); return (bf16x8){lo[0], lo[1], lo[2], lo[3], hh[0], hh[1], hh[2], hh[3]}; }

__device__ __forceinline__ void kv_phase(Frame& F, const bf16* RK, const bf16* RV, bf16* KVS) {
    const int lane = F.lane, r32 = lane & 31, hi = lane >> 5, w = F.wave;
    const unsigned lds0 = (unsigned)(uintptr_t)F.lds;
    const LAS char* L = (const LAS char*)F.lds;
    const int trb = ((lane >> 4) & 1) * 32 + (lane & 3) * 8 + (4 * hi + ((lane & 15) >> 2)) * 64;
    const int db = w >> 1, eb0 = 2 * (w & 1);
#pragma unroll 1
    for (int blk = F.vcu; blk < BATCH * NCH * RH; blk += F.G) {
        const int h = blk % RH, n = (blk / RH) % NCH, b = blk / (RH * NCH);
        const size_t t0 = (size_t)b * SEQ + (size_t)n * CHUNK;
        { const size_t so = (t0 + 16 * (w & 3) + (lane >> 2)) * 512 + h * 128 + 32 * (w >> 2) + (lane & 3) * 8;
          const unsigned d0 = (unsigned)__builtin_amdgcn_readfirstlane(lds0 + w * 1024);
          glds16(RK + so, d0); glds16(RK + so + 64, d0 + 8192); glds16(RV + so, d0 + 16384); glds16(RV + so + 64, d0 + 16384 + 8192); }
        const float lg2 = ret_logg(h) * 1.4426950408889634f;
        RET_WAIT_BAR();
        f32x16 acc0 = f32x16{}, acc1 = f32x16{};
#pragma unroll
        for (int ks = 0; ks < 4; ++ks) {
            float f[8];
#pragma unroll
            for (int jj = 0; jj < 8; ++jj) f[jj] = __builtin_amdgcn_exp2f(lg2 * (float)(63 - (16 * ks + 4 * hi + (jj & 3) + 8 * (jj >> 2))));
            const bf16x8 af = scale8(trfrag_kappa(L + trb + (db * 4 + ks) * 1024), f);
            const bf16x8 b0 = trfrag_kappa(L + 16384 + trb + (eb0 * 4 + ks) * 1024), b1 = trfrag_kappa(L + 16384 + trb + ((eb0 + 1) * 4 + ks) * 1024);
            acc0 = __builtin_amdgcn_mfma_f32_32x32x16_bf16(af, b0, acc0, 0, 0, 0);
            acc1 = __builtin_amdgcn_mfma_f32_32x32x16_bf16(af, b1, acc1, 0, 0, 0);
        }
        bf16* o = KVS + (size_t)blk * 16384 + (size_t)(32 * db) * 128 + 32 * eb0 + r32;
#pragma unroll
        for (int r = 0; r < 16; ++r) { const int d = crow(r, hi); o[d * 128] = (bf16)f2bf(acc0[r]); o[d * 128 + 32] = (bf16)f2bf(acc1[r]); }
        RET_WAIT_BAR();
    }
}
__device__ __forceinline__ void scan_phase(Frame& F, bf16* KVS, bf16* DST) {
    for (int gid = F.vcu * NTHR + F.tid; gid < BATCH * RH * 16384; gid += F.G * NTHR) {
        const int de = gid & 16383, h = (gid >> 14) % RH, b = gid >> 16;
        const float c = expf(ret_logg(h) * (float)CHUNK); float S = 0.f;
        bf16* p = KVS + ((size_t)(b * NCH * RH + h)) * 16384 + de; bf16* q = DST + ((size_t)(b * NCH * RH + h)) * 16384 + de;
#pragma unroll 1
        for (int n0 = 0; n0 < NCH; n0 += 16) {
            bf16 v[16];
#pragma unroll
            for (int i = 0; i < 16; ++i) v[i] = p[(size_t)(n0 + i) * RH * 16384];
#pragma unroll
            for (int i = 0; i < 16; ++i) { q[(size_t)(n0 + i) * RH * 16384] = (bf16)f2bf(S); S = c * S + bf2f(v[i]); }
        }
    }
}
__device__ __forceinline__ void out_phase(Frame& F, const bf16* RQ, const bf16* RK, const bf16* RV, const bf16* RG, const bf16* PREV, bf16* CAT) {
    const int lane = F.lane, r32 = lane & 31, hi = lane >> 5, w = F.wave, ih = w >> 2, eb = w & 3;
    const unsigned lds0 = (unsigned)(uintptr_t)F.lds;
    const LAS char* L = (const LAS char*)F.lds;
    const int trk = ((lane >> 4) & 1) * 32 + (lane & 3) * 8 + (4 * hi + ((lane & 15) >> 2)) * 64;
    const int trn = ((lane >> 4) & 1) * 32 + (lane & 3) * 8 + (8 * hi + ((lane & 15) >> 2)) * 64;
    LAS float* os = (LAS float*)(F.lds + 65536);
#pragma unroll 1
    for (int blk = F.vcu; blk < BATCH * NCH * RH; blk += F.G) {
        const int h = blk % RH, n = (blk / RH) % NCH, b = blk / (RH * NCH);
        const size_t t0 = (size_t)b * SEQ + (size_t)n * CHUNK;
        { const unsigned d0 = (unsigned)__builtin_amdgcn_readfirstlane(lds0 + w * 1024);
          const size_t ko = (t0 + lane) * 512 + h * 128 + w * 8;
          glds16(RK + ko, d0); glds16(RK + ko + 64, d0 + 8192);
          const size_t so = (t0 + 16 * (w & 3) + (lane >> 2)) * 512 + h * 128 + 32 * (w >> 2) + (lane & 3) * 8;
          glds16(RV + so, d0 + 16384); glds16(RV + so + 64, d0 + 16384 + 8192);
          const bf16* pp = PREV + (size_t)blk * 16384 + (size_t)(16 * w + (lane >> 2)) * 128 + (lane & 3) * 8;
          glds16(pp, d0 + 32768); glds16(pp + 32, d0 + 32768 + 8192); glds16(pp + 64, d0 + 32768 + 16384); glds16(pp + 96, d0 + 32768 + 24576); }
        bf16x8 qf[8];
        { const bf16* qrow = RQ + (t0 + 32 * ih + r32) * 512 + h * 128 + hi * 8;
#pragma unroll
          for (int kk = 0; kk < 8; ++kk) qf[kk] = *(const bf16x8*)(qrow + kk * 16); }
        const float lg2 = ret_logg(h) * 1.4426950408889634f;
        RET_WAIT_BAR();
        f32x16 p0 = f32x16{}, p1 = f32x16{};
        { const LAS char* kb = L + hi * 1024 + r32 * 16;
#pragma unroll
          for (int kk = 0; kk < 8; ++kk) { const bf16x8 a0 = *(const LAS bf16x8*)(kb + kk * 2048), a1 = *(const LAS bf16x8*)(kb + kk * 2048 + 512);
              p0 = __builtin_amdgcn_mfma_f32_32x32x16_bf16(a0, qf[kk], p0, 0, 0, 0); p1 = __builtin_amdgcn_mfma_f32_32x32x16_bf16(a1, qf[kk], p1, 0, 0, 0); } }
        f32x16 oc = f32x16{};
#pragma unroll
        for (int kd = 0; kd < 8; ++kd) oc = __builtin_amdgcn_mfma_f32_32x32x16_bf16(qf[kd], trfrag_nat(L + 32768 + trn + (eb * 8 + kd) * 1024), oc, 0, 0, 0);
        { const int i = 32 * ih + r32;
#pragma unroll
          for (int r = 0; r < 16; ++r) { const int j = crow(r, hi); const int d0 = i > j ? i - j : j - i, d1 = i > j + 32 ? i - j - 32 : j + 32 - i;
              p0[r] *= __builtin_amdgcn_exp2f(lg2 * (float)d0); p1[r] *= __builtin_amdgcn_exp2f(lg2 * (float)d1); } }
        bf16x8 pw[4];
        { v4u t0_ = {cvtpk(p0[0], p0[1]), cvtpk(p0[2], p0[3]), cvtpk(p0[4], p0[5]), cvtpk(p0[6], p0[7])};
          v4u t1_ = {cvtpk(p0[8], p0[9]), cvtpk(p0[10], p0[11]), cvtpk(p0[12], p0[13]), cvtpk(p0[14], p0[15])};
          v4u t2_ = {cvtpk(p1[0], p1[1]), cvtpk(p1[2], p1[3]), cvtpk(p1[4], p1[5]), cvtpk(p1[6], p1[7])};
          v4u t3_ = {cvtpk(p1[8], p1[9]), cvtpk(p1[10], p1[11]), cvtpk(p1[12], p1[13]), cvtpk(p1[14], p1[15])};
          pw[0] = __builtin_bit_cast(bf16x8, t0_); pw[1] = __builtin_bit_cast(bf16x8, t1_); pw[2] = __builtin_bit_cast(bf16x8, t2_); pw[3] = __builtin_bit_cast(bf16x8, t3_); }
        f32x16 oi = f32x16{};
#pragma unroll
        for (int ks = 0; ks < 4; ++ks) oi = __builtin_amdgcn_mfma_f32_32x32x16_bf16(pw[ks], trfrag_kappa(L + 16384 + trk + (eb * 4 + ks) * 1024), oi, 0, 0, 0);
#pragma unroll
        for (int r = 0; r < 16; ++r) { const int i = 32 * ih + crow(r, hi); os[i * 128 + 32 * eb + r32] = oi[r] + __builtin_amdgcn_exp2f(lg2 * (float)(i + 1)) * oc[r]; }
        RET_WAIT_BAR();
#pragma unroll 1
        for (int r = 0; r < 8; ++r) { const int i = w * 8 + r;
            const float a0 = os[i * 128 + lane], a1 = os[i * 128 + lane + 64];
            const float mu = wave_sum(a0 + a1) * (1.0f / 128.0f); const float d0 = a0 - mu, d1 = a1 - mu;
            const float rs = 1.0f / sqrtf(wave_sum(d0 * d0 + d1 * d1) * (1.0f / 128.0f) + 1e-5f);
            const float g0 = bf2f(RG[(t0 + i) * 512 + h * 128 + lane]), g1 = bf2f(RG[(t0 + i) * 512 + h * 128 + lane + 64]);
            bf16* orow = CAT + (t0 + i) * D + h * 128;
            orow[lane] = (bf16)f2bf(d0 * rs * g0 * pg8::fast_sigmoid(g0)); orow[lane + 64] = (bf16)f2bf(d1 * rs * g1 * pg8::fast_sigmoid(g1)); }
        RET_WAIT_BAR();
    }
}
#undef RET_WAIT_BAR
}
__global__ void __launch_bounds__(NTHR, 2) mk_fwd(Args args) {
    extern __shared__ __attribute__((aligned(16))) unsigned char lds[];
    Frame F;
    F.lds = (LAS unsigned char*)lds;
    F.MISC = (volatile LAS unsigned*)(F.lds + MISC_OFF);
    F.wave = __builtin_amdgcn_readfirstlane((int)threadIdx.x >> 6);
#define REFRESH() do { int l_; asm volatile("v_mbcnt_lo_u32_b32 %0, -1, 0\n\tv_mbcnt_hi_u32_b32 %0, -1, %0" : "=v"(l_)); F.lane = l_; F.tid = F.wave * 64 + l_; } while (0)
    REFRESH();
    F.G = gridDim.x; { const int bx = blockIdx.x; F.vcu = (F.G % 8 == 0) ? (bx % 8) * (F.G / 8) + bx / 8 : bx; }
    unsigned char* ws = args.ws;
    F.ctl = (gu32*)(ws + WS_CTL);
    for (int u = F.tid; u < (LDS_BYTES - LDSCTL_OFF) / 4; u += NTHR) ((LAS unsigned*)(F.lds + LDSCTL_OFF))[u] = 0u;
    __syncthreads();
    XcdBarrier bar; bar.bar = (unsigned*)(F.ctl + CW_BAR); bar.x = 0; bar.st = nullptr;
    if (N_LAUNCHES != PER_PHASE) bar = xcd_barrier_post((unsigned*)(F.ctl + CW_BAR), F.MISC + 8, F.tid);
#define GRID_BAR() do { if (N_LAUNCHES != PER_PHASE) { REFRESH(); xcd_barrier(bar, F.tid); } REFRESH(); } while (0)
    const int lo = args.ph_lo, hi = args.ph_hi;
#define IN(k) (lo <= (k) && (k) < hi)
#define BOTH(k) (IN(k) && IN((k) + 1))
    bf16* XN = (bf16*)(ws + WS_XN); bf16* RQ = (bf16*)(ws + WS_RQ); bf16* RK = (bf16*)(ws + WS_RK); bf16* RV = (bf16*)(ws + WS_RV); bf16* RG = (bf16*)(ws + WS_RG);
    bf16* QM = (bf16*)(ws + WS_QM); bf16* CQ = (bf16*)(ws + WS_CQ); bf16* CKV = (bf16*)(ws + WS_CKV); bf16* KPE = (bf16*)(ws + WS_KPE); bf16* KVB = (bf16*)(ws + WS_KVB);
    bf16* CAT = (bf16*)(ws + WS_CAT); bf16* PB = (bf16*)(ws + WS_PB); bf16* ACT = (bf16*)(ws + WS_ACT); bf16* KVS = XN; bf16* X1B = XN; bf16* PROJ = KVB;
    float* SSQ = (float*)(ws + WS_SSQ); float* ssq_cq = SSQ; float* ssq_ckv = SSQ + T; float* ssq_x1 = SSQ + 2 * T; float* ssq_x2 = SSQ + 3 * T; float* ssq_x3 = SSQ + 4 * T;
    const float* RC = (const float*)(ws + WS_RC); const float* RS = (const float*)(ws + WS_RS); const float* MC = (const float*)(ws + WS_MC); const float* MS = (const float*)(ws + WS_MS);
    const int cid = (int)blockIdx.x;
    float* ssq_dummy = SSQ + 5 * T;
#define REPS(k) for (int rep = 0; rep < ((MK_DUP) == (k) ? 2 : 1); ++rep)

    if (IN(0)) { REFRESH(); REPS(0) p0_prologue(F, args.in, ws); if (BOTH(0)) { GRID_BAR(); REPS(90) { if (rep) GRID_BAR(); } } }
    if (IN(1)) { REFRESH();
        pg8::Gemm g{XN, (const bf16*)(ws + WS_WIN), T, NZ, D}; pg8::StaticOrder S; S.init(T, NZ, F.G, cid);
        REPS(1) { pg8::EpiZ E{RQ, RK, RV, RG, CQ, CKV, KPE, RC, RS, MC, MS, rep ? ssq_dummy : ssq_cq, rep ? ssq_dummy : ssq_ckv};
        pg8::gemm_phase<pg8::EpiZ, pg8::StaticOrder, true, true>(F.lds + RING_OFF, g, S, E, F.tid, F.wave); }
        if (OPT_W1 && F.G == 256 && cid >= 128) { REFRESH(); p0_weights(F, args.in, ws, 3, 8, (cid - 128) * NWAVES + F.wave, 128 * NWAVES); }
        if (BOTH(1)) GRID_BAR();
    }
    if (IN(2)) { REFRESH(); REPS(21) {
        { pg8::Gemm g{CQ, (const bf16*)(ws + WS_WUQ), T, NQM, 256}; pg8::StaticOrder S; S.init(T, NQM, F.G, cid);
          pg8::EpiQM E{QM, MC, MS, ssq_cq, QSCALE};
          pg8::gemm_phase<pg8::EpiQM, pg8::StaticOrder, true, true>(F.lds + RING_OFF, g, S, E, F.tid, F.wave); }
        { pg8::Gemm g{CKV, (const bf16*)(ws + WS_WUKV), T, NKV, 128}; pg8::StaticOrder S; S.init(T, NKV, F.G, cid);
          pg8::EpiScaleBf16 E{KVB, 256, ssq_ckv, 1.0f / 128.0f, (size_t)T * 256};
          pg8::gemm_phase<pg8::EpiScaleBf16, pg8::StaticOrder, true, true>(F.lds + RING_OFF, g, S, E, F.tid, F.wave); } }
        REFRESH(); REPS(22) ret::kv_phase(F, RK, RV, KVS);
        if (BOTH(2)) GRID_BAR();
    }
    if (IN(3)) { REFRESH();
        REPS(30) ret::scan_phase(F, KVS, rep ? CAT : KVS);
        if (BOTH(3)) GRID_BAR();
    }
    if (IN(4)) { REFRESH();
        REPS(3) att::attn_phase(F, QM, KVB, KPE, CAT);
        REFRESH(); REPS(4) ret::out_phase(F, RQ, RK, RV, RG, KVS, CAT);
        if (BOTH(4)) GRID_BAR();
    }
    if (IN(5)) { REFRESH(); REPS(5) {
        { pg8::Gemm g{CAT, (const bf16*)(ws + WS_WO), T, D, D}; pg8::StaticOrder S; S.init(T, D, F.G, cid);
          pg8::EpiRes E{args.in.x, args.out, X1B, rep ? ssq_dummy : ssq_x1};
          pg8::gemm_phase<pg8::EpiRes, pg8::StaticOrder, true, true>(F.lds + RING_OFF, g, S, E, F.tid, F.wave); }
        if (!OPT_PROJ6 || F.G != 256) { pg8::Gemm g{PB, (const bf16*)(ws + WS_WPP), T, D, DPLE}; pg8::StaticOrder S; S.init(T, D, F.G, cid);
          pg8::EpiScaleBf16 E{PROJ, D, nullptr, 0.f, 0};
          pg8::gemm_phase<pg8::EpiScaleBf16, pg8::StaticOrder, true, true>(F.lds + RING_OFF, g, S, E, F.tid, F.wave); } }
        if (BOTH(5)) GRID_BAR();
    }
    if (IN(6)) { REFRESH();
        pg8::Gemm g{X1B, (const bf16*)(ws + WS_WGU), T, NGU, D}; pg8::StaticOrder S; S.init(T, NGU, F.G, cid);
        pg8::EpiGU E{ACT, DFF, ssq_x1};
        REPS(6) pg8::gemm_phase<pg8::EpiGU, pg8::StaticOrder, true, true>(F.lds + RING_OFF, g, S, E, F.tid, F.wave);
        if (MK_DUP == 60) { GRID_BAR(); pg8::gemm_phase<pg8::EpiGU, pg8::StaticOrder, true, true>(F.lds + RING_OFF, g, S, E, F.tid, F.wave); }
        if (OPT_PROJ6 && F.G == 256 && cid >= 128) { REFRESH();
            pg8::Gemm g2{PB, (const bf16*)(ws + WS_WPP), T, D, DPLE}; pg8::SubsetOrder S2{D / 256, (cid - 128) * 2, 2}; pg8::EpiScaleBf16 E2{PROJ, D, nullptr, 0.f, 0};
            pg8::gemm_phase<pg8::EpiScaleBf16, pg8::SubsetOrder, true, true>(F.lds + RING_OFF, g2, S2, E2, F.tid, F.wave); }
        if (BOTH(6)) GRID_BAR();
    }
    if (IN(7)) { REFRESH();
        if (MK_DUP == 7) { pg8::Gemm g{ACT, (const bf16*)(ws + WS_WD), T, D, DFF}; pg8::StaticOrder S; S.init(T, D, F.G, cid); pg8::EpiScaleBf16 E{CAT, D, nullptr, 0.f, 0};
            pg8::gemm_phase<pg8::EpiScaleBf16, pg8::StaticOrder, true, true>(F.lds + RING_OFF, g, S, E, F.tid, F.wave); }
        pg8::Gemm g{ACT, (const bf16*)(ws + WS_WD), T, D, DFF}; pg8::StaticOrder S; S.init(T, D, F.G, cid);
        pg8::EpiRes E{args.out, args.out, X1B, ssq_x2};
        pg8::gemm_phase<pg8::EpiRes, pg8::StaticOrder, true, true>(F.lds + RING_OFF, g, S, E, F.tid, F.wave);
        if (BOTH(7)) GRID_BAR();
    }
    if (IN(8)) { REFRESH();
        if (MK_DUP == 8) { pg8::Gemm g{X1B, (const bf16*)(ws + WS_WPG), T, D, D}; pg8::StaticOrder S; S.init(T, D, F.G, cid); pg8::EpiScaleBf16 E{CAT, D, nullptr, 0.f, 0};
            pg8::gemm_phase<pg8::EpiScaleBf16, pg8::StaticOrder, true, true>(F.lds + RING_OFF, g, S, E, F.tid, F.wave); }
        pg8::Gemm g{X1B, (const bf16*)(ws + WS_WPG), T, D, D}; pg8::StaticOrder S; S.init(T, D, F.G, cid);
        pg8::EpiPle E{args.out, PROJ, ssq_x2, ssq_x3};
        pg8::gemm_phase<pg8::EpiPle, pg8::StaticOrder, true, true>(F.lds + RING_OFF, g, S, E, F.tid, F.wave);
        if (BOTH(8)) GRID_BAR();
    }
    if (IN(9)) { REFRESH(); final_norm(F, args.out, ssq_x3, args.in.fin_g); }
#undef IN
#undef BOTH
}

extern "C" void kernel_launch(void* const* d_in, const int* in_sizes, int n_in, void* d_out, int out_size, void* d_ws, size_t ws_size, hipStream_t stream) {
    static int grid = 0;
    if (grid == 0) {
        if (n_in != 18 || out_size != T * D || ws_size < WS_END) { fprintf(stderr, "kernel_launch: unexpected shapes (n_in %d out %d ws %zu)\n", n_in, out_size, ws_size); grid = -1; return; }
        int dev = 0, cus = 0;
        if (hipGetDevice(&dev) != hipSuccess || hipDeviceGetAttribute(&cus, hipDeviceAttributeMultiprocessorCount, dev) != hipSuccess) { grid = -1; return; }
        if (hipFuncSetAttribute((const void*)mk_fwd, hipFuncAttributeMaxDynamicSharedMemorySize, LDS_BYTES) != hipSuccess) { fprintf(stderr, "kernel_launch: hipFuncSetAttribute failed\n"); grid = -1; return; }
        grid = cus;
    }
    if (grid < 0) return;
    if (hipMemsetAsync((char*)d_ws + WS_CTL, 0, CTL_ZERO_BYTES, stream) != hipSuccess) return;
    Args a{};
    const void** pp = (const void**)&a.in;
    for (int i = 0; i < 18; ++i) pp[i] = d_in[i];
    a.out = (float*)d_out; a.ws = (unsigned char*)d_ws;
    for (int li = 0; li < N_LAUNCHES; ++li) {
        a.ph_lo = (N_LAUNCHES == PER_PHASE) ? li : 0; a.ph_hi = (N_LAUNCHES == PER_PHASE) ? li + 1 : PER_PHASE; a.li = li;
        hipLaunchKernelGGL(mk_fwd, dim3(grid), dim3(NTHR), LDS_BYTES, stream, a);
    }
}
```
